# Optimizing an MI355X kernel written in HIP

```python
import math
import jax, jax.numpy as jnp
from jax import lax
import numpy as np

D_MODEL = 1024
BATCH = 1
SEQ = 16384
DEPTH = 2

HEAD_DIM = 64
ATT_WIDTH = D_MODEL // 2
ATT_HEADS = ATT_WIDTH // HEAD_DIM
SG_WIDTH = D_MODEL // 4
SG_GROUPS = 4
SG_GROUP_DIM = SG_WIDTH // SG_GROUPS
CONV_WIDTH = D_MODEL // 4
MIX_WIDTH = ATT_WIDTH + SG_WIDTH + CONV_WIDTH

Q_OFF = 0
K_OFF = Q_OFF + ATT_WIDTH
V_OFF = K_OFF + ATT_WIDTH
SGU_OFF = V_OFF + ATT_WIDTH
SGV_OFF = SGU_OFF + SG_WIDTH
CA_OFF = SGV_OFF + SG_WIDTH
CG_OFF = CA_OFF + CONV_WIDTH
IN_COLS = CG_OFF + CONV_WIDTH

MOBA_BLOCK = 256
MOBA_TOPK = 3
Q_CHUNK = 128
SG_CHUNK = 128
CONV_TAPS = 31
ROPE_THETA = 10000.0
N_EXPERTS = 16
N_EXPERT_GROUPS = 4
EXPERTS_PER_GROUP = N_EXPERTS // N_EXPERT_GROUPS
TOP_K = 2
D_EXPERT = D_MODEL // 2
LN_EPS = 1e-5
NEG = -1e30
DEEPNORM_ALPHA = (2.0 * DEPTH) ** 0.25
DEEPNORM_BETA = (8.0 * DEPTH) ** -0.25

kernel_name = "hymba_moba_gmlp_conformer_grouped_moe"


def layer_norm(x, g, b):
    xf = x.astype(jnp.float32)
    mu = jnp.mean(xf, axis=-1, keepdims=True)
    var = jnp.mean(jnp.square(xf - mu), axis=-1, keepdims=True)
    return ((xf - mu) * lax.rsqrt(var + LN_EPS) * g + b).astype(x.dtype)


def rotary(x):
    s = x.shape[1]
    half = HEAD_DIM // 2
    inv_freq = ROPE_THETA ** (-jnp.arange(half, dtype=jnp.float32) / half)
    ang = jnp.arange(s, dtype=jnp.float32)[:, None] * inv_freq[None, :]
    cos = jnp.cos(ang)[None, :, None, :]
    sin = jnp.sin(ang)[None, :, None, :]
    xf = x.astype(jnp.float32)
    x1, x2 = xf[..., :half], xf[..., half:]
    return jnp.concatenate([x1 * cos - x2 * sin, x2 * cos + x1 * sin], axis=-1).astype(x.dtype)


def moba_attention(q, k, v):
    b, s, h, dh = q.shape
    bh = b * h
    nb = -(-s // MOBA_BLOCK)
    pad = nb * MOBA_BLOCK - s
    k_top = min(MOBA_TOPK, nb)
    to_g = lambda t: t.transpose(0, 2, 1, 3).reshape(bh, s, dh)
    qg, kg, vg = to_g(q), to_g(k), to_g(v)
    kb = jnp.pad(kg, ((0, 0), (0, pad), (0, 0))).reshape(bh, nb, MOBA_BLOCK, dh)
    vb = jnp.pad(vg, ((0, 0), (0, pad), (0, 0))).reshape(bh, nb, MOBA_BLOCK, dh)
    kmean = jnp.mean(kb.astype(jnp.float32), axis=2)
    nc = s // Q_CHUNK
    qc = qg.reshape(bh, nc, Q_CHUNK, dh).transpose(1, 0, 2, 3)
    scale = HEAD_DIM ** -0.5
    g_idx = jnp.arange(bh)[:, None, None]
    blk_ids = jnp.arange(nb)
    sel_rank = jnp.arange(k_top)

    def one_chunk(args):
        qi, c = args
        q_pos = c * Q_CHUNK + jnp.arange(Q_CHUNK)
        own = (c * Q_CHUNK) // MOBA_BLOCK
        gate = jnp.einsum('gqd,gnd->gqn', qi.astype(jnp.float32), kmean)
        gate = jnp.where((blk_ids < own)[None, None, :], gate, NEG)
        _, sel = lax.top_k(gate, k_top)
        sel_ok = sel_rank < own
        k_sel = kb[g_idx, sel]
        v_sel = vb[g_idx, sel]
        s_sel = jnp.einsum('gqd,gqnkd->gqnk', qi, k_sel).astype(jnp.float32) * scale
        s_sel = jnp.where(sel_ok[None, None, :, None], s_sel, NEG).reshape(bh, Q_CHUNK, k_top * MOBA_BLOCK)
        k_own = lax.dynamic_index_in_dim(kb, own, axis=1, keepdims=False)
        v_own = lax.dynamic_index_in_dim(vb, own, axis=1, keepdims=False)
        s_own = jnp.einsum('gqd,gkd->gqk', qi, k_own).astype(jnp.float32) * scale
        k_pos = own * MOBA_BLOCK + jnp.arange(MOBA_BLOCK)
        s_own = jnp.where((k_pos[None, :] <= q_pos[:, None])[None], s_own, NEG)
        p = jax.nn.softmax(jnp.concatenate([s_sel, s_own], axis=-1), axis=-1)
        p_sel = p[..., :k_top * MOBA_BLOCK].reshape(bh, Q_CHUNK, k_top, MOBA_BLOCK).astype(v.dtype)
        p_own = p[..., k_top * MOBA_BLOCK:].astype(v.dtype)
        return (jnp.einsum('gqnk,gqnkd->gqd', p_sel, v_sel)
                + jnp.einsum('gqk,gkd->gqd', p_own, v_own))

    out = lax.map(one_chunk, (qc, jnp.arange(nc)))
    out = out.transpose(1, 0, 2, 3).reshape(b, h, s, dh).transpose(0, 2, 1, 3)
    return out.reshape(b, s, h * dh)


def spatial_gating(u, v, ln_g, ln_b, w_s, b_s):
    b, s, _ = v.shape
    v = layer_norm(v, ln_g, ln_b)
    vc = v.reshape(b, s // SG_CHUNK, SG_CHUNK, SG_GROUPS, SG_GROUP_DIM)
    causal = jnp.tril(jnp.ones((SG_CHUNK, SG_CHUNK), dtype=bool))
    w = jnp.where(causal[None], w_s, 0.0)
    mixed = jnp.einsum('gts,bcsgd->bctgd', w, vc) + b_s.T[None, None, :, :, None]
    return u * mixed.reshape(b, s, SG_WIDTH)


def conv_module(a, g, w_dw, b_dw, ln_g, ln_b):
    h = a * jax.nn.sigmoid(g)
    h = lax.conv_general_dilated(h, w_dw[:, None, :], window_strides=(1,),
                                 padding=((CONV_TAPS - 1, 0),),
                                 dimension_numbers=('NWC', 'WIO', 'NWC'),
                                 feature_group_count=CONV_WIDTH) + b_dw
    h = layer_norm(h, ln_g, ln_b)
    return jax.nn.silu(h)


def hybrid_mixer(h, w_in, w_out, sg_ln_g, sg_ln_b, sg_w, sg_b, conv_w, conv_b, conv_ln_g, conv_ln_b):
    b, s, _ = h.shape
    p = h @ w_in
    q = rotary(p[..., Q_OFF:K_OFF].reshape(b, s, ATT_HEADS, HEAD_DIM))
    k = rotary(p[..., K_OFF:V_OFF].reshape(b, s, ATT_HEADS, HEAD_DIM))
    v = p[..., V_OFF:SGU_OFF].reshape(b, s, ATT_HEADS, HEAD_DIM)
    y_att = moba_attention(q, k, v)
    y_sg = spatial_gating(jax.nn.gelu(p[..., SGU_OFF:SGV_OFF]), jax.nn.gelu(p[..., SGV_OFF:CA_OFF]),
                          sg_ln_g, sg_ln_b, sg_w, sg_b)
    y_cv = conv_module(p[..., CA_OFF:CG_OFF], p[..., CG_OFF:IN_COLS], conv_w, conv_b, conv_ln_g, conv_ln_b)
    return jnp.concatenate([y_att, y_sg, y_cv], axis=-1) @ w_out


def grouped_moe(h, w_router, router_bias, w_gate, w_up, w_down):
    b, s, d = h.shape
    hf = h.reshape(b * s, d)
    n = hf.shape[0]
    scores = jax.nn.sigmoid((hf @ w_router).astype(jnp.float32))
    biased = (scores + router_bias.astype(jnp.float32)).reshape(n, N_EXPERT_GROUPS, EXPERTS_PER_GROUP)
    grp_score = jnp.sum(lax.top_k(biased, TOP_K)[0], axis=-1)
    grp = jnp.argmax(grp_score, axis=-1)
    in_grp = jnp.take_along_axis(biased, grp[:, None, None], axis=1)[:, 0]
    _, local = lax.top_k(in_grp, TOP_K)
    expert_ids = grp[:, None] * EXPERTS_PER_GROUP + local
    w_sel = jnp.take_along_axis(scores, expert_ids, axis=1)
    w_sel = w_sel / jnp.sum(w_sel, axis=-1, keepdims=True)
    gates = jnp.sum(jax.nn.one_hot(expert_ids, N_EXPERTS, dtype=jnp.float32) * w_sel[..., None], axis=1)
    gates = gates.astype(hf.dtype)
    out = jnp.zeros_like(hf)
    for e in range(N_EXPERTS):
        y = (jax.nn.silu(hf @ w_gate[e]) * (hf @ w_up[e])) @ w_down[e]
        out = out + gates[:, e:e + 1] * y
    return out.reshape(b, s, d)


def setup_inputs(seed: int = 0) -> dict:
    key = jax.random.key(seed)
    ks = jax.random.split(key, 24)
    f32 = jnp.float32
    nrm = lambda k, shape, sc: jax.random.normal(k, shape, f32) * sc
    gain = lambda k, shape: 1.0 + 0.02 * jax.random.normal(k, shape, f32)
    return {
        "x": jax.random.normal(ks[0], (BATCH, SEQ, D_MODEL), f32),
        "ln_in_g": gain(ks[1], (D_MODEL,)),
        "ln_in_b": nrm(ks[2], (D_MODEL,), 0.02),
        "w_in": nrm(ks[3], (DEPTH, D_MODEL, IN_COLS), D_MODEL ** -0.5),
        "w_out": nrm(ks[4], (DEPTH, MIX_WIDTH, D_MODEL), MIX_WIDTH ** -0.5 * DEEPNORM_BETA),
        "sg_ln_g": gain(ks[5], (DEPTH, SG_WIDTH)),
        "sg_ln_b": nrm(ks[6], (DEPTH, SG_WIDTH), 0.02),
        "sg_w": nrm(ks[7], (DEPTH, SG_GROUPS, SG_CHUNK, SG_CHUNK), SG_CHUNK ** -0.5),
        "sg_b": gain(ks[8], (DEPTH, SG_GROUPS, SG_CHUNK)),
        "conv_w": nrm(ks[9], (DEPTH, CONV_TAPS, CONV_WIDTH), CONV_TAPS ** -0.5),
        "conv_b": nrm(ks[10], (DEPTH, CONV_WIDTH), 0.02),
        "conv_ln_g": gain(ks[11], (DEPTH, CONV_WIDTH)),
        "conv_ln_b": nrm(ks[12], (DEPTH, CONV_WIDTH), 0.02),
        "ln_mix_g": gain(ks[13], (DEPTH, D_MODEL)),
        "ln_mix_b": nrm(ks[14], (DEPTH, D_MODEL), 0.02),
        "w_router": nrm(ks[15], (D_MODEL, N_EXPERTS), D_MODEL ** -0.5),
        "router_bias": nrm(ks[16], (N_EXPERTS,), 0.01),
        "w_gate": nrm(ks[17], (DEPTH, N_EXPERTS, D_MODEL, D_EXPERT), D_MODEL ** -0.5),
        "w_up": nrm(ks[18], (DEPTH, N_EXPERTS, D_MODEL, D_EXPERT), D_MODEL ** -0.5),
        "w_down": nrm(ks[19], (DEPTH, N_EXPERTS, D_EXPERT, D_MODEL), D_EXPERT ** -0.5 * DEEPNORM_BETA),
        "ln_ffn_g": gain(ks[20], (DEPTH, D_MODEL)),
        "ln_ffn_b": nrm(ks[21], (DEPTH, D_MODEL), 0.02),
    }


def reference(x, ln_in_g, ln_in_b, w_in, w_out, sg_ln_g, sg_ln_b, sg_w, sg_b, conv_w, conv_b,
              conv_ln_g, conv_ln_b, ln_mix_g, ln_mix_b, w_router, router_bias, w_gate, w_up, w_down,
              ln_ffn_g, ln_ffn_b):
    h = layer_norm(x, ln_in_g, ln_in_b)
    for l in range(DEPTH):
        mix = hybrid_mixer(h, w_in[l], w_out[l], sg_ln_g[l], sg_ln_b[l], sg_w[l], sg_b[l],
                           conv_w[l], conv_b[l], conv_ln_g[l], conv_ln_b[l])
        h = layer_norm(DEEPNORM_ALPHA * h + mix, ln_mix_g[l], ln_mix_b[l])
        ffn = grouped_moe(h, w_router, router_bias, w_gate[l], w_up[l], w_down[l])
        h = layer_norm(DEEPNORM_ALPHA * h + ffn, ln_ffn_g[l], ln_ffn_b[l])
    return h
```

```cpp
#include <hip/hip_runtime.h>
#include <cstdio>
#include <cstdint>

#ifndef ENABLE_ATT
#define ENABLE_ATT 1
#endif
#ifndef REP_P0
#define REP_P0 0
#endif
#ifndef REP_PA
#define REP_PA 0
#endif
#ifndef REP_SG
#define REP_SG 0
#endif
#ifndef REP_CONV
#define REP_CONV 0
#endif
#ifndef REP_PC
#define REP_PC 0
#endif
#ifndef REP_PD
#define REP_PD 0
#endif
#ifndef REP_PG
#define REP_PG 0
#endif
#ifndef REP_PH
#define REP_PH 0
#endif
#ifndef REP_PI
#define REP_PI 0
#endif
#ifndef REP_GATE
#define REP_GATE 0
#endif
#ifndef REP_PE
#define REP_PE 0
#endif
#ifndef REP_PF
#define REP_PF 0
#endif
#ifndef REP_PJ
#define REP_PJ 0
#endif
#ifndef REP_PFC
#define REP_PFC 0
#endif
#ifndef REP_BAR
#define REP_BAR 0
#endif
#ifndef SELFCHECK
#define SELFCHECK 0
#endif

#define GAS __attribute__((address_space(1)))
#define LAS __attribute__((address_space(3)))
typedef unsigned short bf16;
typedef short bf16x8 __attribute__((ext_vector_type(8)));
typedef float f32x4 __attribute__((ext_vector_type(4)));
typedef float f32x2 __attribute__((ext_vector_type(2)));
typedef unsigned u32x4 __attribute__((ext_vector_type(4)));
typedef unsigned u32x2 __attribute__((ext_vector_type(2)));
typedef GAS unsigned gu32;

constexpr int S = 16384, D = 1024, NIN = 2560, NH = 8, HD = 64, NBLK = 64, DEPTH = 2;
constexpr int NE = 16, DE = 512;
constexpr int SGW = 256, CVW = 256, TAPS = 31;
constexpr int Q_OFF = 0, K_OFF = 512, V_OFF = 1024, SGU_OFF = 1536, SGV_OFF = 1792, CA_OFF = 2048, CG_OFF = 2304;
constexpr float LN_EPS = 1e-5f;
constexpr float ALPHA = 1.4142135623730951f;
constexpr float LOG2E = 1.4426950408889634f;
constexpr int MAXROWS = 2 * S + NE * 256;

constexpr size_t MiB = 1u << 20;
constexpr size_t WS_CTL = 0, CTL_ZERO_BYTES = 1 * MiB;
constexpr size_t WS_CS = 1 * MiB;
constexpr size_t WS_WIN = 5 * MiB;
constexpr size_t WS_WOUT = 15 * MiB;
constexpr size_t WS_WSG = 19 * MiB;
constexpr size_t WS_ELIST = 20 * MiB;
constexpr size_t WS_EW = 21 * MiB;
constexpr size_t WS_ROWINFO = 21 * MiB + 512 * 1024;
constexpr size_t WS_HB = 22 * MiB;
constexpr size_t WS_R = 54 * MiB;
constexpr size_t WS_P = WS_R;
constexpr size_t WS_MIXIN = WS_R + 80 * MiB;
constexpr size_t WS_PARTO = WS_R + 112 * MiB;
constexpr size_t WS_PARTML = WS_R + 160 * MiB;
constexpr size_t WS_LISTS = WS_R + 163 * MiB;
constexpr size_t WS_WGU = WS_R;
constexpr size_t WS_WDN = WS_R + 32 * MiB;
constexpr size_t WS_AG = WS_R + 48 * MiB;
constexpr size_t WS_ACT = WS_R + 120 * MiB;
constexpr size_t WS_Y = WS_R + 156 * MiB;
constexpr size_t WS_END = WS_R + 220 * MiB;
constexpr size_t WS_ERR = WS_END;
static_assert((size_t)MAXROWS * 1024 * 2 <= 72 * MiB && (size_t)MAXROWS * 512 * 2 <= 36 * MiB, "MoE buffers");
constexpr int CW_TMO = 0;
constexpr int CW_BAR = 4096;
constexpr int CW_ACNT = 8192;
constexpr int CW_ECNT = 9216;
constexpr int CW_ERR = 9280;
constexpr int CW_KMEAN = 16384;

constexpr int RING_BYTES = 131072;
constexpr int MISC_OFF = RING_BYTES;
constexpr int LDS_BYTES = 147456;
constexpr int NWAVES = 8;

#define RLX_AGENT __ATOMIC_RELAXED, __HIP_MEMORY_SCOPE_AGENT
#define LDS_WAIT() asm volatile("s_waitcnt lgkmcnt(0)" ::: "memory")
#define VM_WAIT() asm volatile("s_waitcnt vmcnt(0)" ::: "memory")

__device__ __forceinline__ unsigned f2bf(float f) { unsigned u = __builtin_bit_cast(unsigned, f); return (u + 0x7fffu + ((u >> 16) & 1u)) >> 16; }
__device__ __forceinline__ unsigned pk2(float lo, float hi) { return f2bf(lo) | (f2bf(hi) << 16); }
__device__ __forceinline__ float bf2f(unsigned b) { return __builtin_bit_cast(float, b << 16); }
__device__ __forceinline__ float bflo(unsigned w) { return __builtin_bit_cast(float, w << 16); }
__device__ __forceinline__ float bfhi(unsigned w) { return __builtin_bit_cast(float, w & 0xffff0000u); }
__device__ __forceinline__ float wave_sum(float v) {
#pragma unroll
    for (int o = 1; o < 64; o <<= 1) v += __shfl_xor(v, o);
    return v;
}
__device__ __forceinline__ float fast_exp2(float x) { return __builtin_amdgcn_exp2f(x); }
__device__ __forceinline__ float sigmoidf_(float x) { return 1.0f / (1.0f + __expf(-x)); }
__device__ __forceinline__ float gelu_tanh(float x) { const float z = 0.7978845608028654f * (x + 0.044715f * x * x * x); return x * sigmoidf_(2.0f * z); }

namespace pg8 {
constexpr int BM = 256, BK = 64, HALF = 128, HTB = HALF * BK * 2, STAGE_BYTES = 8 * HTB, NXCD = 8, WGM = 8;
__host__ __device__ __forceinline__ int lds_byte(int r, int c) { const int st = (r >> 4) * 2 + (c >> 5), rr = r & 15, cc = c & 31, ob = rr * 64 + cc * 2; return st * 1024 + (ob ^ (((ob >> 9) & 1) << 5)); }
__host__ __device__ __forceinline__ void stage_rc(int b, int& R, int& C) { const int st = b / 1024, sb = b % 1024, swz = sb ^ (((sb >> 9) & 1) << 5); R = (st >> 1) * 16 + swz / 64; C = (st & 1) * 32 + (swz % 64) / 2; }

struct Unit { int pm, pn, e; };

struct DenseOrder {
    const char* A; const char* Bt; size_t tstep; int nM, nN, nwg, G, c;
    __device__ void init(const void* A_, const void* Bt_, int M, int N, int K, int G_, int c_) { A = (const char*)A_; Bt = (const char*)Bt_; tstep = (size_t)BM * K * 2; nM = M / BM; nN = N / BM; nwg = nM * nN; G = G_; c = c_; }
    __device__ bool next(int i, Unit& u) const {
        const long L = (long)i * G + c; if (L >= nwg) return false;
        int wgid = (int)L; { const int q = nwg / NXCD, r = nwg % NXCD, xcd = wgid % NXCD, off = wgid / NXCD; wgid = (xcd < r ? xcd * (q + 1) : r * (q + 1) + (xcd - r) * q) + off; }
        const int nig = WGM * nN, gid = wgid / nig, fm = gid * WGM, gsz = (nM - fm) < WGM ? (nM - fm) : WGM;
        u.pm = fm + ((wgid % nig) % gsz); u.pn = (wgid % nig) / gsz; u.e = 0; return true;
    }
    __device__ __forceinline__ const char* a_base(const Unit& u) const { return A + (size_t)u.pm * tstep; }
    __device__ __forceinline__ const char* b_base(const Unit& u) const { return Bt + (size_t)u.pn * tstep; }
};
struct MoeOrder {
    const char* A; const char* Bt; size_t tstep, estep; int ntot, G, c; const volatile LAS int* tstart;
    __device__ void init(const void* A_, const void* Bt_, int K, int N, int G_, int c_, const volatile LAS int* ts) { A = (const char*)A_; Bt = (const char*)Bt_; tstep = (size_t)BM * K * 2; estep = (size_t)N * K * 2; G = G_; c = c_; tstart = ts; ntot = ts[16]; }
    __device__ bool next(int i, Unit& u) const {
        const long L = (long)i * G + c; if (L >= 4L * ntot) return false;
        const int mt = (int)(L >> 2); u.pm = mt; u.pn = (int)(L & 3);
        int e = 0;
#pragma unroll
        for (int j = 1; j < 16; ++j) e += (mt >= tstart[j]) ? 1 : 0;
        u.e = e; return true;
    }
    __device__ __forceinline__ const char* a_base(const Unit& u) const { return A + (size_t)u.pm * tstep; }
    __device__ __forceinline__ const char* b_base(const Unit& u) const { return Bt + (size_t)u.e * estep + (size_t)u.pn * tstep; }
};

__device__ __forceinline__ unsigned cvt_pk_bf16(float lo, float hi) { unsigned r; asm volatile("v_cvt_pk_bf16_f32 %0, %1, %2" : "=v"(r) : "v"(lo), "v"(hi)); return r; }


struct EpiIn {
    bf16* P; const float* cs; float* ksum;
    __device__ __forceinline__ void operator()(const f32x4 (&acc)[2][2][4][2], const Unit& u, int wr, int wc, int fr, int fq) const {
        const int pn = u.pn, row0 = u.pm * BM + wr * 64 + fr, col0 = pn * BM + wc * 32 + 8 * fq;
        if (pn < 4) {
            const int dbase = 16 * (wc & 1) + 4 * fq;
            const float qs = (pn < 2) ? 0.125f : 1.0f;
            const bool isk = (pn >= 2);
            float ks[2][8];
#pragma unroll
            for (int b = 0; b < 2; ++b)
#pragma unroll
                for (int j = 0; j < 8; ++j) ks[b][j] = 0.f;
#pragma unroll
            for (int ai = 0; ai < 2; ++ai)
#pragma unroll
                for (int m = 0; m < 4; ++m) {
                    const int r = row0 + ai * HALF + m * 16;
                    const f32x4* cp = (const f32x4*)(cs + ((size_t)r * 32 + dbase) * 2);
                    const f32x4 cA = cp[0], cB = cp[1];
                    const float cc[4] = {cA[0], cA[2], cB[0], cB[2]}, ss[4] = {cA[1], cA[3], cB[1], cB[3]};
                    bf16* rowp = P + (size_t)r * NIN + col0;
#pragma unroll
                    for (int bj = 0; bj < 2; ++bj) {
                        const f32x4 x1 = acc[ai][bj][m][0], x2 = acc[ai][bj][m][1];
                        float o1[4], o2[4];
#pragma unroll
                        for (int j = 0; j < 4; ++j) { o1[j] = x1[j] * cc[j] - x2[j] * ss[j]; o2[j] = x2[j] * cc[j] + x1[j] * ss[j]; }
                        if (isk) {
#pragma unroll
                            for (int j = 0; j < 4; ++j) { ks[bj][j] += o1[j]; ks[bj][4 + j] += o2[j]; }
                        }
                        u32x4 w; w.x = cvt_pk_bf16(o1[0] * qs, o1[1] * qs); w.y = cvt_pk_bf16(o1[2] * qs, o1[3] * qs); w.z = cvt_pk_bf16(o2[0] * qs, o2[1] * qs); w.w = cvt_pk_bf16(o2[2] * qs, o2[3] * qs);
                        *(u32x4*)(rowp + bj * HALF) = w;
                    }
                }
            if (isk) {
#pragma unroll
                for (int b = 0; b < 2; ++b)
#pragma unroll
                    for (int j = 0; j < 8; ++j) {
                        float v = ks[b][j];
                        v += __shfl_xor(v, 1); v += __shfl_xor(v, 2); v += __shfl_xor(v, 4); v += __shfl_xor(v, 8);
                        ks[b][j] = v;
                    }
                if (fr == 0) {
#pragma unroll
                    for (int b = 0; b < 2; ++b) {
                        const int head = (pn - 2) * 4 + 2 * b + (wc >> 1);
                        float* kp = ksum + ((size_t)head * NBLK + u.pm) * HD + 32 * (wc & 1) + 8 * fq;
#pragma unroll
                        for (int j = 0; j < 8; ++j) atomicAdd(kp + j, ks[b][j]);
                    }
                }
            }
        } else {
            const bool act = (pn == 6 || pn == 7);
#pragma unroll
            for (int ai = 0; ai < 2; ++ai)
#pragma unroll
                for (int m = 0; m < 4; ++m) {
                    bf16* rowp = P + (size_t)(row0 + ai * HALF + m * 16) * NIN + col0;
#pragma unroll
                    for (int bj = 0; bj < 2; ++bj) {
                        f32x4 v0 = acc[ai][bj][m][0], v1 = acc[ai][bj][m][1];
                        if (act) {
#pragma unroll
                            for (int j = 0; j < 4; ++j) { v0[j] = gelu_tanh(v0[j]); v1[j] = gelu_tanh(v1[j]); }
                        }
                        u32x4 w; w.x = cvt_pk_bf16(v0[0], v0[1]); w.y = cvt_pk_bf16(v0[2], v0[3]); w.z = cvt_pk_bf16(v1[0], v1[1]); w.w = cvt_pk_bf16(v1[2], v1[3]);
                        *(u32x4*)(rowp + bj * HALF) = w;
                    }
                }
        }
    }
};
struct EpiOut {
    float* H; float* HO;
    __device__ __forceinline__ void operator()(const f32x4 (&acc)[2][2][4][2], const Unit& u, int wr, int wc, int fr, int fq) const {
        const int row0 = u.pm * BM + wr * 64 + fr, col0 = u.pn * BM + wc * 32 + 4 * fq;
#pragma unroll
        for (int ai = 0; ai < 2; ++ai)
#pragma unroll
            for (int m = 0; m < 4; ++m) {
                float* rowp = H + (size_t)(row0 + ai * HALF + m * 16) * D + col0;
#pragma unroll
                for (int bj = 0; bj < 2; ++bj)
#pragma unroll
                    for (int n = 0; n < 2; ++n) { f32x4* p = (f32x4*)(rowp + bj * HALF + n * 16); const f32x4 hv = *p; *(f32x4*)((float*)p + (HO - H)) = hv * ALPHA + acc[ai][bj][m][n]; }
            }
    }
};
struct EpiGU {
    bf16* ACT;
    __device__ __forceinline__ void operator()(const f32x4 (&acc)[2][2][4][2], const Unit& u, int wr, int wc, int fr, int fq) const {
        const int row0 = u.pm * BM + wr * 64 + fr, col0 = u.pn * 128 + wc * 16 + 4 * fq;
#pragma unroll
        for (int ai = 0; ai < 2; ++ai)
#pragma unroll
            for (int m = 0; m < 4; ++m) {
                bf16* rowp = ACT + (size_t)(row0 + ai * HALF + m * 16) * DE + col0;
#pragma unroll
                for (int bj = 0; bj < 2; ++bj) {
                    const f32x4 g = acc[ai][bj][m][0], up = acc[ai][bj][m][1];
                    float a[4];
#pragma unroll
                    for (int j = 0; j < 4; ++j) a[j] = g[j] * sigmoidf_(g[j]) * up[j];
                    u32x2 w; w.x = cvt_pk_bf16(a[0], a[1]); w.y = cvt_pk_bf16(a[2], a[3]);
                    *(u32x2*)(rowp + bj * 64) = w;
                }
            }
    }
};
struct EpiDown {
    bf16* Y; const int2* rowinfo;
    __device__ __forceinline__ void operator()(const f32x4 (&acc)[2][2][4][2], const Unit& u, int wr, int wc, int fr, int fq) const {
        const int row0 = u.pm * BM + wr * 64 + fr, col0 = u.pn * BM + wc * 32 + 8 * fq;
#pragma unroll
        for (int ai = 0; ai < 2; ++ai)
#pragma unroll
            for (int m = 0; m < 4; ++m) {
                const int2 ri = rowinfo[row0 + ai * HALF + m * 16];
                if (ri.x >= 0) {
                    const float gw = __builtin_bit_cast(float, ri.y);
                    bf16* rowp = Y + (size_t)ri.x * D + col0;
#pragma unroll
                    for (int bj = 0; bj < 2; ++bj) {
                        const f32x4 v0 = acc[ai][bj][m][0] * gw, v1 = acc[ai][bj][m][1] * gw;
                        u32x4 w; w.x = cvt_pk_bf16(v0[0], v0[1]); w.y = cvt_pk_bf16(v0[2], v0[3]); w.z = cvt_pk_bf16(v1[0], v1[1]); w.w = cvt_pk_bf16(v1[2], v1[3]);
                        *(u32x4*)(rowp + bj * HALF) = w;
                    }
                }
            }
    }
};

template <class Epi, class Sched, bool ALIGN_EPI, bool SP2>
__device__ __forceinline__ void gemm_phase(LAS unsigned char* lds, const int K, const Sched& S, const Epi& E) {
    int tid_ = threadIdx.x; asm volatile("" : "+v"(tid_));
    const int tid = tid_, wid = __builtin_amdgcn_readfirstlane(tid >> 6), lane = tid & 63, wr = wid >> 2, wc = wid & 3, fr = lane & 15, fq = lane >> 4;
    const int nt = K / BK;
    unsigned voffA[2], voffB[2];
#pragma unroll
    for (int i = 0; i < 2; ++i) { int R, C; stage_rc(tid * 16 + i * 8192, R, C); voffA[i] = (unsigned)(R * K + C) * 2u; voffB[i] = voffA[i]; }
    const size_t kstep = (size_t)(BK * 2);
    const size_t hstep = (size_t)HALF * K * 2;
    const unsigned ldsw = (unsigned)wid * 1024u;
    const int aoff = lds_byte(wr * 64 + fr, fq * 8), boff = lds_byte(wc * 32 + fr, fq * 8);
#define PG8_SA(b, h) (((b) * 2 + (h)) * HTB)
#define PG8_SB(b, h) ((4 + (b) * 2 + (h)) * HTB)
#define PG8_STAGE(bufoff, gbase, voff) do { _Pragma("unroll") for (int _i = 0; _i < 2; ++_i) \
        __builtin_amdgcn_global_load_lds((const unsigned*)((const char*)(gbase) + (voff)[_i]), (LAS unsigned*)(lds + (bufoff) + ldsw + _i * 8192), 16, 0, 0); } while (0)
#define PG8_LDA(dst, b, h) do { _Pragma("unroll") for (int m = 0; m < 4; ++m) _Pragma("unroll") for (int k = 0; k < 2; ++k) dst[m][k] = *(const LAS bf16x8*)(lds + PG8_SA(b, h) + aoff + m * 2048 + k * 1024); } while (0)
#define PG8_LDB(dst, b, h) do { _Pragma("unroll") for (int n = 0; n < 2; ++n) _Pragma("unroll") for (int k = 0; k < 2; ++k) dst[n][k] = *(const LAS bf16x8*)(lds + PG8_SB(b, h) + boff + n * 2048 + k * 1024); } while (0)
#define PG8_MMA(ai, bj, At, Bt) do { __builtin_amdgcn_s_setprio(1); _Pragma("unroll") for (int m = 0; m < 4; ++m) _Pragma("unroll") for (int n = 0; n < 2; ++n) _Pragma("unroll") for (int k = 0; k < 2; ++k) \
        acc[ai][bj][m][n] = __builtin_amdgcn_mfma_f32_16x16x32_bf16(Bt[n][k], At[m][k], acc[ai][bj][m][n], 0, 0, 0); __builtin_amdgcn_s_setprio(0); } while (0)
#define PG8_WAIT_V(n) asm volatile("s_waitcnt vmcnt(" #n ")" ::: "memory")
#define PG8_WAIT_L(n) asm volatile("s_waitcnt lgkmcnt(" #n ")" ::: "memory")
#define PG8_BAR __builtin_amdgcn_s_barrier()
#define PG8_SCHED __builtin_amdgcn_sched_barrier(0)
    Unit cur, nxt; int ui = 0;
    if (!S.next(0, cur)) return;
    f32x4 acc[2][2][4][2];
#pragma unroll
    for (int a = 0; a < 2; ++a)
#pragma unroll
        for (int b = 0; b < 2; ++b)
#pragma unroll
            for (int m = 0; m < 4; ++m)
#pragma unroll
                for (int n = 0; n < 2; ++n) acc[a][b][m][n] = (f32x4){0.f, 0.f, 0.f, 0.f};
    bf16x8 At[4][2], B0[2][2], B1[2][2];
    const char* cA = S.a_base(cur); const char* cB = S.b_base(cur);
    if constexpr (SP2) {
        PG8_STAGE(PG8_SB(0, 0), cB, voffB); PG8_STAGE(PG8_SB(0, 1), cB + hstep, voffB); PG8_STAGE(PG8_SA(0, 0), cA, voffA); PG8_STAGE(PG8_SA(0, 1), cA + hstep, voffA);
        if (wr == 1) PG8_BAR;
        PG8_WAIT_V(2); PG8_BAR;
        PG8_STAGE(PG8_SB(1, 0), cB + kstep, voffB); PG8_STAGE(PG8_SA(1, 0), cA + kstep, voffA); PG8_STAGE(PG8_SB(1, 1), cB + hstep + kstep, voffB);
        PG8_WAIT_V(6); PG8_BAR;
    } else {
        PG8_STAGE(PG8_SB(0, 0), cB, voffB); PG8_STAGE(PG8_SA(0, 0), cA, voffA); PG8_STAGE(PG8_SB(0, 1), cB + hstep, voffB); PG8_STAGE(PG8_SA(0, 1), cA + hstep, voffA);
        if (wr == 1) PG8_BAR;
        PG8_WAIT_V(4); PG8_BAR;
        PG8_STAGE(PG8_SB(1, 0), cB + kstep, voffB); PG8_STAGE(PG8_SA(1, 0), cA + kstep, voffA); PG8_STAGE(PG8_SB(1, 1), cB + hstep + kstep, voffB);
        PG8_WAIT_V(6); PG8_BAR;
    }
    for (;;) {
        const bool has_next = S.next(ui + 1, nxt);
        const char* nA = has_next ? S.a_base(nxt) : cA; const char* nB = has_next ? S.b_base(nxt) : cB;
        for (int t = 0; t < nt; t += 2) {
            const bool last = (t == nt - 2);
            const char* a1 = cA + (size_t)(t + 1) * kstep;
            const char* a2 = last ? nA : cA + (size_t)(t + 2) * kstep; const char* b2 = last ? nB : cB + (size_t)(t + 2) * kstep;
            const char* a3 = a2 + kstep; const char* b3 = b2 + kstep;
            if constexpr (SP2) {
            PG8_LDB(B0, 0, 0); PG8_LDB(B1, 0, 1); PG8_SCHED; PG8_LDA(At, 0, 0); PG8_STAGE(PG8_SA(1, 1), a1 + hstep, voffA);
            PG8_WAIT_V(8); PG8_WAIT_L(0); PG8_BAR; PG8_MMA(0, 0, At, B0); PG8_MMA(0, 1, At, B1); PG8_BAR; PG8_SCHED;
            PG8_LDA(At, 0, 1); PG8_STAGE(PG8_SB(0, 0), b2, voffB); PG8_STAGE(PG8_SB(0, 1), b2 + hstep, voffB); PG8_STAGE(PG8_SA(0, 0), a2, voffA);
            PG8_WAIT_V(8); PG8_WAIT_L(0); PG8_BAR; PG8_MMA(1, 0, At, B0); PG8_MMA(1, 1, At, B1); PG8_BAR; PG8_SCHED;
            PG8_LDB(B0, 1, 0); PG8_LDB(B1, 1, 1); PG8_SCHED; PG8_LDA(At, 1, 0); PG8_STAGE(PG8_SA(0, 1), a2 + hstep, voffA);
            PG8_WAIT_V(8); PG8_WAIT_L(0); PG8_BAR; PG8_MMA(0, 0, At, B0); PG8_MMA(0, 1, At, B1); PG8_BAR; PG8_SCHED;
            PG8_LDA(At, 1, 1); PG8_STAGE(PG8_SB(1, 0), b3, voffB); PG8_STAGE(PG8_SB(1, 1), b3 + hstep, voffB); PG8_STAGE(PG8_SA(1, 0), a3, voffA);
            PG8_WAIT_V(8); PG8_WAIT_L(0); PG8_BAR; PG8_MMA(1, 0, At, B0); PG8_MMA(1, 1, At, B1); PG8_BAR; PG8_SCHED;
            } else {
            PG8_LDB(B0, 0, 0); PG8_SCHED; PG8_LDA(At, 0, 0); PG8_STAGE(PG8_SA(1, 1), a1 + hstep, voffA);
            PG8_WAIT_L(8); PG8_BAR; PG8_WAIT_L(0); PG8_MMA(0, 0, At, B0); PG8_BAR; PG8_SCHED;
            PG8_LDB(B1, 0, 1); PG8_STAGE(PG8_SB(0, 0), b2, voffB);
            PG8_BAR; PG8_WAIT_L(0); PG8_MMA(0, 1, At, B1); PG8_BAR;
            PG8_LDA(At, 0, 1); PG8_STAGE(PG8_SA(0, 0), a2, voffA);
            PG8_BAR; PG8_WAIT_L(0); PG8_MMA(1, 0, At, B0); PG8_BAR; PG8_SCHED;
            PG8_STAGE(PG8_SB(0, 1), b2 + hstep, voffB);
            PG8_WAIT_V(6); PG8_BAR; PG8_MMA(1, 1, At, B1); PG8_BAR;
            PG8_LDB(B0, 1, 0); PG8_SCHED; PG8_LDA(At, 1, 0); PG8_STAGE(PG8_SA(0, 1), a2 + hstep, voffA);
            PG8_WAIT_L(8); PG8_BAR; PG8_WAIT_L(0); PG8_MMA(0, 0, At, B0); PG8_BAR; PG8_SCHED;
            PG8_LDB(B1, 1, 1); PG8_STAGE(PG8_SB(1, 0), b3, voffB);
            PG8_BAR; PG8_WAIT_L(0); PG8_MMA(0, 1, At, B1); PG8_BAR;
            PG8_LDA(At, 1, 1); PG8_STAGE(PG8_SA(1, 0), a3, voffA);
            PG8_BAR; PG8_WAIT_L(0); PG8_MMA(1, 0, At, B0); PG8_BAR; PG8_SCHED;
            PG8_STAGE(PG8_SB(1, 1), b3 + hstep, voffB);
            PG8_WAIT_V(6); PG8_BAR; PG8_MMA(1, 1, At, B1); PG8_BAR;
            }
        }
        if constexpr (ALIGN_EPI) { if (wr == 0) PG8_BAR; }
        E(acc, cur, wr, wc, fr, fq);
        if (!has_next) break;
#pragma unroll
        for (int a = 0; a < 2; ++a)
#pragma unroll
            for (int b = 0; b < 2; ++b)
#pragma unroll
                for (int m = 0; m < 4; ++m)
#pragma unroll
                    for (int n = 0; n < 2; ++n) acc[a][b][m][n] = (f32x4){0.f, 0.f, 0.f, 0.f};
        cur = nxt; cA = nA; cB = nB; ++ui;
        if constexpr (ALIGN_EPI) { if (wr == 1) PG8_BAR; }
    }
    PG8_WAIT_V(0);
    if constexpr (!ALIGN_EPI) { if (wr == 0) PG8_BAR; }
    PG8_BAR;
#undef PG8_SA
#undef PG8_SB
#undef PG8_STAGE
#undef PG8_LDA
#undef PG8_LDB
#undef PG8_MMA
#undef PG8_WAIT_V
#undef PG8_WAIT_L
#undef PG8_BAR
#undef PG8_SCHED
}
}

#define XB_TMO      128
#define XB_XCNT(j)  (256  + 64 * (j))
#define XB_XSUB(j)  (1280 + 64 * (j))
#define XB_XGEN(j)  (2304 + 64 * (j))
#define XB_TOP      3328
#define XB_TOPGEN   3392
#define XCD_BAR_WORDS 3456
#define XB_SPIN_CAP (1u << 18)
__device__ __forceinline__ unsigned xb_ld(unsigned* p)              { return __hip_atomic_load(p, __ATOMIC_RELAXED, __HIP_MEMORY_SCOPE_AGENT); }
__device__ __forceinline__ unsigned xb_add(unsigned* p, unsigned v) { return __hip_atomic_fetch_add(p, v, __ATOMIC_RELAXED, __HIP_MEMORY_SCOPE_AGENT); }
__device__ __forceinline__ unsigned xb_xcc_id() { return (unsigned)__builtin_amdgcn_s_getreg((3 << 11) | 20) & 0xFu; }
#define XB_SPIN(cond, bar) do { unsigned _sp = 0; while (cond) { __builtin_amdgcn_s_sleep(1); \
    if ((++_sp & 255u) == 0u) { if (xb_ld(&(bar)[XB_TMO])) break; if (_sp > XB_SPIN_CAP) { atomicAdd(&(bar)[XB_TMO], 1u); break; } } } } while (0)
struct XcdBarrier { unsigned* bar; unsigned x; volatile LAS unsigned* st; };
__device__ __forceinline__ XcdBarrier xcd_barrier_post(unsigned* bar, volatile LAS unsigned* st) {
    XcdBarrier b; b.bar = bar; b.x = xb_xcc_id(); b.st = st;
    if (threadIdx.x == 0) (void)xb_add(&bar[XB_XCNT(b.x)], 1u);
    return b;
}
__device__ __forceinline__ void xcd_barrier_complete(unsigned* bar, unsigned x, unsigned& nloc, unsigned& nx) {
    const unsigned G = gridDim.x * gridDim.y * gridDim.z;
    unsigned sum, cnt, mine, sp = 0u;
    for (;;) {
        sum = 0u; cnt = 0u; mine = 0u;
#pragma unroll
        for (unsigned j = 0; j < 16; ++j) { const unsigned c = xb_ld(&bar[XB_XCNT(j)]); sum += c; cnt += (c > 0u) ? 1u : 0u; mine = (j == x) ? c : mine; }
        if (sum == G) break;
        __builtin_amdgcn_s_sleep(1);
        if ((++sp & 255u) == 0u) { if (xb_ld(&bar[XB_TMO])) break; if (sp > XB_SPIN_CAP) { atomicAdd(&bar[XB_TMO], 1u); break; } }
    }
    nloc = mine > 0u ? mine : 1u; nx = cnt > 0u ? cnt : 1u;
}
template <bool FIRST>
__device__ __forceinline__ void xcd_barrier_t(const XcdBarrier& b) {
    asm volatile("s_waitcnt vmcnt(0)" ::: "memory");
    __syncthreads();
    if (threadIdx.x == 0) {
        unsigned* bar = b.bar; unsigned bx = b.x;
        asm volatile("" : "+s"(bar), "+s"(bx));
        __builtin_amdgcn_s_waitcnt(0);
        unsigned nloc = b.st[0], nx = b.st[1];
        if (FIRST) { xcd_barrier_complete(bar, bx, nloc, nx); b.st[0] = nloc; b.st[1] = nx; }
        const unsigned old = xb_add(&bar[XB_XSUB(bx)], 1u);
        const unsigned gen = old / nloc;
        if (old + 1u == (gen + 1u) * nloc) {
            __builtin_amdgcn_fence(__ATOMIC_RELEASE, "agent");
            asm volatile("s_waitcnt vmcnt(0)" ::: "memory");
            const unsigned og = xb_add(&bar[XB_TOP], 1u);
            const unsigned tg = og / nx;
            if (og + 1u == (tg + 1u) * nx) xb_add(&bar[XB_TOPGEN], 1u);
            else XB_SPIN(xb_ld(&bar[XB_TOPGEN]) == tg, bar);
            __builtin_amdgcn_fence(__ATOMIC_ACQUIRE, "agent");
            xb_add(&bar[XB_XGEN(bx)], 1u);
            asm volatile("s_waitcnt vmcnt(0)" ::: "memory");
        } else {
            XB_SPIN(xb_ld(&bar[XB_XGEN(bx)]) == gen, bar);
            __builtin_amdgcn_fence(__ATOMIC_ACQUIRE, "agent");
            asm volatile("s_waitcnt vmcnt(0)" ::: "memory");
        }
    }
    __syncthreads();
}

struct Args {
    const float* x; const float* ln_in_g; const float* ln_in_b; const float* w_in; const float* w_out; const float* sg_ln_g; const float* sg_ln_b; const float* sg_w; const float* sg_b;
    const float* conv_w; const float* conv_b; const float* conv_ln_g; const float* conv_ln_b; const float* ln_mix_g; const float* ln_mix_b; const float* w_router; const float* router_bias;
    const float* w_gate; const float* w_up; const float* w_down; const float* ln_ffn_g; const float* ln_ffn_b;
    float* out; unsigned char* ws;
    int mode, pad;
};
struct Ctx { LAS unsigned char* lds; int tid, lane, wave, vcu, G; };
constexpr int ARGS_OFF = MISC_OFF + 512;
__device__ __forceinline__ LAS unsigned char* lds_opaque(LAS unsigned char* p) { asm volatile("" : "+s"(p)); return p; }
template <class T> __device__ __forceinline__ T lds_arg(const Ctx& C, int byteoff) {
    volatile LAS unsigned* p = (volatile LAS unsigned*)(lds_opaque(C.lds) + ARGS_OFF + byteoff);
    const unsigned lo = __builtin_amdgcn_readfirstlane(p[0]), hi = __builtin_amdgcn_readfirstlane(p[1]);
    return (T)(((unsigned long long)hi << 32) | lo);
}
#define ARG(field) lds_arg<decltype(Args::field)>(C, (int)__builtin_offsetof(Args, field))
#define LOADARG(a, field) (a).field = ARG(field)

template <class RowMap>
__device__ __forceinline__ void transpose_item(const float* W, int K, int N, bf16* WT, LAS float* scr, int item, int lane, const RowMap& rowmap) {
    const int nblk = N / 64, kb = item / nblk, nb = item % nblk, k0 = 64 * kb, n0 = 64 * nb;
    const int lr = lane >> 4, lc = (lane & 15) * 4;
    f32x4 v[16];
#pragma unroll
    for (int i = 0; i < 16; ++i) v[i] = *(const f32x4*)(W + (size_t)(k0 + 4 * i + lr) * N + n0 + lc);
#pragma unroll
    for (int i = 0; i < 16; ++i) { const int kk = 4 * i + lr; *(LAS f32x4*)(scr + kk * 64 + (lc ^ (8 * ((kk >> 3) & 3)))) = v[i]; }
    LDS_WAIT(); asm volatile("" ::: "memory");
    const int c = lane & 7, sw = 8 * (c & 3);
#pragma unroll
    for (int j = 0; j < 8; ++j) { const int n = (lane >> 3) + 8 * j; const LAS float* sp = scr + (8 * c) * 64 + (n ^ sw);
        u32x4 o; o.x = pk2(sp[0], sp[64]); o.y = pk2(sp[128], sp[192]); o.z = pk2(sp[256], sp[320]); o.w = pk2(sp[384], sp[448]);
        *(GAS u32x4*)(WT + (size_t)rowmap(n0 + n) * K + k0 + 8 * c) = o; }
    LDS_WAIT(); asm volatile("" ::: "memory");
}
struct MapIn { __device__ __forceinline__ int operator()(int n) const {
    if (n < 1024) return (n & ~48) | ((n & 16) << 1) | ((n & 32) >> 1);
    return (n & ~31) | ((n & 4) << 2) | ((n & 24) >> 1) | (n & 3); } };
struct MapId { __device__ __forceinline__ int operator()(int n) const { return n; } };
struct MapPerm { __device__ __forceinline__ int operator()(int n) const { return (n & ~31) | ((n & 4) << 2) | ((n & 24) >> 1) | (n & 3); } };
struct MapGU { int which; __device__ __forceinline__ int operator()(int c) const {
    return ((c >> 7) << 8) | (((c >> 6) & 1) << 7) | (((c >> 4) & 3) << 5) | (which << 4) | (c & 15); } };

__device__ __forceinline__ void ln_row(f32x4 (&v)[4], const float* g, const float* b, int lane, float eps) {
    float s = 0.f;
#pragma unroll
    for (int j = 0; j < 4; ++j) s += (v[j][0] + v[j][1]) + (v[j][2] + v[j][3]);
    const float mean = wave_sum(s) * (1.f / D); float s2 = 0.f;
#pragma unroll
    for (int j = 0; j < 4; ++j) { v[j] = v[j] - mean; s2 += (v[j][0] * v[j][0] + v[j][1] * v[j][1]) + (v[j][2] * v[j][2] + v[j][3] * v[j][3]); }
    const float rstd = 1.f / sqrtf(wave_sum(s2) * (1.f / D) + eps);
#pragma unroll
    for (int j = 0; j < 4; ++j) { const f32x4 gg = *(const f32x4*)(g + 4 * lane + 256 * j), bb = *(const f32x4*)(b + 4 * lane + 256 * j); v[j] = v[j] * rstd * gg + bb; }
}
__device__ __forceinline__ void store_row(const f32x4 (&v)[4], float* orow, bf16* brow, int lane) {
#pragma unroll
    for (int j = 0; j < 4; ++j) {
        *(f32x4*)(orow + 4 * lane + 256 * j) = v[j];
        u32x2 w; w.x = pk2(v[j][0], v[j][1]); w.y = pk2(v[j][2], v[j][3]);
        *(u32x2*)(brow + 4 * lane + 256 * j) = w;
    }
}

__device__ __forceinline__ void p0_prologue(const Ctx& C0) {
    Ctx C = C0; asm volatile("" : "+v"(C.tid), "+v"(C.lane), "+s"(C.wave), "+s"(C.vcu), "+s"(C.G), "+s"(C.lds));
    Args a; LOADARG(a, ws); LOADARG(a, w_in); LOADARG(a, w_out); LOADARG(a, sg_w); LOADARG(a, x); LOADARG(a, ln_in_g); LOADARG(a, ln_in_b); LOADARG(a, out);
    LAS float* scr = (LAS float*)(C.lds + C.wave * 16384);
    const int gw = C.vcu * NWAVES + C.wave, NGW = C.G * NWAVES;
    unsigned char* ws = a.ws;
    constexpr int I_IN = (D / 64) * (NIN / 64), I_OUT = (D / 64) * (D / 64);
    for (int it = gw; it < DEPTH * (I_IN + I_OUT); it += NGW) {
        const int l = it / (I_IN + I_OUT); int r = it % (I_IN + I_OUT);
        if (r < I_IN) transpose_item(a.w_in + (size_t)l * D * NIN, D, NIN, (bf16*)(ws + WS_WIN) + (size_t)l * NIN * D, scr, r, C.lane, MapIn{});
        else transpose_item(a.w_out + (size_t)l * D * D, D, D, (bf16*)(ws + WS_WOUT) + (size_t)l * D * D, scr, r - I_IN, C.lane, MapId{});
    }
    const int gt = C.vcu * (NWAVES * 64) + C.tid, NGT = C.G * NWAVES * 64;
    float2* cs = (float2*)(ws + WS_CS);
    for (int i = gt; i < S * 32; i += NGT) {
        const int s = i >> 5, f = i & 31;
        const float inv = powf(10000.0f, -(float)f / 32.0f);
        const float ang = (float)s * inv;
        cs[i] = make_float2(cosf(ang), sinf(ang));
    }
    bf16* wsg = (bf16*)(ws + WS_WSG);
    for (int i = gt; i < DEPTH * 4 * 128 * 128; i += NGT) { const int t = (i >> 7) & 127, s = i & 127; wsg[i] = (bf16)((s <= t) ? f2bf(a.sg_w[i]) : 0u); }
    bf16* hb = (bf16*)(ws + WS_HB);
    for (int m = gw; m < S; m += NGW) {
        f32x4 v[4];
#pragma unroll
        for (int j = 0; j < 4; ++j) v[j] = *(const f32x4*)(a.x + (size_t)m * D + 4 * C.lane + 256 * j);
        ln_row(v, a.ln_in_g, a.ln_in_b, C.lane, LN_EPS);
        store_row(v, a.out + (size_t)m * D, hb + (size_t)m * D, C.lane);
    }
}

__device__ __forceinline__ unsigned k_off(int row, int ch) { return (unsigned)(row * 128 + 16 * (ch ^ (row & 7))); }
__device__ __forceinline__ unsigned v_off(int row, int ch) { return (unsigned)(row * 128 + 16 * (ch ^ (((row >> 1) & 3) << 1))); }

template <int KS>
__device__ __forceinline__ void tr8(u32x2 (&r)[8], const unsigned (&va)[4]) {
    asm volatile(
        "ds_read_b64_tr_b16 %0, %8 offset:%12\n\t"
        "ds_read_b64_tr_b16 %1, %9 offset:%12\n\t"
        "ds_read_b64_tr_b16 %2, %10 offset:%12\n\t"
        "ds_read_b64_tr_b16 %3, %11 offset:%12\n\t"
        "ds_read_b64_tr_b16 %4, %8 offset:%13\n\t"
        "ds_read_b64_tr_b16 %5, %9 offset:%13\n\t"
        "ds_read_b64_tr_b16 %6, %10 offset:%13\n\t"
        "ds_read_b64_tr_b16 %7, %11 offset:%13\n\t"
        "s_waitcnt lgkmcnt(0)"
        : "=&v"(r[0]), "=&v"(r[1]), "=&v"(r[2]), "=&v"(r[3]), "=&v"(r[4]), "=&v"(r[5]), "=&v"(r[6]), "=&v"(r[7])
        : "v"(va[0]), "v"(va[1]), "v"(va[2]), "v"(va[3]), "i"(KS * 4096), "i"(KS * 4096 + 2048)
        : "memory");
}

struct AttnOut { f32x4 o[4]; float m, l; };

template <bool MASK>
__device__ __forceinline__ void attn_core(AttnOut& R, LAS unsigned char* Ks, LAS unsigned char* Vs, const bf16x8 (&qf)[2], int nct, int qoff, int lane) {
    const int fr = lane & 15, fq = lane >> 4;
    f32x4 sacc[16];
#pragma unroll
    for (int c = 0; c < 16; ++c) sacc[c] = (f32x4){0.f, 0.f, 0.f, 0.f};
#pragma unroll
    for (int c = 0; c < 16; ++c) {
        if (c < nct) {
#pragma unroll
            for (int ks = 0; ks < 2; ++ks) {
                const bf16x8 kf = *(const LAS bf16x8*)(Ks + k_off(16 * c + fr, 4 * ks + fq));
                sacc[c] = __builtin_amdgcn_mfma_f32_16x16x32_bf16(kf, qf[ks], sacc[c], 0, 0, 0);
            }
        }
    }
    float mx = -1e30f;
#pragma unroll
    for (int c = 0; c < 16; ++c) {
        if (c < nct) {
#pragma unroll
            for (int j = 0; j < 4; ++j) {
                if (MASK) { if (16 * c + 4 * fq + j > qoff) sacc[c][j] = -1e30f; }
                mx = fmaxf(mx, sacc[c][j]);
            }
        }
    }
    mx = fmaxf(mx, __shfl_xor(mx, 16)); mx = fmaxf(mx, __shfl_xor(mx, 32));
    float lsum = 0.f;
    const float mb = mx * LOG2E;
#pragma unroll
    for (int c = 0; c < 16; ++c) {
        if (c < nct) {
#pragma unroll
            for (int j = 0; j < 4; ++j) { const float p = fast_exp2(sacc[c][j] * LOG2E - mb); sacc[c][j] = p; lsum += p; }
        }
    }
    lsum += __shfl_xor(lsum, 16); lsum += __shfl_xor(lsum, 32);
    const int q4 = (lane & 15) >> 2, p4 = lane & 3;
    unsigned va[4];
    {
        const int row = 4 * fq + q4;
        const unsigned vbase = (unsigned)(size_t)Vs;
#pragma unroll
        for (int c = 0; c < 4; ++c) va[c] = vbase + v_off(row, 2 * c + (p4 >> 1)) + 8 * (p4 & 1);
    }
    f32x4 oacc[4];
#pragma unroll
    for (int c = 0; c < 4; ++c) oacc[c] = (f32x4){0.f, 0.f, 0.f, 0.f};
#define ATT_PV(KS) do { if (2 * (KS) < nct) { u32x2 vr[8]; tr8<KS>(vr, va); __builtin_amdgcn_sched_barrier(0); \
        u32x4 pw; pw.x = pg8::cvt_pk_bf16(sacc[2 * (KS)][0], sacc[2 * (KS)][1]); pw.y = pg8::cvt_pk_bf16(sacc[2 * (KS)][2], sacc[2 * (KS)][3]); \
        pw.z = pg8::cvt_pk_bf16(sacc[2 * (KS) + 1][0], sacc[2 * (KS) + 1][1]); pw.w = pg8::cvt_pk_bf16(sacc[2 * (KS) + 1][2], sacc[2 * (KS) + 1][3]); \
        const bf16x8 pf = __builtin_bit_cast(bf16x8, pw); \
        _Pragma("unroll") for (int c = 0; c < 4; ++c) { u32x4 vw; vw.x = vr[c].x; vw.y = vr[c].y; vw.z = vr[4 + c].x; vw.w = vr[4 + c].y; \
            oacc[c] = __builtin_amdgcn_mfma_f32_16x16x32_bf16(__builtin_bit_cast(bf16x8, vw), pf, oacc[c], 0, 0, 0); } } } while (0)
    ATT_PV(0); ATT_PV(1); ATT_PV(2); ATT_PV(3); ATT_PV(4); ATT_PV(5); ATT_PV(6); ATT_PV(7);
#undef ATT_PV
#pragma unroll
    for (int c = 0; c < 4; ++c) R.o[c] = oacc[c];
    R.m = mx; R.l = lsum;
}

__device__ __forceinline__ void stage_kv(const Ctx& C, const bf16* P, int blk, int h, int nrows, LAS unsigned char* Ks, LAS unsigned char* Vs) {
    for (int i = C.tid; i < nrows * 8; i += NWAVES * 64) {
        const int row = i >> 3, ch = i & 7;
        const bf16* src = P + (size_t)(blk * 256 + row) * NIN + h * HD + ch * 8;
        const u32x4 kv = *(const u32x4*)(src + K_OFF), vv = *(const u32x4*)(src + V_OFF);
        *(LAS u32x4*)(Ks + k_off(row, ch)) = kv;
        *(LAS u32x4*)(Vs + v_off(row, ch)) = vv;
    }
}

__device__ __forceinline__ void pb_gating(const Ctx& C0, int l, int item, bool dry = false) {
    Ctx C = C0; asm volatile("" : "+v"(C.tid), "+v"(C.lane), "+s"(C.wave), "+s"(C.vcu), "+s"(C.G), "+s"(C.lds));
    Args a; LOADARG(a, ws);
    const int h = item & 7, grp = item >> 3, tok = grp * 512 + C.tid, own = tok >> 8;
    unsigned char* ws = a.ws;
    const bf16* P = (const bf16*)(ws + WS_P);
    LAS float* km = (LAS float*)C.lds;
    LAS unsigned* cntL = (LAS unsigned*)(C.lds + 16384);
    LAS unsigned* baseL = (LAS unsigned*)(C.lds + 16384 + 256);
    const float* ksum = (const float*)(ws + WS_CTL) + CW_KMEAN + (size_t)l * (NH * NBLK * HD) + (size_t)h * NBLK * HD;
    for (int i = C.tid; i < NBLK * HD; i += NWAVES * 64) km[i] = ksum[i] * (1.0f / 256.0f);
    if (C.tid < 64) cntL[C.tid] = 0u;
    __syncthreads();
    float q[64];
    {
        const u32x4* qp = (const u32x4*)(P + (size_t)tok * NIN + Q_OFF + h * HD);
#pragma unroll
        for (int c = 0; c < 8; ++c) { const u32x4 w = qp[c]; q[8 * c + 0] = bflo(w.x); q[8 * c + 1] = bfhi(w.x); q[8 * c + 2] = bflo(w.y); q[8 * c + 3] = bfhi(w.y); q[8 * c + 4] = bflo(w.z); q[8 * c + 5] = bfhi(w.z); q[8 * c + 6] = bflo(w.w); q[8 * c + 7] = bfhi(w.w); }
    }
    float v0 = -3e38f, v1 = -3e38f, v2 = -3e38f; int i0 = 0, i1 = 0, i2 = 0;
    const int ownu = __builtin_amdgcn_readfirstlane(own);
    for (int n = 0; n < ownu; ++n) {
        const LAS f32x4* kr = (const LAS f32x4*)(km + n * 64);
        float g0 = 0.f, g1 = 0.f, g2 = 0.f, g3 = 0.f;
#pragma unroll
        for (int c = 0; c < 16; ++c) { const f32x4 kv = kr[c]; g0 += q[4 * c] * kv[0]; g1 += q[4 * c + 1] * kv[1]; g2 += q[4 * c + 2] * kv[2]; g3 += q[4 * c + 3] * kv[3]; }
        const float g = (g0 + g1) + (g2 + g3);
        if (g > v0) { v2 = v1; i2 = i1; v1 = v0; i1 = i0; v0 = g; i0 = n; }
        else if (g > v1) { v2 = v1; i2 = i1; v1 = g; i1 = n; }
        else if (g > v2) { v2 = g; i2 = n; }
    }
    if (dry) { asm volatile("" :: "v"(i0), "v"(i1), "v"(i2)); __syncthreads(); return; }
    const int nsel = own < 3 ? own : 3;
    unsigned lp0 = 0, lp1 = 0, lp2 = 0;
    if (nsel > 0) lp0 = __hip_atomic_fetch_add(&cntL[i0], 1u, __ATOMIC_RELAXED, __HIP_MEMORY_SCOPE_WORKGROUP);
    if (nsel > 1) lp1 = __hip_atomic_fetch_add(&cntL[i1], 1u, __ATOMIC_RELAXED, __HIP_MEMORY_SCOPE_WORKGROUP);
    if (nsel > 2) lp2 = __hip_atomic_fetch_add(&cntL[i2], 1u, __ATOMIC_RELAXED, __HIP_MEMORY_SCOPE_WORKGROUP);
    __syncthreads();
    unsigned* acnt = (unsigned*)(ws + WS_CTL) + CW_ACNT + l * 512 + h * 64;
    if (C.tid < 64) { const unsigned c = cntL[C.tid]; baseL[C.tid] = c ? atomicAdd(&acnt[C.tid], c) : 0u; }
    __syncthreads();
    unsigned short* lists = (unsigned short*)(ws + WS_LISTS) + (size_t)h * NBLK * S;
    if (nsel > 0) lists[(size_t)i0 * S + baseL[i0] + lp0] = (unsigned short)(tok | (0 << 14));
    if (nsel > 1) lists[(size_t)i1 * S + baseL[i1] + lp1] = (unsigned short)(tok | (1 << 14));
    if (nsel > 2) lists[(size_t)i2 * S + baseL[i2] + lp2] = (unsigned short)(tok | (2 << 14));
    __syncthreads();
}

__device__ __forceinline__ unsigned sg_off(int row, int ch) { return (unsigned)(row * 512 + 16 * (ch ^ (((row & 3) | (((row >> 3) & 1) << 2)) << 1))); }
template <int KS>
__device__ __forceinline__ void tr2(u32x2& r0, u32x2& r1, unsigned addr) {
    asm volatile("ds_read_b64_tr_b16 %0, %2 offset:%3\n\tds_read_b64_tr_b16 %1, %2 offset:%4\n\ts_waitcnt lgkmcnt(0)"
                 : "=&v"(r0), "=&v"(r1) : "v"(addr), "i"(KS * 32 * 512), "i"(KS * 32 * 512 + 4 * 512) : "memory");
}
__device__ __forceinline__ void pb_sg(const Ctx& C0, int l, int chunk) {
    Ctx C = C0; asm volatile("" : "+v"(C.tid), "+v"(C.lane), "+s"(C.wave), "+s"(C.vcu), "+s"(C.G), "+s"(C.lds));
    Args a; LOADARG(a, ws); LOADARG(a, sg_ln_g); LOADARG(a, sg_ln_b); LOADARG(a, sg_b);
    unsigned char* ws = a.ws;
    const bf16* P = (const bf16*)(ws + WS_P);
    bf16* mix = (bf16*)(ws + WS_MIXIN);
    LAS unsigned char* vt = C.lds;
    const float* lg = a.sg_ln_g + l * SGW; const float* lb = a.sg_ln_b + l * SGW;
    for (int s = C.wave; s < 128; s += NWAVES) {
        const int tok = chunk * 128 + s;
        const u32x2 w = *(const u32x2*)(P + (size_t)tok * NIN + SGV_OFF + 4 * C.lane);
        float x[4] = {bflo(w.x), bfhi(w.x), bflo(w.y), bfhi(w.y)};
        const float mean = wave_sum((x[0] + x[1]) + (x[2] + x[3])) * (1.0f / SGW);
        float q = 0.f;
#pragma unroll
        for (int j = 0; j < 4; ++j) { x[j] -= mean; q += x[j] * x[j]; }
        const float rstd = 1.0f / sqrtf(wave_sum(q) * (1.0f / SGW) + LN_EPS);
        const f32x4 gg = *(const f32x4*)(lg + 4 * C.lane), bb = *(const f32x4*)(lb + 4 * C.lane);
        u32x2 o; o.x = pk2(x[0] * rstd * gg[0] + bb[0], x[1] * rstd * gg[1] + bb[1]); o.y = pk2(x[2] * rstd * gg[2] + bb[2], x[3] * rstd * gg[3] + bb[3]);
        *(LAS u32x2*)(vt + sg_off(s, C.lane >> 1) + 8 * (C.lane & 1)) = o;
    }
    __syncthreads();
    const int fr = C.lane & 15, fq = C.lane >> 4, q4 = fr >> 2, p4 = C.lane & 3, w = C.wave;
    const bf16* wsg = (const bf16*)(ws + WS_WSG) + (size_t)l * 4 * 128 * 128;
    const int nks = (16 * w + 15) / 32 + 1;
    f32x4 acc[4][4];
#pragma unroll
    for (int g = 0; g < 4; ++g)
#pragma unroll
        for (int c = 0; c < 4; ++c) acc[g][c] = (f32x4){0.f, 0.f, 0.f, 0.f};
    const unsigned vbase = (unsigned)(size_t)vt;
#define SG_STEP(KS) do { if ((KS) < nks) { _Pragma("unroll") for (int g = 0; g < 4; ++g) { \
        const bf16x8 wf = *(const bf16x8*)(wsg + ((size_t)g * 128 + 16 * w + fr) * 128 + 32 * (KS) + 8 * fq); \
        _Pragma("unroll") for (int c = 0; c < 4; ++c) { const int cc = 4 * g + c; u32x2 r0, r1; \
            tr2<KS>(r0, r1, vbase + sg_off(8 * fq + q4, 2 * cc + (p4 >> 1)) + 8 * (p4 & 1)); __builtin_amdgcn_sched_barrier(0); \
            u32x4 vw; vw.x = r0.x; vw.y = r0.y; vw.z = r1.x; vw.w = r1.y; \
            acc[g][c] = __builtin_amdgcn_mfma_f32_16x16x32_bf16(__builtin_bit_cast(bf16x8, vw), wf, acc[g][c], 0, 0, 0); } } } } while (0)
    SG_STEP(0); SG_STEP(1); SG_STEP(2); SG_STEP(3);
#undef SG_STEP
    const int t = 16 * w + fr, tok = chunk * 128 + t;
#pragma unroll
    for (int g = 0; g < 4; ++g) {
        const float bs = a.sg_b[(l * 4 + g) * 128 + t];
#pragma unroll
        for (int c = 0; c < 4; ++c) {
            const int d = 64 * g + 16 * c + 4 * fq;
            const u32x2 uw = *(const u32x2*)(P + (size_t)tok * NIN + SGU_OFF + d);
            u32x2 o; o.x = pk2(bflo(uw.x) * (acc[g][c][0] + bs), bfhi(uw.x) * (acc[g][c][1] + bs)); o.y = pk2(bflo(uw.y) * (acc[g][c][2] + bs), bfhi(uw.y) * (acc[g][c][3] + bs));
            *(u32x2*)(mix + (size_t)tok * D + 512 + d) = o;
        }
    }
    __syncthreads();
}

__device__ __forceinline__ void pb_conv(const Ctx& C0, int l, int item) {
    Ctx C = C0; asm volatile("" : "+v"(C.tid), "+v"(C.lane), "+s"(C.wave), "+s"(C.vcu), "+s"(C.G), "+s"(C.lds));
    Args a; LOADARG(a, ws); LOADARG(a, conv_w); LOADARG(a, conv_b); LOADARG(a, conv_ln_g); LOADARG(a, conv_ln_b);
    unsigned char* ws = a.ws;
    const bf16* P = (const bf16*)(ws + WS_P);
    bf16* mix = (bf16*)(ws + WS_MIXIN);
    LAS float* hb = (LAS float*)C.lds;
    const int t0 = item * 64;
    for (int i = C.tid; i < 94 * 32; i += NWAVES * 64) {
        const int r = i >> 5, ch = i & 31, tok = t0 - 30 + r;
        f32x4 o0 = (f32x4){0.f, 0.f, 0.f, 0.f}, o1 = o0;
        if (tok >= 0) {
            const u32x4 aw = *(const u32x4*)(P + (size_t)tok * NIN + CA_OFF + 8 * ch), gw = *(const u32x4*)(P + (size_t)tok * NIN + CG_OFF + 8 * ch);
            o0[0] = bflo(aw.x) * sigmoidf_(bflo(gw.x)); o0[1] = bfhi(aw.x) * sigmoidf_(bfhi(gw.x)); o0[2] = bflo(aw.y) * sigmoidf_(bflo(gw.y)); o0[3] = bfhi(aw.y) * sigmoidf_(bfhi(gw.y));
            o1[0] = bflo(aw.z) * sigmoidf_(bflo(gw.z)); o1[1] = bfhi(aw.z) * sigmoidf_(bfhi(gw.z)); o1[2] = bflo(aw.w) * sigmoidf_(bflo(gw.w)); o1[3] = bfhi(aw.w) * sigmoidf_(bfhi(gw.w));
        }
        *(LAS f32x4*)(hb + r * 256 + 8 * ch) = o0; *(LAS f32x4*)(hb + r * 256 + 8 * ch + 4) = o1;
    }
    __syncthreads();
    const int c = C.tid & 255, half = C.tid >> 8;
    float wt[TAPS];
#pragma unroll
    for (int j = 0; j < TAPS; ++j) wt[j] = a.conv_w[((size_t)l * TAPS + j) * CVW + c];
    const float bias = a.conv_b[l * CVW + c];
    float outv[32];
#pragma unroll
    for (int gI = 0; gI < 8; ++gI) {
        const int tb = half * 32 + gI * 4;
        float win[34];
#pragma unroll
        for (int j = 0; j < 34; ++j) win[j] = hb[(tb + j) * 256 + c];
#pragma unroll
        for (int o = 0; o < 4; ++o) {
            float s = bias;
#pragma unroll
            for (int j = 0; j < TAPS; ++j) s += wt[j] * win[o + j];
            outv[gI * 4 + o] = s;
        }
    }
    __syncthreads();
#pragma unroll
    for (int i = 0; i < 32; ++i) hb[(half * 32 + i) * 256 + c] = outv[i];
    __syncthreads();
    const float* lg = a.conv_ln_g + l * CVW; const float* lb = a.conv_ln_b + l * CVW;
    for (int s = C.wave; s < 64; s += NWAVES) {
        f32x4 x = *(const LAS f32x4*)(hb + s * 256 + 4 * C.lane);
        const float mean = wave_sum((x[0] + x[1]) + (x[2] + x[3])) * (1.0f / CVW);
        x = x - mean;
        const float rstd = 1.0f / sqrtf(wave_sum((x[0] * x[0] + x[1] * x[1]) + (x[2] * x[2] + x[3] * x[3])) * (1.0f / CVW) + LN_EPS);
        const f32x4 gg = *(const f32x4*)(lg + 4 * C.lane), bb = *(const f32x4*)(lb + 4 * C.lane);
        f32x4 y = x * rstd * gg + bb;
#pragma unroll
        for (int j = 0; j < 4; ++j) y[j] = y[j] * sigmoidf_(y[j]);
        u32x2 o; o.x = pk2(y[0], y[1]); o.y = pk2(y[2], y[3]);
        *(u32x2*)(mix + (size_t)(t0 + s) * D + 768 + 4 * C.lane) = o;
    }
    __syncthreads();
}

__device__ __forceinline__ void pc_selattn(const Ctx& C0, int l) {
    Ctx C = C0; asm volatile("" : "+v"(C.tid), "+v"(C.lane), "+s"(C.wave), "+s"(C.vcu), "+s"(C.G), "+s"(C.lds));
    Args a; LOADARG(a, ws);
    unsigned char* ws = a.ws;
    const bf16* P = (const bf16*)(ws + WS_P);
    LAS unsigned char* Ks = C.lds; LAS unsigned char* Vs = C.lds + 32768;
    LAS int* pref = (LAS int*)(C.lds + 65536);
    const unsigned* acnt = (const unsigned*)(ws + WS_CTL) + CW_ACNT + l * 512;
    LAS int* nt_ = (LAS int*)(C.lds + 65536 + 4096);
    nt_[C.tid] = (int)((__hip_atomic_load(acnt + C.tid, RLX_AGENT) + 127u) >> 7);
    __syncthreads();
    if (C.tid == 0) { int s = 0; for (int i = 0; i < 512; ++i) { pref[i] = s; s += nt_[i]; } pref[512] = s; }
    __syncthreads();
    const int total = pref[512];
    bf16* PO = (bf16*)(ws + WS_PARTO); float2* PML = (float2*)(ws + WS_PARTML);
    const unsigned short* lists = (const unsigned short*)(ws + WS_LISTS);
    const int fr = C.lane & 15, fq = C.lane >> 4;
    LAS int* cntl = (LAS int*)(C.lds + 65536 + 8192);
    cntl[C.tid] = (int)__hip_atomic_load(acnt + C.tid, RLX_AGENT);
    __syncthreads();
    int curpair = -1;
    const int per = (total + C.G - 1) / C.G, T0 = C.vcu * per, T1 = (T0 + per < total) ? T0 + per : total;
#define PC_TILE(T_, pair_, idx_, cnt_) do { int lo_ = 0, hi_ = 511; while (lo_ < hi_) { const int mid_ = (lo_ + hi_ + 1) >> 1; if (pref[mid_] <= (T_)) lo_ = mid_; else hi_ = mid_ - 1; } \
        pair_ = lo_; idx_ = ((T_) - pref[lo_]) * 128 + 16 * C.wave + fr; cnt_ = cntl[lo_]; } while (0)
#define PC_ENT(ent_, T_) do { ent_ = 0u; if ((T_) < T1) { int p_, i_, c_; PC_TILE(T_, p_, i_, c_); if (i_ < c_) ent_ = 0x10000u | (unsigned)lists[(size_t)p_ * S + i_]; } } while (0)
#define PC_Q(q_, ent_, T_) do { int p_ = 0, i_, c_; if ((T_) < T1) PC_TILE(T_, p_, i_, c_); const bf16* qp_ = P + (size_t)((ent_) & 0x3fff) * NIN + Q_OFF + (p_ >> 6) * HD + 8 * fq; \
        q_[0] = *(const bf16x8*)qp_; q_[1] = *(const bf16x8*)(qp_ + 32); } while (0)
    unsigned e1, e2; bf16x8 q1[2];
    PC_ENT(e1, T0); PC_ENT(e2, T0 + 1); PC_Q(q1, e1, T0);
    for (int T = T0; T < T1; ++T) {
        int pair, idx, cnt; PC_TILE(T, pair, idx, cnt);
        const int h = pair >> 6, n = pair & 63;
        const unsigned ent = e1; bf16x8 qf[2] = {q1[0], q1[1]};
        e1 = e2; PC_Q(q1, e1, T + 1); PC_ENT(e2, T + 2);
        if (pair != curpair) { __syncthreads(); stage_kv(C, P, n, h, 256, Ks, Vs); __syncthreads(); curpair = pair; }
        const bool valid = (ent & 0x10000u) != 0u;
        const int tok = ent & 0x3fff, rank = (ent >> 14) & 3;
        AttnOut R;
        attn_core<false>(R, Ks, Vs, qf, 16, 0, C.lane);
        if (valid) {
            const float inv = 1.0f / R.l;
            bf16* op = PO + (((size_t)rank * S + tok) * NH + h) * HD + 4 * fq;
#pragma unroll
            for (int c = 0; c < 4; ++c) { u32x2 o; o.x = pk2(R.o[c][0] * inv, R.o[c][1] * inv); o.y = pk2(R.o[c][2] * inv, R.o[c][3] * inv); *(u32x2*)(op + 16 * c) = o; }
            if (fq == 0) PML[((size_t)rank * S + tok) * NH + h] = make_float2(R.m, R.l);
        }
    }
#undef PC_TILE
#undef PC_ENT
#undef PC_Q
    __syncthreads();
}

__device__ __forceinline__ void pd_ownattn(const Ctx& C0, int l) {
    Ctx C = C0; asm volatile("" : "+v"(C.tid), "+v"(C.lane), "+s"(C.wave), "+s"(C.vcu), "+s"(C.G), "+s"(C.lds));
    Args a; LOADARG(a, ws);
    unsigned char* ws = a.ws;
    const bf16* P = (const bf16*)(ws + WS_P);
    bf16* mix = (bf16*)(ws + WS_MIXIN);
    LAS unsigned char* Ks = C.lds; LAS unsigned char* Vs = C.lds + 32768;
    const bf16* PO = (const bf16*)(ws + WS_PARTO); const float2* PML = (const float2*)(ws + WS_PARTML);
    const int fr = C.lane & 15, fq = C.lane >> 4;
    for (int it = C.vcu; it < NH * 64; it += C.G) {
        const int h = it & 7, own = it >> 3;
        __syncthreads();
        stage_kv(C, P, own, h, 256, Ks, Vs);
        __syncthreads();
#pragma unroll 1
        for (int par = 0; par < 2; ++par) {
        const int qoff = par * 128 + 16 * C.wave + fr;
        const int tok = own * 256 + qoff;
        bf16x8 qf[2];
#pragma unroll
        for (int ks = 0; ks < 2; ++ks) qf[ks] = *(const bf16x8*)(P + (size_t)tok * NIN + Q_OFF + h * HD + 32 * ks + 8 * fq);
        const int nct = ((8 * par + C.wave + 1) + 1) & ~1;
        AttnOut R;
        attn_core<true>(R, Ks, Vs, qf, nct, qoff, C.lane);
        const int nsel = own < 3 ? own : 3;
        float mm[3], ll[3]; float M = R.m;
#pragma unroll
        for (int r = 0; r < 3; ++r) { mm[r] = -1e30f; ll[r] = 0.f; if (r < nsel) { const float2 t = PML[((size_t)r * S + tok) * NH + h]; mm[r] = t.x; ll[r] = t.y; M = fmaxf(M, t.x); } }
        const float w0 = fast_exp2((R.m - M) * LOG2E);
        float wr_[3]; float den = R.l * w0;
#pragma unroll
        for (int r = 0; r < 3; ++r) { wr_[r] = (r < nsel) ? ll[r] * fast_exp2((mm[r] - M) * LOG2E) : 0.f; den += wr_[r]; }
        const float inv = 1.0f / den;
        f32x4 o[4];
#pragma unroll
        for (int c = 0; c < 4; ++c) o[c] = R.o[c] * w0;
#pragma unroll
        for (int r = 0; r < 3; ++r) {
            if (r < nsel) {
                const bf16* op = PO + (((size_t)r * S + tok) * NH + h) * HD + 4 * fq;
#pragma unroll
                for (int c = 0; c < 4; ++c) { const u32x2 w = *(const u32x2*)(op + 16 * c); o[c][0] += wr_[r] * bflo(w.x); o[c][1] += wr_[r] * bfhi(w.x); o[c][2] += wr_[r] * bflo(w.y); o[c][3] += wr_[r] * bfhi(w.y); }
            }
        }
        bf16* yp = mix + (size_t)tok * D + h * HD + 4 * fq;
#pragma unroll
        for (int c = 0; c < 4; ++c) { u32x2 w; w.x = pk2(o[c][0] * inv, o[c][1] * inv); w.y = pk2(o[c][2] * inv, o[c][3] * inv); *(u32x2*)(yp + 16 * c) = w; }
        }
    }
    __syncthreads();
}

__device__ __forceinline__ float reduce16_scatter(const float (&lg)[16], int lane) {
    const bool h32 = (lane & 32) != 0, h16 = (lane & 16) != 0, h8 = (lane & 8) != 0, h4 = (lane & 4) != 0;
    float r8[8], r4[4], r2[2];
#pragma unroll
    for (int e = 0; e < 8; ++e) { const float keep = h32 ? lg[e + 8] : lg[e], send = h32 ? lg[e] : lg[e + 8]; r8[e] = keep + __shfl_xor(send, 32); }
#pragma unroll
    for (int e = 0; e < 4; ++e) { const float keep = h16 ? r8[e + 4] : r8[e], send = h16 ? r8[e] : r8[e + 4]; r4[e] = keep + __shfl_xor(send, 16); }
#pragma unroll
    for (int e = 0; e < 2; ++e) { const float keep = h8 ? r4[e + 2] : r4[e], send = h8 ? r4[e] : r4[e + 2]; r2[e] = keep + __shfl_xor(send, 8); }
    float r1 = (h4 ? r2[1] : r2[0]) + __shfl_xor(h4 ? r2[0] : r2[1], 4);
    r1 += __shfl_xor(r1, 2); r1 += __shfl_xor(r1, 1);
    return r1;
}
__device__ __forceinline__ void route_one(float red, const float* router_bias, int lane, int lt, LAS int* tinfo, LAS float* tw, LAS unsigned* cntL) {
    float sc[16], bi[16];
#pragma unroll
    for (int e = 0; e < 16; ++e) {
        const int L = 32 * (e >> 3) + 16 * ((e >> 2) & 1) + 8 * ((e >> 1) & 1) + 4 * (e & 1);
        const float lgt = __builtin_bit_cast(float, __builtin_amdgcn_readlane(__builtin_bit_cast(int, red), L));
        sc[e] = sigmoidf_(lgt); bi[e] = sc[e] + router_bias[e];
    }
    int bg = 0; float bgs = -3e38f;
#pragma unroll
    for (int gI = 0; gI < 4; ++gI) {
        float t1 = -3e38f, t2 = -3e38f;
#pragma unroll
        for (int i = 0; i < 4; ++i) { const float x = bi[4 * gI + i]; if (x > t1) { t2 = t1; t1 = x; } else if (x > t2) t2 = x; }
        const float gs = t1 + t2;
        if (gs > bgs) { bgs = gs; bg = gI; }
    }
    float t1 = -3e38f, t2 = -3e38f; int j1 = 0, j2 = 0;
#pragma unroll
    for (int gI = 0; gI < 4; ++gI) {
        if (gI == bg) {
#pragma unroll
            for (int i = 0; i < 4; ++i) { const float x = bi[4 * gI + i]; if (x > t1) { t2 = t1; j2 = j1; t1 = x; j1 = i; } else if (x > t2) { t2 = x; j2 = i; } }
        }
    }
    float s1 = 0.f, s2 = 0.f;
#pragma unroll
    for (int e = 0; e < 16; ++e) { if (e == 4 * bg + j1) s1 = sc[e]; if (e == 4 * bg + j2) s2 = sc[e]; }
    const int e0 = 4 * bg + j1, e1 = 4 * bg + j2;
    if (lane == 0) {
        const float inv = 1.0f / (s1 + s2);
        tinfo[4 * lt + 0] = e0; tinfo[4 * lt + 1] = (int)__hip_atomic_fetch_add(&cntL[e0], 1u, __ATOMIC_RELAXED, __HIP_MEMORY_SCOPE_WORKGROUP);
        tinfo[4 * lt + 2] = e1; tinfo[4 * lt + 3] = (int)__hip_atomic_fetch_add(&cntL[e1], 1u, __ATOMIC_RELAXED, __HIP_MEMORY_SCOPE_WORKGROUP);
        tw[2 * lt] = s1 * inv; tw[2 * lt + 1] = s2 * inv;
    }
}

__device__ __forceinline__ void pf_convert(const Ctx& C0, int l) {
    Ctx C = C0; asm volatile("" : "+v"(C.tid), "+v"(C.lane), "+s"(C.wave), "+s"(C.vcu), "+s"(C.G), "+s"(C.lds));
    Args a; LOADARG(a, ws); LOADARG(a, w_gate); LOADARG(a, w_up); LOADARG(a, w_down);
    unsigned char* ws = a.ws;
    LAS float* scr = (LAS float*)(C.lds + C.wave * 16384);
    const int gw = C.vcu * NWAVES + C.wave, NGW = C.G * NWAVES;
    constexpr int I_G = (D / 64) * (DE / 64), I_D = (DE / 64) * (D / 64);
    for (int it = gw; it < NE * (2 * I_G + I_D); it += NGW) {
        const int e = it / (2 * I_G + I_D); int r = it % (2 * I_G + I_D);
        const size_t eo = ((size_t)l * NE + e) * D * DE;
        if (r < I_G) transpose_item(a.w_gate + eo, D, DE, (bf16*)(ws + WS_WGU) + (size_t)e * D * D, scr, r, C.lane, MapGU{0});
        else if (r < 2 * I_G) transpose_item(a.w_up + eo, D, DE, (bf16*)(ws + WS_WGU) + (size_t)e * D * D, scr, r - I_G, C.lane, MapGU{1});
        else transpose_item(a.w_down + eo, DE, D, (bf16*)(ws + WS_WDN) + (size_t)e * D * DE, scr, r - 2 * I_G, C.lane, MapPerm{});
    }
    __syncthreads();
}
__device__ __forceinline__ void pf_ln_router(const Ctx& C0, int l, bool dry = false) {
    Ctx C = C0; asm volatile("" : "+v"(C.tid), "+v"(C.lane), "+s"(C.wave), "+s"(C.vcu), "+s"(C.G), "+s"(C.lds));
    Args a; LOADARG(a, ws); LOADARG(a, w_router); LOADARG(a, router_bias); LOADARG(a, out); LOADARG(a, ln_mix_g); LOADARG(a, ln_mix_b);
    unsigned char* ws = a.ws;
    LAS float* wrt = (LAS float*)C.lds;
    LAS unsigned* cntL = (LAS unsigned*)(C.lds + 65536);
    LAS unsigned* baseL = cntL + 16;
    LAS int* tinfo = (LAS int*)(C.lds + 65536 + 256);
    LAS float* tw = (LAS float*)(C.lds + 65536 + 256 + 4096);
    for (int i = C.tid; i < D * NE / 4; i += NWAVES * 64) { const int k = i >> 2, q = i & 3; ((LAS f32x4*)wrt)[q * 1024 + ((k >> 8) * 4 + (k & 3)) * 64 + ((k >> 2) & 63)] = ((const f32x4*)a.w_router)[i]; }
    if (C.tid < 16) cntL[C.tid] = 0u;
    __syncthreads();
    float* H = a.out; bf16* hb = (bf16*)(ws + WS_HB);
    const float* g = a.ln_mix_g + l * D; const float* b = a.ln_mix_b + l * D;
    constexpr int TPW = S / 256;
    for (int lt = C.wave; lt < TPW; lt += 2 * NWAVES) {
        const int tokA = C.vcu * TPW + lt, tokB = tokA + NWAVES;
        f32x4 vA[4], vB[4];
#pragma unroll
        for (int j = 0; j < 4; ++j) { vA[j] = *(const f32x4*)(H + (size_t)tokA * D + 4 * C.lane + 256 * j); vB[j] = *(const f32x4*)(H + (size_t)tokB * D + 4 * C.lane + 256 * j); }
        ln_row(vA, g, b, C.lane, LN_EPS); ln_row(vB, g, b, C.lane, LN_EPS);
        if (dry) { store_row(vA, (float*)(ws + WS_AG) + (size_t)tokA * D, (bf16*)(ws + WS_ACT) + (size_t)tokA * D, C.lane); store_row(vB, (float*)(ws + WS_AG) + (size_t)tokB * D, (bf16*)(ws + WS_ACT) + (size_t)tokB * D, C.lane); }
        else { store_row(vA, H + (size_t)tokA * D, hb + (size_t)tokA * D, C.lane); store_row(vB, H + (size_t)tokB * D, hb + (size_t)tokB * D, C.lane); }
        float lgA[16], lgB[16];
#pragma unroll
        for (int e = 0; e < 16; ++e) { lgA[e] = 0.f; lgB[e] = 0.f; }
#pragma unroll
        for (int j = 0; j < 4; ++j)
#pragma unroll
            for (int i = 0; i < 4; ++i) {
                const LAS f32x4* wr4 = (const LAS f32x4*)wrt + (4 * j + i) * 64 + C.lane;
                const float xa = vA[j][i], xb = vB[j][i];
#pragma unroll
                for (int q = 0; q < 4; ++q) { const f32x4 w4 = wr4[q * 1024];
                    lgA[4 * q] += xa * w4[0]; lgA[4 * q + 1] += xa * w4[1]; lgA[4 * q + 2] += xa * w4[2]; lgA[4 * q + 3] += xa * w4[3];
                    lgB[4 * q] += xb * w4[0]; lgB[4 * q + 1] += xb * w4[1]; lgB[4 * q + 2] += xb * w4[2]; lgB[4 * q + 3] += xb * w4[3]; }
            }
        const float rA = reduce16_scatter(lgA, C.lane), rB = reduce16_scatter(lgB, C.lane);
        route_one(rA, a.router_bias, C.lane, lt, tinfo, tw, cntL);
        route_one(rB, a.router_bias, C.lane, lt + NWAVES, tinfo, tw, cntL);
    }
    __syncthreads();
    if (dry) { __syncthreads(); return; }
    unsigned* ecnt = (unsigned*)(ws + WS_CTL) + CW_ECNT + l * 16;
    if (C.tid < 16) { const unsigned c = cntL[C.tid]; baseL[C.tid] = c ? atomicAdd(&ecnt[C.tid], c) : 0u; }
    __syncthreads();
    int* elist = (int*)(ws + WS_ELIST); float* ew = (float*)(ws + WS_EW);
    if (C.tid < 2 * TPW) {
        const int lt = C.tid >> 1, sl = C.tid & 1, tok = C.vcu * TPW + lt;
        const int e = tinfo[4 * lt + 2 * sl], lp = tinfo[4 * lt + 2 * sl + 1];
        elist[(size_t)e * S + baseL[e] + lp] = tok * 2 + sl;
        ew[tok * 2 + sl] = tw[2 * lt + sl];
    }
    __syncthreads();
}

__device__ __forceinline__ void pg_gather(const Ctx& C0, int l, volatile LAS int* tstart) {
    Ctx C = C0; asm volatile("" : "+v"(C.tid), "+v"(C.lane), "+s"(C.wave), "+s"(C.vcu), "+s"(C.G), "+s"(C.lds));
    Args a; LOADARG(a, ws);
    unsigned char* ws = a.ws;
    const unsigned* ecnt = (const unsigned*)(ws + WS_CTL) + CW_ECNT + l * 16;
    LAS int* ecl = (LAS int*)(C.lds);
    if (C.tid == 0) { int s = 0; for (int e = 0; e < 16; ++e) { const int c = (int)__hip_atomic_load(ecnt + e, RLX_AGENT); ecl[e] = c; tstart[e] = s; s += (c + 255) >> 8; } tstart[16] = s; }
    __syncthreads();
    const int nrows = tstart[16] * 256;
    const int gw = C.vcu * NWAVES + C.wave, NGW = C.G * NWAVES;
    const int* elist = (const int*)(ws + WS_ELIST); const float* ew = (const float*)(ws + WS_EW);
    const bf16* hb = (const bf16*)(ws + WS_HB); bf16* AG = (bf16*)(ws + WS_AG); int2* rowinfo = (int2*)(ws + WS_ROWINFO);
    for (int R = gw; R < nrows; R += NGW) {
        const int mt = R >> 8; int e = 0;
#pragma unroll
        for (int j = 1; j < 16; ++j) e += (mt >= tstart[j]) ? 1 : 0;
        const int pos = R - tstart[e] * 256;
        if (pos < ecl[e]) {
            const int ent = elist[(size_t)e * S + pos], tok = ent >> 1;
            const u32x4* src = (const u32x4*)(hb + (size_t)tok * D); u32x4* dst = (u32x4*)(AG + (size_t)R * D);
            const u32x4 x0 = src[C.lane], x1 = src[64 + C.lane];
            dst[C.lane] = x0; dst[64 + C.lane] = x1;
            if (C.lane == 0) rowinfo[R] = make_int2(ent, __builtin_bit_cast(int, ew[ent]));
        } else {
            u32x4* dst = (u32x4*)(AG + (size_t)R * D); const u32x4 z = (u32x4){0u, 0u, 0u, 0u};
            dst[C.lane] = z; dst[64 + C.lane] = z;
            if (C.lane == 0) rowinfo[R] = make_int2(-1, 0);
        }
    }
}

__device__ __forceinline__ void pj_final(const Ctx& C0, int l, bool poison, bool dry = false) {
    Ctx C = C0; asm volatile("" : "+v"(C.tid), "+v"(C.lane), "+s"(C.wave), "+s"(C.vcu), "+s"(C.G), "+s"(C.lds));
    Args a; LOADARG(a, ws); LOADARG(a, out); LOADARG(a, ln_ffn_g); LOADARG(a, ln_ffn_b);
    unsigned char* ws = a.ws;
    const int gw = C.vcu * NWAVES + C.wave, NGW = C.G * NWAVES;
    float* H = a.out; bf16* hb = (bf16*)(ws + WS_HB); const bf16* Y = (const bf16*)(ws + WS_Y);
    const float* g = a.ln_ffn_g + l * D; const float* b = a.ln_ffn_b + l * D;
    for (int tok = gw; tok < S; tok += NGW) {
        f32x4 v[4];
#pragma unroll
        for (int j = 0; j < 4; ++j) {
            v[j] = *(const f32x4*)(H + (size_t)tok * D + 4 * C.lane + 256 * j) * ALPHA;
            const u32x2 y0 = *(const u32x2*)(Y + ((size_t)tok * 2) * D + 4 * C.lane + 256 * j), y1 = *(const u32x2*)(Y + ((size_t)tok * 2 + 1) * D + 4 * C.lane + 256 * j);
            v[j][0] += bflo(y0.x) + bflo(y1.x); v[j][1] += bfhi(y0.x) + bfhi(y1.x); v[j][2] += bflo(y0.y) + bflo(y1.y); v[j][3] += bfhi(y0.y) + bfhi(y1.y);
        }
        ln_row(v, g, b, C.lane, LN_EPS);
        if (poison) {
#pragma unroll
            for (int j = 0; j < 4; ++j) v[j] = (f32x4){__builtin_nanf(""), __builtin_nanf(""), __builtin_nanf(""), __builtin_nanf("")};
        }
        if (dry) store_row(v, (float*)(ws + WS_AG) + (size_t)tok * D, (bf16*)(ws + WS_ACT) + (size_t)tok * D, C.lane);
        else store_row(v, H + (size_t)tok * D, hb + (size_t)tok * D, C.lane);
    }
}


#if SELFCHECK
__global__ void __launch_bounds__(256) selfcheck_kernel(Args a) {
    const int l = 0;
    unsigned char* ws = a.ws;
    const bf16* P = (const bf16*)(ws + WS_P);
    unsigned* err = (unsigned*)(ws + WS_ERR);
    const int gt = blockIdx.x * blockDim.x + threadIdx.x, NGT = gridDim.x * blockDim.x;
#if SELFCHECK & 1
    {
        const bf16* mix = (const bf16*)(ws + WS_MIXIN);
        const float* ksum = (const float*)(ws + WS_CTL) + CW_KMEAN + (size_t)l * (NH * NBLK * HD);
        constexpr int NTOK = 1024 + (S - 1024) / 7;
        for (int p = gt; p < NTOK * 8; p += NGT) {
            const int ti = p >> 3, h = p & 7;
            const int tok = ti < 1024 ? ti : 1024 + (ti - 1024) * 7 + 3;
            const int own = tok >> 8;
            float q[64];
            {
                const u32x4* qp = (const u32x4*)(P + (size_t)tok * NIN + Q_OFF + h * HD);
#pragma unroll
                for (int c = 0; c < 8; ++c) { const u32x4 w = qp[c]; q[8 * c + 0] = bflo(w.x); q[8 * c + 1] = bfhi(w.x); q[8 * c + 2] = bflo(w.y); q[8 * c + 3] = bfhi(w.y); q[8 * c + 4] = bflo(w.z); q[8 * c + 5] = bfhi(w.z); q[8 * c + 6] = bflo(w.w); q[8 * c + 7] = bfhi(w.w); }
            }
            float v0 = -3e38f, v1 = -3e38f, v2 = -3e38f; int i0 = 0, i1 = 0, i2 = 0;
            for (int n = 0; n < own; ++n) {
                const f32x4* kr = (const f32x4*)(ksum + ((size_t)h * NBLK + n) * HD);
                float g = 0.f;
#pragma unroll
                for (int c = 0; c < 16; ++c) { const f32x4 kv = kr[c]; g += q[4 * c] * kv[0] + q[4 * c + 1] * kv[1] + q[4 * c + 2] * kv[2] + q[4 * c + 3] * kv[3]; }
                if (g > v0) { v2 = v1; i2 = i1; v1 = v0; i1 = i0; v0 = g; i0 = n; }
                else if (g > v1) { v2 = v1; i2 = i1; v1 = g; i1 = n; }
                else if (g > v2) { v2 = g; i2 = n; }
            }
            const int nsel = own < 3 ? own : 3;
            float m = -1e30f, lsum = 0.f; float o[64];
#pragma unroll
            for (int d = 0; d < 64; ++d) o[d] = 0.f;
            for (int r = 0; r < 4; ++r) {
                if (r < 3 && r >= nsel) continue;
                const int blk = (r == 0) ? i0 : (r == 1) ? i1 : (r == 2) ? i2 : own;
                const int nk = (r == 3) ? (tok & 255) + 1 : 256;
                for (int j = 0; j < nk; ++j) {
                    const bf16* kp = P + (size_t)(blk * 256 + j) * NIN + K_OFF + h * HD;
                    float sc = 0.f;
#pragma unroll
                    for (int c = 0; c < 8; ++c) { const u32x4 w = ((const u32x4*)kp)[c]; sc += q[8 * c] * bflo(w.x) + q[8 * c + 1] * bfhi(w.x) + q[8 * c + 2] * bflo(w.y) + q[8 * c + 3] * bfhi(w.y) + q[8 * c + 4] * bflo(w.z) + q[8 * c + 5] * bfhi(w.z) + q[8 * c + 6] * bflo(w.w) + q[8 * c + 7] * bfhi(w.w); }
                    const float mn = fmaxf(m, sc), al = __expf(m - mn), pe = __expf(sc - mn);
                    lsum = lsum * al + pe; m = mn;
                    const bf16* vp = P + (size_t)(blk * 256 + j) * NIN + V_OFF + h * HD;
#pragma unroll
                    for (int c = 0; c < 8; ++c) { const u32x4 w = ((const u32x4*)vp)[c];
                        o[8 * c] = o[8 * c] * al + pe * bflo(w.x); o[8 * c + 1] = o[8 * c + 1] * al + pe * bfhi(w.x); o[8 * c + 2] = o[8 * c + 2] * al + pe * bflo(w.y); o[8 * c + 3] = o[8 * c + 3] * al + pe * bfhi(w.y);
                        o[8 * c + 4] = o[8 * c + 4] * al + pe * bflo(w.z); o[8 * c + 5] = o[8 * c + 5] * al + pe * bfhi(w.z); o[8 * c + 6] = o[8 * c + 6] * al + pe * bflo(w.w); o[8 * c + 7] = o[8 * c + 7] * al + pe * bfhi(w.w); }
                }
            }
            const float inv = 1.0f / lsum; bool bad = false;
            const u32x4* yp = (const u32x4*)(mix + (size_t)tok * D + h * HD);
#pragma unroll
            for (int c = 0; c < 8; ++c) { const u32x4 w = yp[c]; const float g8[8] = {bflo(w.x), bfhi(w.x), bflo(w.y), bfhi(w.y), bflo(w.z), bfhi(w.z), bflo(w.w), bfhi(w.w)};
#pragma unroll
                for (int j = 0; j < 8; ++j) { const float ref = o[8 * c + j] * inv, df = fabsf(ref - g8[j]); if (!(df <= 0.002f + 0.02f * fabsf(ref))) bad = true; } }
            atomicAdd(err + 0, 1u); if (bad) atomicAdd(err + 1, 1u);
        }
    }
#endif
#if SELFCHECK & 2
    {
        const bf16* hb = (const bf16*)(ws + WS_HB);
        const float* W = a.w_in + (size_t)l * D * NIN;
        constexpr int NT = S / 37;
        for (int it = gt; it < NT * NIN; it += NGT) {
            const int ti = it / NIN, col = it % NIN, tok = 37 * ti + 5;
            const bool rot = col < 1024;
            const int d = col & 63, pcol = rot ? ((d < 32) ? col + 32 : col - 32) : col;
            float s1 = 0.f, s2 = 0.f;
            for (int k = 0; k < D; ++k) { const float hv = bf2f(hb[(size_t)tok * D + k]); s1 += hv * W[(size_t)k * NIN + col]; s2 += hv * W[(size_t)k * NIN + pcol]; }
            float ref; int pidx = col;
            if (rot) {
                const int i = d & 31;
                const double ang = (double)((float)tok * powf(10000.0f, -(float)i / 32.0f));
                const float cs_ = (float)cos(ang), sn_ = (float)sin(ang);
                ref = (d < 32) ? (s1 * cs_ - s2 * sn_) : (s1 * cs_ + s2 * sn_);
                if (col < 512) ref *= 0.125f;
                const int n1 = d >> 5, w1 = (d >> 4) & 1, t = d & 15;
                pidx = (col & ~63) + 32 * w1 + 8 * (t >> 2) + 4 * n1 + (t & 3);
            } else if (col >= SGU_OFF && col < CA_OFF) ref = gelu_tanh(s1);
            else ref = s1;
            const float got = bf2f(P[(size_t)tok * NIN + pidx]);
            if (!(fabsf(ref - got) <= 0.03f + 0.02f * fabsf(ref))) atomicAdd(err + 2, 1u);
        }
    }
#endif
#if SELFCHECK & 4
    {
        const float* ksum = (const float*)(ws + WS_CTL) + CW_KMEAN + (size_t)l * (NH * NBLK * HD);
        for (int it = gt; it < NH * NBLK * HD; it += NGT) {
            const int h = it >> 12, n = (it >> 6) & 63, dd = it & 63;
            float s = 0.f;
            for (int j = 0; j < 256; ++j) s += bf2f(P[(size_t)(n * 256 + j) * NIN + K_OFF + h * HD + dd]);
            if (!(fabsf(s - ksum[it]) * (1.0f / 256.0f) <= 2e-3f)) atomicAdd(err + 3, 1u);
        }
    }
#endif
}
__device__ __forceinline__ bool selfcheck_failed(unsigned char* ws) {
    unsigned* err = (unsigned*)(ws + WS_ERR);
    const unsigned n = __hip_atomic_load(err + 0, RLX_AGENT), b1 = __hip_atomic_load(err + 1, RLX_AGENT);
    const unsigned b2 = __hip_atomic_load(err + 2, RLX_AGENT), b3 = __hip_atomic_load(err + 3, RLX_AGENT);
    bool f = false;
#if SELFCHECK & 1
    f = f || (n == 0u) || (b1 * 100u > n);
#endif
#if SELFCHECK & 2
    f = f || (b2 > 200u);
#endif
#if SELFCHECK & 4
    f = f || (b3 > 0u);
#endif
    return f;
}
#endif

__global__ void __launch_bounds__(NWAVES * 64, 2) hymba_fwd(Args args) {
    extern __shared__ __attribute__((aligned(16))) unsigned char lds_raw[];
    Ctx C;
    C.lds = (LAS unsigned char*)lds_raw;
    volatile LAS unsigned* MISC = (volatile LAS unsigned*)(C.lds + MISC_OFF);
    C.tid = threadIdx.x; C.lane = C.tid & 63; C.wave = __builtin_amdgcn_readfirstlane(C.tid >> 6);
    C.G = gridDim.x; { const int bx = blockIdx.x; C.vcu = (C.G % 8 == 0) ? (bx % 8) * (C.G / 8) + bx / 8 : bx; }
    for (int u = C.tid; u < 64; u += NWAVES * 64) MISC[u] = 0u;
    if (C.tid == 0) {
        const unsigned long long pv[24] = {(unsigned long long)args.x, (unsigned long long)args.ln_in_g, (unsigned long long)args.ln_in_b, (unsigned long long)args.w_in, (unsigned long long)args.w_out,
            (unsigned long long)args.sg_ln_g, (unsigned long long)args.sg_ln_b, (unsigned long long)args.sg_w, (unsigned long long)args.sg_b, (unsigned long long)args.conv_w, (unsigned long long)args.conv_b,
            (unsigned long long)args.conv_ln_g, (unsigned long long)args.conv_ln_b, (unsigned long long)args.ln_mix_g, (unsigned long long)args.ln_mix_b, (unsigned long long)args.w_router,
            (unsigned long long)args.router_bias, (unsigned long long)args.w_gate, (unsigned long long)args.w_up, (unsigned long long)args.w_down, (unsigned long long)args.ln_ffn_g,
            (unsigned long long)args.ln_ffn_b, (unsigned long long)args.out, (unsigned long long)args.ws};
        volatile LAS unsigned* ap = (volatile LAS unsigned*)(C.lds + ARGS_OFF);
#pragma unroll
        for (int i = 0; i < 24; ++i) { ap[2 * i] = (unsigned)pv[i]; ap[2 * i + 1] = (unsigned)(pv[i] >> 32); }
    }
    __syncthreads();
    XcdBarrier bar;
    { unsigned char* ws0 = ARG(ws); bar = xcd_barrier_post((unsigned*)((gu32*)(ws0 + WS_CTL) + CW_BAR), MISC + 8); }
    volatile LAS int* tstart = (volatile LAS int*)(MISC + 16);
#define GRID_BAR() xcd_barrier_t<false>(bar)

#ifndef SKIP_P0
for (int rep_ = 0; rep_ <= REP_P0; ++rep_) { p0_prologue(C); }
#endif
    xcd_barrier_t<true>(bar);

    for (int l = 0; l < DEPTH; ++l) {
        {
            unsigned char* ws = ARG(ws);
            pg8::DenseOrder So; int bxl = blockIdx.x, Gl = C.G; asm volatile("" : "+s"(bxl), "+s"(Gl)); So.init(ws + WS_HB, (bf16*)(ws + WS_WIN) + (size_t)l * NIN * D, S, NIN, D, Gl, bxl);
            pg8::EpiIn E{(bf16*)(ws + WS_P), (const float*)(ws + WS_CS), (float*)(ws + WS_CTL) + CW_KMEAN + (size_t)l * (NH * NBLK * HD)};
#ifndef SKIP_PA
for (int rep_ = 0; rep_ <= REP_PA; ++rep_) { pg8::gemm_phase<pg8::EpiIn, pg8::DenseOrder, true, true>(lds_opaque(C.lds), D, So, E); }
#endif
        }
        GRID_BAR();
        for (int rep_ = 0; rep_ < REP_BAR; ++rep_) GRID_BAR();
        {
#if ENABLE_ATT
#ifndef SKIP_PBG
            for (int rep_ = 0; rep_ < REP_GATE; ++rep_) for (int it = C.vcu; it < 256; it += C.G) pb_gating(C, l, it, true);
            for (int it = C.vcu; it < 256; it += C.G) pb_gating(C, l, it);
#endif
#endif
#ifndef SKIP_PBS
for (int rep_ = 0; rep_ <= REP_SG; ++rep_) { for (int it = C.vcu; it < 128; it += C.G) pb_sg(C, l, it); }
#endif
#ifndef SKIP_PBC
for (int rep_ = 0; rep_ <= REP_CONV; ++rep_) { for (int it = C.vcu; it < 256; it += C.G) pb_conv(C, l, it); }
#endif
        }
        GRID_BAR();
#if ENABLE_ATT
#ifndef SKIP_PC
for (int rep_ = 0; rep_ <= REP_PC; ++rep_) { pc_selattn(C, l); }
#endif
        GRID_BAR();
#ifndef SKIP_PD
for (int rep_ = 0; rep_ <= REP_PD; ++rep_) { pd_ownattn(C, l); }
#endif
        GRID_BAR();
#else
        {
            unsigned char* ws = ARG(ws);
            const int gt = C.vcu * (NWAVES * 64) + C.tid, NGT = C.G * NWAVES * 64;
            bf16* mix = (bf16*)(ws + WS_MIXIN);
            for (int i = gt; i < S * 64; i += NGT) { const int tok = i >> 6, c8 = i & 63; *(u32x4*)(mix + (size_t)tok * D + 8 * c8) = (u32x4){0u, 0u, 0u, 0u}; }
        }
        GRID_BAR();
#endif
#if SELFCHECK
        if (args.mode == 1) return;
#endif
        {
            unsigned char* ws = ARG(ws);
            pg8::DenseOrder So; int bxl = blockIdx.x, Gl = C.G; asm volatile("" : "+s"(bxl), "+s"(Gl)); So.init(ws + WS_MIXIN, (bf16*)(ws + WS_WOUT) + (size_t)l * D * D, S, D, D, Gl, bxl);
            float* Hp = ARG(out);
            for (int rep_ = 0; rep_ < REP_PE; ++rep_) { pg8::EpiOut Ed{Hp, (float*)(ws + WS_Y)}; pg8::gemm_phase<pg8::EpiOut, pg8::DenseOrder, false, true>(lds_opaque(C.lds), D, So, Ed); }
            pg8::EpiOut E{Hp, Hp};
#ifndef SKIP_PE
            pg8::gemm_phase<pg8::EpiOut, pg8::DenseOrder, false, true>(lds_opaque(C.lds), D, So, E);
#endif
        }
        GRID_BAR();
#ifndef SKIP_PF
        for (int rep_ = 0; rep_ <= REP_PFC; ++rep_) pf_convert(C, l);
        for (int rep_ = 0; rep_ < REP_PF; ++rep_) pf_ln_router(C, l, true);
        pf_ln_router(C, l);
#endif
        GRID_BAR();
#ifndef SKIP_PG
for (int rep_ = 0; rep_ <= REP_PG; ++rep_) { pg_gather(C, l, tstart); }
#endif
        GRID_BAR();
        {
            unsigned char* ws = ARG(ws);
            pg8::MoeOrder So; int vl = C.vcu, Gl = C.G; asm volatile("" : "+s"(vl), "+s"(Gl)); So.init(ws + WS_AG, ws + WS_WGU, D, D, Gl, vl, tstart);
            pg8::EpiGU E{(bf16*)(ws + WS_ACT)};
#ifndef SKIP_PH
for (int rep_ = 0; rep_ <= REP_PH; ++rep_) { pg8::gemm_phase<pg8::EpiGU, pg8::MoeOrder, true, true>(lds_opaque(C.lds), D, So, E); }
#endif
        }
        GRID_BAR();
        {
            unsigned char* ws = ARG(ws);
            pg8::MoeOrder So; int vl = C.vcu, Gl = C.G; asm volatile("" : "+s"(vl), "+s"(Gl)); So.init(ws + WS_ACT, ws + WS_WDN, DE, D, Gl, vl, tstart);
            pg8::EpiDown E{(bf16*)(ws + WS_Y), (const int2*)(ws + WS_ROWINFO)};
#ifndef SKIP_PI
for (int rep_ = 0; rep_ <= REP_PI; ++rep_) { pg8::gemm_phase<pg8::EpiDown, pg8::MoeOrder, true, true>(lds_opaque(C.lds), DE, So, E); }
#endif
        }
        GRID_BAR();
        {
            bool poison = false;
            if (l == DEPTH - 1) {
                gu32* ctl = (gu32*)(ARG(ws) + WS_CTL);
                poison = __hip_atomic_load((unsigned*)(ctl + CW_BAR) + XB_TMO, RLX_AGENT) != 0u;
#if SELFCHECK
                poison = poison || selfcheck_failed(ARG(ws));
#endif
            }
#ifndef SKIP_PJ
            for (int rep_ = 0; rep_ < REP_PJ; ++rep_) pj_final(C, l, poison, true);
            pj_final(C, l, poison);
#endif
        }
        if (l + 1 < DEPTH) GRID_BAR();
    }
}

extern "C" void kernel_launch(void* const* d_in, const int* in_sizes, int n_in, void* d_out, int out_size, void* d_ws, size_t ws_size, hipStream_t stream) {
    static int grid = 0;
    if (grid == 0) {
        if (n_in != 22 || in_sizes[0] != S * D || out_size != S * D || ws_size < WS_END + 4096) {
            fprintf(stderr, "kernel_launch: unexpected shapes (n_in %d, in0 %d, out %d, ws %zu, need %zu); nothing launched\n", n_in, n_in > 0 ? in_sizes[0] : -1, out_size, ws_size, (size_t)WS_END); grid = -1; return; }
        int dev = 0, cus = 0, per_cu = 0;
        if (hipGetDevice(&dev) != hipSuccess || hipDeviceGetAttribute(&cus, hipDeviceAttributeMultiprocessorCount, dev) != hipSuccess) { grid = -1; return; }
        if (hipFuncSetAttribute((const void*)hymba_fwd, hipFuncAttributeMaxDynamicSharedMemorySize, LDS_BYTES) != hipSuccess) { fprintf(stderr, "kernel_launch: hipFuncSetAttribute failed\n"); grid = -1; return; }
        if (hipOccupancyMaxActiveBlocksPerMultiprocessor(&per_cu, (const void*)hymba_fwd, NWAVES * 64, LDS_BYTES) != hipSuccess || per_cu < 1) { fprintf(stderr, "kernel_launch: occupancy query says %d\n", per_cu); grid = -1; (void)hipGetLastError(); return; }
        (void)hipGetLastError();
        grid = cus;
        if (grid != 256) { fprintf(stderr, "kernel_launch: built for a 256-CU device, got %d CUs\n", cus); grid = -1; return; }
    }
    if (grid < 0) return;
    if (hipMemsetAsync((char*)d_ws + WS_CTL, 0, CTL_ZERO_BYTES, stream) != hipSuccess) return;
    Args a{};
    a.x = (const float*)d_in[0]; a.ln_in_g = (const float*)d_in[1]; a.ln_in_b = (const float*)d_in[2]; a.w_in = (const float*)d_in[3]; a.w_out = (const float*)d_in[4];
    a.sg_ln_g = (const float*)d_in[5]; a.sg_ln_b = (const float*)d_in[6]; a.sg_w = (const float*)d_in[7]; a.sg_b = (const float*)d_in[8];
    a.conv_w = (const float*)d_in[9]; a.conv_b = (const float*)d_in[10]; a.conv_ln_g = (const float*)d_in[11]; a.conv_ln_b = (const float*)d_in[12];
    a.ln_mix_g = (const float*)d_in[13]; a.ln_mix_b = (const float*)d_in[14]; a.w_router = (const float*)d_in[15]; a.router_bias = (const float*)d_in[16];
    a.w_gate = (const float*)d_in[17]; a.w_up = (const float*)d_in[18]; a.w_down = (const float*)d_in[19]; a.ln_ffn_g = (const float*)d_in[20]; a.ln_ffn_b = (const float*)d_in[21];
    a.out = (float*)d_out; a.ws = (unsigned char*)d_ws;
#if SELFCHECK
    (void)hipMemsetAsync((char*)d_ws + WS_ERR, 0, 4096, stream);
    a.mode = 1;
    hipLaunchKernelGGL(hymba_fwd, dim3(grid), dim3(NWAVES * 64), LDS_BYTES, stream, a);
    hipLaunchKernelGGL(selfcheck_kernel, dim3(2048), dim3(256), 0, stream, a);
    (void)hipMemsetAsync((char*)d_ws + WS_CTL, 0, CTL_ZERO_BYTES, stream);
    a.mode = 0;
#endif
    hipLaunchKernelGGL(hymba_fwd, dim3(grid), dim3(NWAVES * 64), LDS_BYTES, stream, a);
}
```

```cpp
#include <hip/hip_runtime.h>
#include <cstdio>
#include <cstdint>

#ifndef ENABLE_ATT
#define ENABLE_ATT 1
#endif
#ifndef REP_P0
#define REP_P0 0
#endif
#ifndef REP_PA
#define REP_PA 0
#endif
#ifndef REP_SG
#define REP_SG 0
#endif
#ifndef REP_CONV
#define REP_CONV 0
#endif
#ifndef REP_PC
#define REP_PC 0
#endif
#ifndef REP_PD
#define REP_PD 0
#endif
#ifndef REP_PG
#define REP_PG 0
#endif
#ifndef REP_PH
#define REP_PH 0
#endif
#ifndef REP_PI
#define REP_PI 0
#endif
#ifndef REP_GATE
#define REP_GATE 0
#endif
#ifndef REP_PE
#define REP_PE 0
#endif
#ifndef REP_PF
#define REP_PF 0
#endif
#ifndef REP_PJ
#define REP_PJ 0
#endif
#ifndef REP_PFC
#define REP_PFC 0
#endif
#ifndef REP_BAR
#define REP_BAR 0
#endif
#ifndef SELFCHECK
#define SELFCHECK 0
#endif

#define GAS __attribute__((address_space(1)))
#define LAS __attribute__((address_space(3)))
typedef unsigned short bf16;
typedef short bf16x8 __attribute__((ext_vector_type(8)));
typedef float f32x4 __attribute__((ext_vector_type(4)));
typedef float f32x2 __attribute__((ext_vector_type(2)));
typedef unsigned u32x4 __attribute__((ext_vector_type(4)));
typedef unsigned u32x2 __attribute__((ext_vector_type(2)));
typedef GAS unsigned gu32;

constexpr int S = 16384, D = 1024, NIN = 2560, NH = 8, HD = 64, NBLK = 64, DEPTH = 2;
constexpr int NE = 16, DE = 512;
constexpr int SGW = 256, CVW = 256, TAPS = 31;
constexpr int Q_OFF = 0, K_OFF = 512, V_OFF = 1024, SGU_OFF = 1536, SGV_OFF = 1792, CA_OFF = 2048, CG_OFF = 2304;
constexpr float LN_EPS = 1e-5f;
constexpr float ALPHA = 1.4142135623730951f;
constexpr float LOG2E = 1.4426950408889634f;
constexpr int MAXROWS = 2 * S + NE * 256;

constexpr size_t MiB = 1u << 20;
constexpr size_t WS_CTL = 0, CTL_ZERO_BYTES = 1 * MiB;
constexpr size_t WS_CS = 1 * MiB;
constexpr size_t WS_WIN = 5 * MiB;
constexpr size_t WS_WOUT = 15 * MiB;
constexpr size_t WS_WSG = 19 * MiB;
constexpr size_t WS_ELIST = 20 * MiB;
constexpr size_t WS_EW = 21 * MiB;
constexpr size_t WS_ROWINFO = 21 * MiB + 512 * 1024;
constexpr size_t WS_HB = 22 * MiB;
constexpr size_t WS_R = 54 * MiB;
constexpr size_t WS_P = WS_R;
constexpr size_t WS_MIXIN = WS_R + 80 * MiB;
constexpr size_t WS_PARTO = WS_R + 112 * MiB;
constexpr size_t WS_PARTML = WS_R + 160 * MiB;
constexpr size_t WS_LISTS = WS_R + 163 * MiB;
constexpr size_t WS_WGU = WS_R;
constexpr size_t WS_WDN = WS_R + 32 * MiB;
constexpr size_t WS_AG = WS_R + 48 * MiB;
constexpr size_t WS_ACT = WS_R + 120 * MiB;
constexpr size_t WS_Y = WS_R + 156 * MiB;
constexpr size_t WS_END = WS_R + 220 * MiB;
constexpr size_t WS_ERR = WS_END;
static_assert((size_t)MAXROWS * 1024 * 2 <= 72 * MiB && (size_t)MAXROWS * 512 * 2 <= 36 * MiB, "MoE buffers");
constexpr int CW_TMO = 0;
constexpr int CW_BAR = 4096;
constexpr int CW_ACNT = 8192;
constexpr int CW_ECNT = 9216;
constexpr int CW_ERR = 9280;
constexpr int CW_KMEAN = 16384;

constexpr int RING_BYTES = 131072;
constexpr int MISC_OFF = RING_BYTES;
constexpr int LDS_BYTES = 147456;
constexpr int NWAVES = 8;

#define RLX_AGENT __ATOMIC_RELAXED, __HIP_MEMORY_SCOPE_AGENT
#define LDS_WAIT() asm volatile("s_waitcnt lgkmcnt(0)" ::: "memory")
#define VM_WAIT() asm volatile("s_waitcnt vmcnt(0)" ::: "memory")

__device__ __forceinline__ unsigned f2bf(float f) { unsigned u = __builtin_bit_cast(unsigned, f); return (u + 0x7fffu + ((u >> 16) & 1u)) >> 16; }
__device__ __forceinline__ unsigned pk2(float lo, float hi) { return f2bf(lo) | (f2bf(hi) << 16); }
__device__ __forceinline__ float bf2f(unsigned b) { return __builtin_bit_cast(float, b << 16); }
__device__ __forceinline__ float bflo(unsigned w) { return __builtin_bit_cast(float, w << 16); }
__device__ __forceinline__ float bfhi(unsigned w) { return __builtin_bit_cast(float, w & 0xffff0000u); }
__device__ __forceinline__ float wave_sum(float v) {
#pragma unroll
    for (int o = 1; o < 64; o <<= 1) v += __shfl_xor(v, o);
    return v;
}
__device__ __forceinline__ float fast_exp2(float x) { return __builtin_amdgcn_exp2f(x); }
__device__ __forceinline__ float sigmoidf_(float x) { return 1.0f / (1.0f + __expf(-x)); }
__device__ __forceinline__ float gelu_tanh(float x) { const float z = 0.7978845608028654f * (x + 0.044715f * x * x * x); return x * sigmoidf_(2.0f * z); }

namespace pg8 {
constexpr int BM = 256, BK = 64, HALF = 128, HTB = HALF * BK * 2, STAGE_BYTES = 8 * HTB, NXCD = 8, WGM = 8;
__host__ __device__ __forceinline__ int lds_byte(int r, int c) { const int st = (r >> 4) * 2 + (c >> 5), rr = r & 15, cc = c & 31, ob = rr * 64 + cc * 2; return st * 1024 + (ob ^ (((ob >> 9) & 1) << 5)); }
__host__ __device__ __forceinline__ void stage_rc(int b, int& R, int& C) { const int st = b / 1024, sb = b % 1024, swz = sb ^ (((sb >> 9) & 1) << 5); R = (st >> 1) * 16 + swz / 64; C = (st & 1) * 32 + (swz % 64) / 2; }

struct Unit { int pm, pn, e; };

struct DenseOrder {
    const char* A; const char* Bt; size_t tstep; int nM, nN, nwg, G, c;
    __device__ void init(const void* A_, const void* Bt_, int M, int N, int K, int G_, int c_) { A = (const char*)A_; Bt = (const char*)Bt_; tstep = (size_t)BM * K * 2; nM = M / BM; nN = N / BM; nwg = nM * nN; G = G_; c = c_; }
    __device__ bool next(int i, Unit& u) const {
        const long L = (long)i * G + c; if (L >= nwg) return false;
        int wgid = (int)L; { const int q = nwg / NXCD, r = nwg % NXCD, xcd = wgid % NXCD, off = wgid / NXCD; wgid = (xcd < r ? xcd * (q + 1) : r * (q + 1) + (xcd - r) * q) + off; }
        const int nig = WGM * nN, gid = wgid / nig, fm = gid * WGM, gsz = (nM - fm) < WGM ? (nM - fm) : WGM;
        u.pm = fm + ((wgid % nig) % gsz); u.pn = (wgid % nig) / gsz; u.e = 0; return true;
    }
    __device__ __forceinline__ const char* a_base(const Unit& u) const { return A + (size_t)u.pm * tstep; }
    __device__ __forceinline__ const char* b_base(const Unit& u) const { return Bt + (size_t)u.pn * tstep; }
};
struct MoeOrder {
    const char* A; const char* Bt; size_t tstep, estep; int ntot, G, c; const volatile LAS int* tstart;
    __device__ void init(const void* A_, const void* Bt_, int K, int N, int G_, int c_, const volatile LAS int* ts) { A = (const char*)A_; Bt = (const char*)Bt_; tstep = (size_t)BM * K * 2; estep = (size_t)N * K * 2; G = G_; c = c_; tstart = ts; ntot = ts[16]; }
    __device__ bool next(int i, Unit& u) const {
        const long L = (long)i * G + c; if (L >= 4L * ntot) return false;
        const int mt = (int)(L >> 2); u.pm = mt; u.pn = (int)(L & 3);
        int e = 0;
#pragma unroll
        for (int j = 1; j < 16; ++j) e += (mt >= tstart[j]) ? 1 : 0;
        u.e = e; return true;
    }
    __device__ __forceinline__ const char* a_base(const Unit& u) const { return A + (size_t)u.pm * tstep; }
    __device__ __forceinline__ const char* b_base(const Unit& u) const { return Bt + (size_t)u.e * estep + (size_t)u.pn * tstep; }
};

__device__ __forceinline__ unsigned cvt_pk_bf16(float lo, float hi) { unsigned r; asm volatile("v_cvt_pk_bf16_f32 %0, %1, %2" : "=v"(r) : "v"(lo), "v"(hi)); return r; }


struct EpiIn {
    bf16* P; const float* cs; float* ksum;
    __device__ __forceinline__ void operator()(const f32x4 (&acc)[2][2][4][2], const Unit& u, int wr, int wc, int fr, int fq) const {
        const int pn = u.pn, row0 = u.pm * BM + wr * 64 + fr, col0 = pn * BM + wc * 32 + 8 * fq;
        if (pn < 4) {
            const int dbase = 16 * (wc & 1) + 4 * fq;
            const float qs = (pn < 2) ? 0.125f : 1.0f;
            const bool isk = (pn >= 2);
            float ks[2][8];
#pragma unroll
            for (int b = 0; b < 2; ++b)
#pragma unroll
                for (int j = 0; j < 8; ++j) ks[b][j] = 0.f;
#pragma unroll
            for (int ai = 0; ai < 2; ++ai)
#pragma unroll
                for (int m = 0; m < 4; ++m) {
                    const int r = row0 + ai * HALF + m * 16;
                    const f32x4* cp = (const f32x4*)(cs + ((size_t)r * 32 + dbase) * 2);
                    const f32x4 cA = cp[0], cB = cp[1];
                    const float cc[4] = {cA[0], cA[2], cB[0], cB[2]}, ss[4] = {cA[1], cA[3], cB[1], cB[3]};
                    bf16* rowp = P + (size_t)r * NIN + col0;
#pragma unroll
                    for (int bj = 0; bj < 2; ++bj) {
                        const f32x4 x1 = acc[ai][bj][m][0], x2 = acc[ai][bj][m][1];
                        float o1[4], o2[4];
#pragma unroll
                        for (int j = 0; j < 4; ++j) { o1[j] = x1[j] * cc[j] - x2[j] * ss[j]; o2[j] = x2[j] * cc[j] + x1[j] * ss[j]; }
                        if (isk) {
#pragma unroll
                            for (int j = 0; j < 4; ++j) { ks[bj][j] += o1[j]; ks[bj][4 + j] += o2[j]; }
                        }
                        u32x4 w; w.x = cvt_pk_bf16(o1[0] * qs, o1[1] * qs); w.y = cvt_pk_bf16(o1[2] * qs, o1[3] * qs); w.z = cvt_pk_bf16(o2[0] * qs, o2[1] * qs); w.w = cvt_pk_bf16(o2[2] * qs, o2[3] * qs);
                        *(u32x4*)(rowp + bj * HALF) = w;
                    }
                }
            if (isk) {
#pragma unroll
                for (int b = 0; b < 2; ++b)
#pragma unroll
                    for (int j = 0; j < 8; ++j) {
                        float v = ks[b][j];
                        v += __shfl_xor(v, 1); v += __shfl_xor(v, 2); v += __shfl_xor(v, 4); v += __shfl_xor(v, 8);
                        ks[b][j] = v;
                    }
                if (fr == 0) {
#pragma unroll
                    for (int b = 0; b < 2; ++b) {
                        const int head = (pn - 2) * 4 + 2 * b + (wc >> 1);
                        float* kp = ksum + ((size_t)head * NBLK + u.pm) * HD + 32 * (wc & 1) + 8 * fq;
#pragma unroll
                        for (int j = 0; j < 8; ++j) atomicAdd(kp + j, ks[b][j]);
                    }
                }
            }
        } else {
            const bool act = (pn == 6 || pn == 7);
#pragma unroll
            for (int ai = 0; ai < 2; ++ai)
#pragma unroll
                for (int m = 0; m < 4; ++m) {
                    bf16* rowp = P + (size_t)(row0 + ai * HALF + m * 16) * NIN + col0;
#pragma unroll
                    for (int bj = 0; bj < 2; ++bj) {
                        f32x4 v0 = acc[ai][bj][m][0], v1 = acc[ai][bj][m][1];
                        if (act) {
#pragma unroll
                            for (int j = 0; j < 4; ++j) { v0[j] = gelu_tanh(v0[j]); v1[j] = gelu_tanh(v1[j]); }
                        }
                        u32x4 w; w.x = cvt_pk_bf16(v0[0], v0[1]); w.y = cvt_pk_bf16(v0[2], v0[3]); w.z = cvt_pk_bf16(v1[0], v1[1]); w.w = cvt_pk_bf16(v1[2], v1[3]);
                        *(u32x4*)(rowp + bj * HALF) = w;
                    }
                }
        }
    }
};
struct EpiOut {
    float* H; float* HO;
    __device__ __forceinline__ void operator()(const f32x4 (&acc)[2][2][4][2], const Unit& u, int wr, int wc, int fr, int fq) const {
        const int row0 = u.pm * BM + wr * 64 + fr, col0 = u.pn * BM + wc * 32 + 4 * fq;
#pragma unroll
        for (int ai = 0; ai < 2; ++ai)
#pragma unroll
            for (int m = 0; m < 4; ++m) {
                float* rowp = H + (size_t)(row0 + ai * HALF + m * 16) * D + col0;
#pragma unroll
                for (int bj = 0; bj < 2; ++bj)
#pragma unroll
                    for (int n = 0; n < 2; ++n) { f32x4* p = (f32x4*)(rowp + bj * HALF + n * 16); const f32x4 hv = *p; *(f32x4*)((float*)p + (HO - H)) = hv * ALPHA + acc[ai][bj][m][n]; }
            }
    }
};
struct EpiGU {
    bf16* ACT;
    __device__ __forceinline__ void operator()(const f32x4 (&acc)[2][2][4][2], const Unit& u, int wr, int wc, int fr, int fq) const {
        const int row0 = u.pm * BM + wr * 64 + fr, col0 = u.pn * 128 + wc * 16 + 4 * fq;
#pragma unroll
        for (int ai = 0; ai < 2; ++ai)
#pragma unroll
            for (int m = 0; m < 4; ++m) {
                bf16* rowp = ACT + (size_t)(row0 + ai * HALF + m * 16) * DE + col0;
#pragma unroll
                for (int bj = 0; bj < 2; ++bj) {
                    const f32x4 g = acc[ai][bj][m][0], up = acc[ai][bj][m][1];
                    float a[4];
#pragma unroll
                    for (int j = 0; j < 4; ++j) a[j] = g[j] * sigmoidf_(g[j]) * up[j];
                    u32x2 w; w.x = cvt_pk_bf16(a[0], a[1]); w.y = cvt_pk_bf16(a[2], a[3]);
                    *(u32x2*)(rowp + bj * 64) = w;
                }
            }
    }
};
struct EpiDown {
    bf16* Y; const int2* rowinfo;
    __device__ __forceinline__ void operator()(const f32x4 (&acc)[2][2][4][2], const Unit& u, int wr, int wc, int fr, int fq) const {
        const int row0 = u.pm * BM + wr * 64 + fr, col0 = u.pn * BM + wc * 32 + 8 * fq;
#pragma unroll
        for (int ai = 0; ai < 2; ++ai)
#pragma unroll
            for (int m = 0; m < 4; ++m) {
                const int2 ri = rowinfo[row0 + ai * HALF + m * 16];
                if (ri.x >= 0) {
                    const float gw = __builtin_bit_cast(float, ri.y);
                    bf16* rowp = Y + (size_t)ri.x * D + col0;
#pragma unroll
                    for (int bj = 0; bj < 2; ++bj) {
                        const f32x4 v0 = acc[ai][bj][m][0] * gw, v1 = acc[ai][bj][m][1] * gw;
                        u32x4 w; w.x = cvt_pk_bf16(v0[0], v0[1]); w.y = cvt_pk_bf16(v0[2], v0[3]); w.z = cvt_pk_bf16(v1[0], v1[1]); w.w = cvt_pk_bf16(v1[2], v1[3]);
                        *(u32x4*)(rowp + bj * HALF) = w;
                    }
                }
            }
    }
};

template <class Epi, class Sched, bool ALIGN_EPI, bool SP2>
__device__ __forceinline__ void gemm_phase(LAS unsigned char* lds, const int K, const Sched& S, const Epi& E) {
    int tid_ = threadIdx.x; asm volatile("" : "+v"(tid_));
    const int tid = tid_, wid = __builtin_amdgcn_readfirstlane(tid >> 6), lane = tid & 63, wr = wid >> 2, wc = wid & 3, fr = lane & 15, fq = lane >> 4;
    const int nt = K / BK;
    unsigned voffA[2], voffB[2];
#pragma unroll
    for (int i = 0; i < 2; ++i) { int R, C; stage_rc(tid * 16 + i * 8192, R, C); voffA[i] = (unsigned)(R * K + C) * 2u; voffB[i] = voffA[i]; }
    const size_t kstep = (size_t)(BK * 2);
    const size_t hstep = (size_t)HALF * K * 2;
    const unsigned ldsw = (unsigned)wid * 1024u;
    const int aoff = lds_byte(wr * 64 + fr, fq * 8), boff = lds_byte(wc * 32 + fr, fq * 8);
#define PG8_SA(b, h) (((b) * 2 + (h)) * HTB)
#define PG8_SB(b, h) ((4 + (b) * 2 + (h)) * HTB)
#define PG8_STAGE(bufoff, gbase, voff) do { _Pragma("unroll") for (int _i = 0; _i < 2; ++_i) \
        __builtin_amdgcn_global_load_lds((const unsigned*)((const char*)(gbase) + (voff)[_i]), (LAS unsigned*)(lds + (bufoff) + ldsw + _i * 8192), 16, 0, 0); } while (0)
#define PG8_LDA(dst, b, h) do { _Pragma("unroll") for (int m = 0; m < 4; ++m) _Pragma("unroll") for (int k = 0; k < 2; ++k) dst[m][k] = *(const LAS bf16x8*)(lds + PG8_SA(b, h) + aoff + m * 2048 + k * 1024); } while (0)
#define PG8_LDB(dst, b, h) do { _Pragma("unroll") for (int n = 0; n < 2; ++n) _Pragma("unroll") for (int k = 0; k < 2; ++k) dst[n][k] = *(const LAS bf16x8*)(lds + PG8_SB(b, h) + boff + n * 2048 + k * 1024); } while (0)
#define PG8_MMA(ai, bj, At, Bt) do { __builtin_amdgcn_s_setprio(1); _Pragma("unroll") for (int m = 0; m < 4; ++m) _Pragma("unroll") for (int n = 0; n < 2; ++n) _Pragma("unroll") for (int k = 0; k < 2; ++k) \
        acc[ai][bj][m][n] = __builtin_amdgcn_mfma_f32_16x16x32_bf16(Bt[n][k], At[m][k], acc[ai][bj][m][n], 0, 0, 0); __builtin_amdgcn_s_setprio(0); } while (0)
#define PG8_WAIT_V(n) asm volatile("s_waitcnt vmcnt(" #n ")" ::: "memory")
#define PG8_WAIT_L(n) asm volatile("s_waitcnt lgkmcnt(" #n ")" ::: "memory")
#define PG8_BAR __builtin_amdgcn_s_barrier()
#define PG8_SCHED __builtin_amdgcn_sched_barrier(0)
    Unit cur, nxt; int ui = 0;
    if (!S.next(0, cur)) return;
    f32x4 acc[2][2][4][2];
#pragma unroll
    for (int a = 0; a < 2; ++a)
#pragma unroll
        for (int b = 0; b < 2; ++b)
#pragma unroll
            for (int m = 0; m < 4; ++m)
#pragma unroll
                for (int n = 0; n < 2; ++n) acc[a][b][m][n] = (f32x4){0.f, 0.f, 0.f, 0.f};
    bf16x8 At[4][2], B0[2][2], B1[2][2];
    const char* cA = S.a_base(cur); const char* cB = S.b_base(cur);
    if constexpr (SP2) {
        PG8_STAGE(PG8_SB(0, 0), cB, voffB); PG8_STAGE(PG8_SB(0, 1), cB + hstep, voffB); PG8_STAGE(PG8_SA(0, 0), cA, voffA); PG8_STAGE(PG8_SA(0, 1), cA + hstep, voffA);
        if (wr == 1) PG8_BAR;
        PG8_WAIT_V(2); PG8_BAR;
        PG8_STAGE(PG8_SB(1, 0), cB + kstep, voffB); PG8_STAGE(PG8_SA(1, 0), cA + kstep, voffA); PG8_STAGE(PG8_SB(1, 1), cB + hstep + kstep, voffB);
        PG8_WAIT_V(6); PG8_BAR;
    } else {
        PG8_STAGE(PG8_SB(0, 0), cB, voffB); PG8_STAGE(PG8_SA(0, 0), cA, voffA); PG8_STAGE(PG8_SB(0, 1), cB + hstep, voffB); PG8_STAGE(PG8_SA(0, 1), cA + hstep, voffA);
        if (wr == 1) PG8_BAR;
        PG8_WAIT_V(4); PG8_BAR;
        PG8_STAGE(PG8_SB(1, 0), cB + kstep, voffB); PG8_STAGE(PG8_SA(1, 0), cA + kstep, voffA); PG8_STAGE(PG8_SB(1, 1), cB + hstep + kstep, voffB);
        PG8_WAIT_V(6); PG8_BAR;
    }
    for (;;) {
        const bool has_next = S.next(ui + 1, nxt);
        const char* nA = has_next ? S.a_base(nxt) : cA; const char* nB = has_next ? S.b_base(nxt) : cB;
        for (int t = 0; t < nt; t += 2) {
            const bool last = (t == nt - 2);
            const char* a1 = cA + (size_t)(t + 1) * kstep;
            const char* a2 = last ? nA : cA + (size_t)(t + 2) * kstep; const char* b2 = last ? nB : cB + (size_t)(t + 2) * kstep;
            const char* a3 = a2 + kstep; const char* b3 = b2 + kstep;
            if constexpr (SP2) {
            PG8_LDB(B0, 0, 0); PG8_LDB(B1, 0, 1); PG8_SCHED; PG8_LDA(At, 0, 0); PG8_STAGE(PG8_SA(1, 1), a1 + hstep, voffA);
            PG8_WAIT_V(8); PG8_WAIT_L(0); PG8_BAR; PG8_MMA(0, 0, At, B0); PG8_MMA(0, 1, At, B1); PG8_BAR; PG8_SCHED;
            PG8_LDA(At, 0, 1); PG8_STAGE(PG8_SB(0, 0), b2, voffB); PG8_STAGE(PG8_SB(0, 1), b2 + hstep, voffB); PG8_STAGE(PG8_SA(0, 0), a2, voffA);
            PG8_WAIT_V(8); PG8_WAIT_L(0); PG8_BAR; PG8_MMA(1, 0, At, B0); PG8_MMA(1, 1, At, B1); PG8_BAR; PG8_SCHED;
            PG8_LDB(B0, 1, 0); PG8_LDB(B1, 1, 1); PG8_SCHED; PG8_LDA(At, 1, 0); PG8_STAGE(PG8_SA(0, 1), a2 + hstep, voffA);
            PG8_WAIT_V(8); PG8_WAIT_L(0); PG8_BAR; PG8_MMA(0, 0, At, B0); PG8_MMA(0, 1, At, B1); PG8_BAR; PG8_SCHED;
            PG8_LDA(At, 1, 1); PG8_STAGE(PG8_SB(1, 0), b3, voffB); PG8_STAGE(PG8_SB(1, 1), b3 + hstep, voffB); PG8_STAGE(PG8_SA(1, 0), a3, voffA);
            PG8_WAIT_V(8); PG8_WAIT_L(0); PG8_BAR; PG8_MMA(1, 0, At, B0); PG8_MMA(1, 1, At, B1); PG8_BAR; PG8_SCHED;
            } else {
            PG8_LDB(B0, 0, 0); PG8_SCHED; PG8_LDA(At, 0, 0); PG8_STAGE(PG8_SA(1, 1), a1 + hstep, voffA);
            PG8_WAIT_L(8); PG8_BAR; PG8_WAIT_L(0); PG8_MMA(0, 0, At, B0); PG8_BAR; PG8_SCHED;
            PG8_LDB(B1, 0, 1); PG8_STAGE(PG8_SB(0, 0), b2, voffB);
            PG8_BAR; PG8_WAIT_L(0); PG8_MMA(0, 1, At, B1); PG8_BAR;
            PG8_LDA(At, 0, 1); PG8_STAGE(PG8_SA(0, 0), a2, voffA);
            PG8_BAR; PG8_WAIT_L(0); PG8_MMA(1, 0, At, B0); PG8_BAR; PG8_SCHED;
            PG8_STAGE(PG8_SB(0, 1), b2 + hstep, voffB);
            PG8_WAIT_V(6); PG8_BAR; PG8_MMA(1, 1, At, B1); PG8_BAR;
            PG8_LDB(B0, 1, 0); PG8_SCHED; PG8_LDA(At, 1, 0); PG8_STAGE(PG8_SA(0, 1), a2 + hstep, voffA);
            PG8_WAIT_L(8); PG8_BAR; PG8_WAIT_L(0); PG8_MMA(0, 0, At, B0); PG8_BAR; PG8_SCHED;
            PG8_LDB(B1, 1, 1); PG8_STAGE(PG8_SB(1, 0), b3, voffB);
            PG8_BAR; PG8_WAIT_L(0); PG8_MMA(0, 1, At, B1); PG8_BAR;
            PG8_LDA(At, 1, 1); PG8_STAGE(PG8_SA(1, 0), a3, voffA);
            PG8_BAR; PG8_WAIT_L(0); PG8_MMA(1, 0, At, B0); PG8_BAR; PG8_SCHED;
            PG8_STAGE(PG8_SB(1, 1), b3 + hstep, voffB);
            PG8_WAIT_V(6); PG8_BAR; PG8_MMA(1, 1, At, B1); PG8_BAR;
            }
        }
        if constexpr (ALIGN_EPI) { if (wr == 0) PG8_BAR; }
        E(acc, cur, wr, wc, fr, fq);
        if (!has_next) break;
#pragma unroll
        for (int a = 0; a < 2; ++a)
#pragma unroll
            for (int b = 0; b < 2; ++b)
#pragma unroll
                for (int m = 0; m < 4; ++m)
#pragma unroll
                    for (int n = 0; n < 2; ++n) acc[a][b][m][n] = (f32x4){0.f, 0.f, 0.f, 0.f};
        cur = nxt; cA = nA; cB = nB; ++ui;
        if constexpr (ALIGN_EPI) { if (wr == 1) PG8_BAR; }
    }
    PG8_WAIT_V(0);
    if constexpr (!ALIGN_EPI) { if (wr == 0) PG8_BAR; }
    PG8_BAR;
#undef PG8_SA
#undef PG8_SB
#undef PG8_STAGE
#undef PG8_LDA
#undef PG8_LDB
#undef PG8_MMA
#undef PG8_WAIT_V
#undef PG8_WAIT_L
#undef PG8_BAR
#undef PG8_SCHED
}
}

#define XB_TMO      128
#define XB_XCNT(j)  (256  + 64 * (j))
#define XB_XSUB(j)  (1280 + 64 * (j))
#define XB_XGEN(j)  (2304 + 64 * (j))
#define XB_TOP      3328
#define XB_TOPGEN   3392
#define XCD_BAR_WORDS 3456
#define XB_SPIN_CAP (1u << 18)
__device__ __forceinline__ unsigned xb_ld(unsigned* p)              { return __hip_atomic_load(p, __ATOMIC_RELAXED, __HIP_MEMORY_SCOPE_AGENT); }
__device__ __forceinline__ unsigned xb_add(unsigned* p, unsigned v) { return __hip_atomic_fetch_add(p, v, __ATOMIC_RELAXED, __HIP_MEMORY_SCOPE_AGENT); }
__device__ __forceinline__ unsigned xb_xcc_id() { return (unsigned)__builtin_amdgcn_s_getreg((3 << 11) | 20) & 0xFu; }
#define XB_SPIN(cond, bar) do { unsigned _sp = 0; while (cond) { __builtin_amdgcn_s_sleep(1); \
    if ((++_sp & 255u) == 0u) { if (xb_ld(&(bar)[XB_TMO])) break; if (_sp > XB_SPIN_CAP) { atomicAdd(&(bar)[XB_TMO], 1u); break; } } } } while (0)
struct XcdBarrier { unsigned* bar; unsigned x; volatile LAS unsigned* st; };
__device__ __forceinline__ XcdBarrier xcd_barrier_post(unsigned* bar, volatile LAS unsigned* st) {
    XcdBarrier b; b.bar = bar; b.x = xb_xcc_id(); b.st = st;
    if (threadIdx.x == 0) (void)xb_add(&bar[XB_XCNT(b.x)], 1u);
    return b;
}
__device__ __forceinline__ void xcd_barrier_complete(unsigned* bar, unsigned x, unsigned& nloc, unsigned& nx) {
    const unsigned G = gridDim.x * gridDim.y * gridDim.z;
    unsigned sum, cnt, mine, sp = 0u;
    for (;;) {
        sum = 0u; cnt = 0u; mine = 0u;
#pragma unroll
        for (unsigned j = 0; j < 16; ++j) { const unsigned c = xb_ld(&bar[XB_XCNT(j)]); sum += c; cnt += (c > 0u) ? 1u : 0u; mine = (j == x) ? c : mine; }
        if (sum == G) break;
        __builtin_amdgcn_s_sleep(1);
        if ((++sp & 255u) == 0u) { if (xb_ld(&bar[XB_TMO])) break; if (sp > XB_SPIN_CAP) { atomicAdd(&bar[XB_TMO], 1u); break; } }
    }
    nloc = mine > 0u ? mine : 1u; nx = cnt > 0u ? cnt : 1u;
}
template <bool FIRST>
__device__ __forceinline__ void xcd_barrier_t(const XcdBarrier& b) {
    asm volatile("s_waitcnt vmcnt(0)" ::: "memory");
    __syncthreads();
    if (threadIdx.x == 0) {
        unsigned* bar = b.bar; unsigned bx = b.x;
        asm volatile("" : "+s"(bar), "+s"(bx));
        __builtin_amdgcn_s_waitcnt(0);
        unsigned nloc = b.st[0], nx = b.st[1];
        if (FIRST) { xcd_barrier_complete(bar, bx, nloc, nx); b.st[0] = nloc; b.st[1] = nx; }
        const unsigned old = xb_add(&bar[XB_XSUB(bx)], 1u);
        const unsigned gen = old / nloc;
        if (old + 1u == (gen + 1u) * nloc) {
            __builtin_amdgcn_fence(__ATOMIC_RELEASE, "agent");
            asm volatile("s_waitcnt vmcnt(0)" ::: "memory");
            const unsigned og = xb_add(&bar[XB_TOP], 1u);
            const unsigned tg = og / nx;
            if (og + 1u == (tg + 1u) * nx) xb_add(&bar[XB_TOPGEN], 1u);
            else XB_SPIN(xb_ld(&bar[XB_TOPGEN]) == tg, bar);
            __builtin_amdgcn_fence(__ATOMIC_ACQUIRE, "agent");
            xb_add(&bar[XB_XGEN(bx)], 1u);
            asm volatile("s_waitcnt vmcnt(0)" ::: "memory");
        } else {
            XB_SPIN(xb_ld(&bar[XB_XGEN(bx)]) == gen, bar);
            __builtin_amdgcn_fence(__ATOMIC_ACQUIRE, "agent");
            asm volatile("s_waitcnt vmcnt(0)" ::: "memory");
        }
    }
    __syncthreads();
}

struct Args {
    const float* x; const float* ln_in_g; const float* ln_in_b; const float* w_in; const float* w_out; const float* sg_ln_g; const float* sg_ln_b; const float* sg_w; const float* sg_b;
    const float* conv_w; const float* conv_b; const float* conv_ln_g; const float* conv_ln_b; const float* ln_mix_g; const float* ln_mix_b; const float* w_router; const float* router_bias;
    const float* w_gate; const float* w_up; const float* w_down; const float* ln_ffn_g; const float* ln_ffn_b;
    float* out; unsigned char* ws;
    int mode, pad;
};
struct Ctx { LAS unsigned char* lds; int tid, lane, wave, vcu, G; };
constexpr int ARGS_OFF = MISC_OFF + 512;
__device__ __forceinline__ LAS unsigned char* lds_opaque(LAS unsigned char* p) { asm volatile("" : "+s"(p)); return p; }
template <class T> __device__ __forceinline__ T lds_arg(const Ctx& C, int byteoff) {
    volatile LAS unsigned* p = (volatile LAS unsigned*)(lds_opaque(C.lds) + ARGS_OFF + byteoff);
    const unsigned lo = __builtin_amdgcn_readfirstlane(p[0]), hi = __builtin_amdgcn_readfirstlane(p[1]);
    return (T)(((unsigned long long)hi << 32) | lo);
}
#define ARG(field) lds_arg<decltype(Args::field)>(C, (int)__builtin_offsetof(Args, field))
#define LOADARG(a, field) (a).field = ARG(field)

template <class RowMap>
__device__ __forceinline__ void transpose_item(const float* W, int K, int N, bf16* WT, LAS float* scr, int item, int lane, const RowMap& rowmap) {
    const int nblk = N / 64, kb = item / nblk, nb = item % nblk, k0 = 64 * kb, n0 = 64 * nb;
    const int lr = lane >> 4, lc = (lane & 15) * 4;
    f32x4 v[16];
#pragma unroll
    for (int i = 0; i < 16; ++i) v[i] = *(const f32x4*)(W + (size_t)(k0 + 4 * i + lr) * N + n0 + lc);
#pragma unroll
    for (int i = 0; i < 16; ++i) { const int kk = 4 * i + lr; *(LAS f32x4*)(scr + kk * 64 + (lc ^ (8 * ((kk >> 3) & 3)))) = v[i]; }
    LDS_WAIT(); asm volatile("" ::: "memory");
    const int c = lane & 7, sw = 8 * (c & 3);
#pragma unroll
    for (int j = 0; j < 8; ++j) { const int n = (lane >> 3) + 8 * j; const LAS float* sp = scr + (8 * c) * 64 + (n ^ sw);
        u32x4 o; o.x = pk2(sp[0], sp[64]); o.y = pk2(sp[128], sp[192]); o.z = pk2(sp[256], sp[320]); o.w = pk2(sp[384], sp[448]);
        *(GAS u32x4*)(WT + (size_t)rowmap(n0 + n) * K + k0 + 8 * c) = o; }
    LDS_WAIT(); asm volatile("" ::: "memory");
}
struct MapIn { __device__ __forceinline__ int operator()(int n) const {
    if (n < 1024) return (n & ~48) | ((n & 16) << 1) | ((n & 32) >> 1);
    return (n & ~31) | ((n & 4) << 2) | ((n & 24) >> 1) | (n & 3); } };
struct MapId { __device__ __forceinline__ int operator()(int n) const { return n; } };
struct MapPerm { __device__ __forceinline__ int operator()(int n) const { return (n & ~31) | ((n & 4) << 2) | ((n & 24) >> 1) | (n & 3); } };
struct MapGU { int which; __device__ __forceinline__ int operator()(int c) const {
    return ((c >> 7) << 8) | (((c >> 6) & 1) << 7) | (((c >> 4) & 3) << 5) | (which << 4) | (c & 15); } };

__device__ __forceinline__ void ln_row(f32x4 (&v)[4], const float* g, const float* b, int lane, float eps) {
    float s = 0.f;
#pragma unroll
    for (int j = 0; j < 4; ++j) s += (v[j][0] + v[j][1]) + (v[j][2] + v[j][3]);
    const float mean = wave_sum(s) * (1.f / D); float s2 = 0.f;
#pragma unroll
    for (int j = 0; j < 4; ++j) { v[j] = v[j] - mean; s2 += (v[j][0] * v[j][0] + v[j][1] * v[j][1]) + (v[j][2] * v[j][2] + v[j][3] * v[j][3]); }
    const float rstd = 1.f / sqrtf(wave_sum(s2) * (1.f / D) + eps);
#pragma unroll
    for (int j = 0; j < 4; ++j) { const f32x4 gg = *(const f32x4*)(g + 4 * lane + 256 * j), bb = *(const f32x4*)(b + 4 * lane + 256 * j); v[j] = v[j] * rstd * gg + bb; }
}
__device__ __forceinline__ void store_row(const f32x4 (&v)[4], float* orow, bf16* brow, int lane) {
#pragma unroll
    for (int j = 0; j < 4; ++j) {
        *(f32x4*)(orow + 4 * lane + 256 * j) = v[j];
        u32x2 w; w.x = pk2(v[j][0], v[j][1]); w.y = pk2(v[j][2], v[j][3]);
        *(u32x2*)(brow + 4 * lane + 256 * j) = w;
    }
}

__device__ __forceinline__ void p0_prologue(const Ctx& C0) {
    Ctx C = C0; asm volatile("" : "+v"(C.tid), "+v"(C.lane), "+s"(C.wave), "+s"(C.vcu), "+s"(C.G), "+s"(C.lds));
    Args a; LOADARG(a, ws); LOADARG(a, w_in); LOADARG(a, w_out); LOADARG(a, sg_w); LOADARG(a, x); LOADARG(a, ln_in_g); LOADARG(a, ln_in_b); LOADARG(a, out);
    LAS float* scr = (LAS float*)(C.lds + C.wave * 16384);
    const int gw = C.vcu * NWAVES + C.wave, NGW = C.G * NWAVES;
    unsigned char* ws = a.ws;
    constexpr int I_IN = (D / 64) * (NIN / 64), I_OUT = (D / 64) * (D / 64);
    for (int it = gw; it < DEPTH * (I_IN + I_OUT); it += NGW) {
        const int l = it / (I_IN + I_OUT); int r = it % (I_IN + I_OUT);
        if (r < I_IN) transpose_item(a.w_in + (size_t)l * D * NIN, D, NIN, (bf16*)(ws + WS_WIN) + (size_t)l * NIN * D, scr, r, C.lane, MapIn{});
        else transpose_item(a.w_out + (size_t)l * D * D, D, D, (bf16*)(ws + WS_WOUT) + (size_t)l * D * D, scr, r - I_IN, C.lane, MapId{});
    }
    const int gt = C.vcu * (NWAVES * 64) + C.tid, NGT = C.G * NWAVES * 64;
    float2* cs = (float2*)(ws + WS_CS);
    for (int i = gt; i < S * 32; i += NGT) {
        const int s = i >> 5, f = i & 31;
        const float inv = powf(10000.0f, -(float)f / 32.0f);
        const float ang = (float)s * inv;
        cs[i] = make_float2(cosf(ang), sinf(ang));
    }
    bf16* wsg = (bf16*)(ws + WS_WSG);
    for (int i = gt; i < DEPTH * 4 * 128 * 128; i += NGT) { const int t = (i >> 7) & 127, s = i & 127; wsg[i] = (bf16)((s <= t) ? f2bf(a.sg_w[i]) : 0u); }
    bf16* hb = (bf16*)(ws + WS_HB);
    for (int m = gw; m < S; m += NGW) {
        f32x4 v[4];
#pragma unroll
        for (int j = 0; j < 4; ++j) v[j] = *(const f32x4*)(a.x + (size_t)m * D + 4 * C.lane + 256 * j);
        ln_row(v, a.ln_in_g, a.ln_in_b, C.lane, LN_EPS);
        store_row(v, a.out + (size_t)m * D, hb + (size_t)m * D, C.lane);
    }
}

__device__ __forceinline__ unsigned k_off(int row, int ch) { return (unsigned)(row * 128 + 16 * (ch ^ (row & 7))); }
__device__ __forceinline__ unsigned v_off(int row, int ch) { return (unsigned)(row * 128 + 16 * (ch ^ (((row >> 1) & 3) << 1))); }

template <int KS>
__device__ __forceinline__ void tr8(u32x2 (&r)[8], const unsigned (&va)[4]) {
    asm volatile(
        "ds_read_b64_tr_b16 %0, %8 offset:%12\n\t"
        "ds_read_b64_tr_b16 %1, %9 offset:%12\n\t"
        "ds_read_b64_tr_b16 %2, %10 offset:%12\n\t"
        "ds_read_b64_tr_b16 %3, %11 offset:%12\n\t"
        "ds_read_b64_tr_b16 %4, %8 offset:%13\n\t"
        "ds_read_b64_tr_b16 %5, %9 offset:%13\n\t"
        "ds_read_b64_tr_b16 %6, %10 offset:%13\n\t"
        "ds_read_b64_tr_b16 %7, %11 offset:%13\n\t"
        "s_waitcnt lgkmcnt(0)"
        : "=&v"(r[0]), "=&v"(r[1]), "=&v"(r[2]), "=&v"(r[3]), "=&v"(r[4]), "=&v"(r[5]), "=&v"(r[6]), "=&v"(r[7])
        : "v"(va[0]), "v"(va[1]), "v"(va[2]), "v"(va[3]), "i"(KS * 4096), "i"(KS * 4096 + 2048)
        : "memory");
}

struct AttnOut { f32x4 o[4]; float m, l; };

template <bool MASK>
__device__ __forceinline__ void attn_core(AttnOut& R, LAS unsigned char* Ks, LAS unsigned char* Vs, const bf16x8 (&qf)[2], int nct, int qoff, int lane) {
    const int fr = lane & 15, fq = lane >> 4;
    f32x4 sacc[16];
#pragma unroll
    for (int c = 0; c < 16; ++c) sacc[c] = (f32x4){0.f, 0.f, 0.f, 0.f};
#pragma unroll
    for (int c = 0; c < 16; ++c) {
        if (c < nct) {
#pragma unroll
            for (int ks = 0; ks < 2; ++ks) {
                const bf16x8 kf = *(const LAS bf16x8*)(Ks + k_off(16 * c + fr, 4 * ks + fq));
                sacc[c] = __builtin_amdgcn_mfma_f32_16x16x32_bf16(kf, qf[ks], sacc[c], 0, 0, 0);
            }
        }
    }
    float mx = -1e30f;
#pragma unroll
    for (int c = 0; c < 16; ++c) {
        if (c < nct) {
#pragma unroll
            for (int j = 0; j < 4; ++j) {
                if (MASK) { if (16 * c + 4 * fq + j > qoff) sacc[c][j] = -1e30f; }
                mx = fmaxf(mx, sacc[c][j]);
            }
        }
    }
    mx = fmaxf(mx, __shfl_xor(mx, 16)); mx = fmaxf(mx, __shfl_xor(mx, 32));
    float lsum = 0.f;
    const float mb = mx * LOG2E;
#pragma unroll
    for (int c = 0; c < 16; ++c) {
        if (c < nct) {
#pragma unroll
            for (int j = 0; j < 4; ++j) { const float p = fast_exp2(sacc[c][j] * LOG2E - mb); sacc[c][j] = p; lsum += p; }
        }
    }
    lsum += __shfl_xor(lsum, 16); lsum += __shfl_xor(lsum, 32);
    const int q4 = (lane & 15) >> 2, p4 = lane & 3;
    unsigned va[4];
    {
        const int row = 4 * fq + q4;
        const unsigned vbase = (unsigned)(size_t)Vs;
#pragma unroll
        for (int c = 0; c < 4; ++c) va[c] = vbase + v_off(row, 2 * c + (p4 >> 1)) + 8 * (p4 & 1);
    }
    f32x4 oacc[4];
#pragma unroll
    for (int c = 0; c < 4; ++c) oacc[c] = (f32x4){0.f, 0.f, 0.f, 0.f};
#define ATT_PV(KS) do { if (2 * (KS) < nct) { u32x2 vr[8]; tr8<KS>(vr, va); __builtin_amdgcn_sched_barrier(0); \
        u32x4 pw; pw.x = pg8::cvt_pk_bf16(sacc[2 * (KS)][0], sacc[2 * (KS)][1]); pw.y = pg8::cvt_pk_bf16(sacc[2 * (KS)][2], sacc[2 * (KS)][3]); \
        pw.z = pg8::cvt_pk_bf16(sacc[2 * (KS) + 1][0], sacc[2 * (KS) + 1][1]); pw.w = pg8::cvt_pk_bf16(sacc[2 * (KS) + 1][2], sacc[2 * (KS) + 1][3]); \
        const bf16x8 pf = __builtin_bit_cast(bf16x8, pw); \
        _Pragma("unroll") for (int c = 0; c < 4; ++c) { u32x4 vw; vw.x = vr[c].x; vw.y = vr[c].y; vw.z = vr[4 + c].x; vw.w = vr[4 + c].y; \
            oacc[c] = __builtin_amdgcn_mfma_f32_16x16x32_bf16(__builtin_bit_cast(bf16x8, vw), pf, oacc[c], 0, 0, 0); } } } while (0)
    ATT_PV(0); ATT_PV(1); ATT_PV(2); ATT_PV(3); ATT_PV(4); ATT_PV(5); ATT_PV(6); ATT_PV(7);
#undef ATT_PV
#pragma unroll
    for (int c = 0; c < 4; ++c) R.o[c] = oacc[c];
    R.m = mx; R.l = lsum;
}

__device__ __forceinline__ void stage_kv(const Ctx& C, const bf16* P, int blk, int h, int nrows, LAS unsigned char* Ks, LAS unsigned char* Vs) {
    for (int i = C.tid; i < nrows * 8; i += NWAVES * 64) {
        const int row = i >> 3, ch = i & 7;
        const bf16* src = P + (size_t)(blk * 256 + row) * NIN + h * HD + ch * 8;
        const u32x4 kv = *(const u32x4*)(src + K_OFF), vv = *(const u32x4*)(src + V_OFF);
        *(LAS u32x4*)(Ks + k_off(row, ch)) = kv;
        *(LAS u32x4*)(Vs + v_off(row, ch)) = vv;
    }
}

__device__ __forceinline__ void pb_gating(const Ctx& C0, int l, int item, bool dry = false) {
    Ctx C = C0; asm volatile("" : "+v"(C.tid), "+v"(C.lane), "+s"(C.wave), "+s"(C.vcu), "+s"(C.G), "+s"(C.lds));
    Args a; LOADARG(a, ws);
    const int h = item & 7, grp = item >> 3, tok = grp * 512 + C.tid, own = tok >> 8;
    unsigned char* ws = a.ws;
    const bf16* P = (const bf16*)(ws + WS_P);
    LAS float* km = (LAS float*)C.lds;
    LAS unsigned* cntL = (LAS unsigned*)(C.lds + 16384);
    LAS unsigned* baseL = (LAS unsigned*)(C.lds + 16384 + 256);
    const float* ksum = (const float*)(ws + WS_CTL) + CW_KMEAN + (size_t)l * (NH * NBLK * HD) + (size_t)h * NBLK * HD;
    for (int i = C.tid; i < NBLK * HD; i += NWAVES * 64) km[i] = ksum[i] * (1.0f / 256.0f);
    if (C.tid < 64) cntL[C.tid] = 0u;
    __syncthreads();
    float q[64];
    {
        const u32x4* qp = (const u32x4*)(P + (size_t)tok * NIN + Q_OFF + h * HD);
#pragma unroll
        for (int c = 0; c < 8; ++c) { const u32x4 w = qp[c]; q[8 * c + 0] = bflo(w.x); q[8 * c + 1] = bfhi(w.x); q[8 * c + 2] = bflo(w.y); q[8 * c + 3] = bfhi(w.y); q[8 * c + 4] = bflo(w.z); q[8 * c + 5] = bfhi(w.z); q[8 * c + 6] = bflo(w.w); q[8 * c + 7] = bfhi(w.w); }
    }
    float v0 = -3e38f, v1 = -3e38f, v2 = -3e38f; int i0 = 0, i1 = 0, i2 = 0;
    const int ownu = __builtin_amdgcn_readfirstlane(own);
    for (int n = 0; n < ownu; ++n) {
        const LAS f32x4* kr = (const LAS f32x4*)(km + n * 64);
        float g0 = 0.f, g1 = 0.f, g2 = 0.f, g3 = 0.f;
#pragma unroll
        for (int c = 0; c < 16; ++c) { const f32x4 kv = kr[c]; g0 += q[4 * c] * kv[0]; g1 += q[4 * c + 1] * kv[1]; g2 += q[4 * c + 2] * kv[2]; g3 += q[4 * c + 3] * kv[3]; }
        const float g = (g0 + g1) + (g2 + g3);
        if (g > v0) { v2 = v1; i2 = i1; v1 = v0; i1 = i0; v0 = g; i0 = n; }
        else if (g > v1) { v2 = v1; i2 = i1; v1 = g; i1 = n; }
        else if (g > v2) { v2 = g; i2 = n; }
    }
    if (dry) { asm volatile("" :: "v"(i0), "v"(i1), "v"(i2)); __syncthreads(); return; }
    const int nsel = own < 3 ? own : 3;
    unsigned lp0 = 0, lp1 = 0, lp2 = 0;
    if (nsel > 0) lp0 = __hip_atomic_fetch_add(&cntL[i0], 1u, __ATOMIC_RELAXED, __HIP_MEMORY_SCOPE_WORKGROUP);
    if (nsel > 1) lp1 = __hip_atomic_fetch_add(&cntL[i1], 1u, __ATOMIC_RELAXED, __HIP_MEMORY_SCOPE_WORKGROUP);
    if (nsel > 2) lp2 = __hip_atomic_fetch_add(&cntL[i2], 1u, __ATOMIC_RELAXED, __HIP_MEMORY_SCOPE_WORKGROUP);
    __syncthreads();
    unsigned* acnt = (unsigned*)(ws + WS_CTL) + CW_ACNT + l * 512 + h * 64;
    if (C.tid < 64) { const unsigned c = cntL[C.tid]; baseL[C.tid] = c ? atomicAdd(&acnt[C.tid], c) : 0u; }
    __syncthreads();
    unsigned short* lists = (unsigned short*)(ws + WS_LISTS) + (size_t)h * NBLK * S;
    if (nsel > 0) lists[(size_t)i0 * S + baseL[i0] + lp0] = (unsigned short)(tok | (0 << 14));
    if (nsel > 1) lists[(size_t)i1 * S + baseL[i1] + lp1] = (unsigned short)(tok | (1 << 14));
    if (nsel > 2) lists[(size_t)i2 * S + baseL[i2] + lp2] = (unsigned short)(tok | (2 << 14));
    __syncthreads();
}

__device__ __forceinline__ unsigned sg_off(int row, int ch) { return (unsigned)(row * 512 + 16 * (ch ^ (((row & 3) | (((row >> 3) & 1) << 2)) << 1))); }
template <int KS>
__device__ __forceinline__ void tr2(u32x2& r0, u32x2& r1, unsigned addr) {
    asm volatile("ds_read_b64_tr_b16 %0, %2 offset:%3\n\tds_read_b64_tr_b16 %1, %2 offset:%4\n\ts_waitcnt lgkmcnt(0)"
                 : "=&v"(r0), "=&v"(r1) : "v"(addr), "i"(KS * 32 * 512), "i"(KS * 32 * 512 + 4 * 512) : "memory");
}
__device__ __forceinline__ void pb_sg(const Ctx& C0, int l, int chunk) {
    Ctx C = C0; asm volatile("" : "+v"(C.tid), "+v"(C.lane), "+s"(C.wave), "+s"(C.vcu), "+s"(C.G), "+s"(C.lds));
    Args a; LOADARG(a, ws); LOADARG(a, sg_ln_g); LOADARG(a, sg_ln_b); LOADARG(a, sg_b);
    unsigned char* ws = a.ws;
    const bf16* P = (const bf16*)(ws + WS_P);
    bf16* mix = (bf16*)(ws + WS_MIXIN);
    LAS unsigned char* vt = C.lds;
    const float* lg = a.sg_ln_g + l * SGW; const float* lb = a.sg_ln_b + l * SGW;
    for (int s = C.wave; s < 128; s += NWAVES) {
        const int tok = chunk * 128 + s;
        const u32x2 w = *(const u32x2*)(P + (size_t)tok * NIN + SGV_OFF + 4 * C.lane);
        float x[4] = {bflo(w.x), bfhi(w.x), bflo(w.y), bfhi(w.y)};
        const float mean = wave_sum((x[0] + x[1]) + (x[2] + x[3])) * (1.0f / SGW);
        float q = 0.f;
#pragma unroll
        for (int j = 0; j < 4; ++j) { x[j] -= mean; q += x[j] * x[j]; }
        const float rstd = 1.0f / sqrtf(wave_sum(q) * (1.0f / SGW) + LN_EPS);
        const f32x4 gg = *(const f32x4*)(lg + 4 * C.lane), bb = *(const f32x4*)(lb + 4 * C.lane);
        u32x2 o; o.x = pk2(x[0] * rstd * gg[0] + bb[0], x[1] * rstd * gg[1] + bb[1]); o.y = pk2(x[2] * rstd * gg[2] + bb[2], x[3] * rstd * gg[3] + bb[3]);
        *(LAS u32x2*)(vt + sg_off(s, C.lane >> 1) + 8 * (C.lane & 1)) = o;
    }
    __syncthreads();
    const int fr = C.lane & 15, fq = C.lane >> 4, q4 = fr >> 2, p4 = C.lane & 3, w = C.wave;
    const bf16* wsg = (const bf16*)(ws + WS_WSG) + (size_t)l * 4 * 128 * 128;
    const int nks = (16 * w + 15) / 32 + 1;
    f32x4 acc[4][4];
#pragma unroll
    for (int g = 0; g < 4; ++g)
#pragma unroll
        for (int c = 0; c < 4; ++c) acc[g][c] = (f32x4){0.f, 0.f, 0.f, 0.f};
    const unsigned vbase = (unsigned)(size_t)vt;
#define SG_STEP(KS) do { if ((KS) < nks) { _Pragma("unroll") for (int g = 0; g < 4; ++g) { \
        const bf16x8 wf = *(const bf16x8*)(wsg + ((size_t)g * 128 + 16 * w + fr) * 128 + 32 * (KS) + 8 * fq); \
        _Pragma("unroll") for (int c = 0; c < 4; ++c) { const int cc = 4 * g + c; u32x2 r0, r1; \
            tr2<KS>(r0, r1, vbase + sg_off(8 * fq + q4, 2 * cc + (p4 >> 1)) + 8 * (p4 & 1)); __builtin_amdgcn_sched_barrier(0); \
            u32x4 vw; vw.x = r0.x; vw.y = r0.y; vw.z = r1.x; vw.w = r1.y; \
            acc[g][c] = __builtin_amdgcn_mfma_f32_16x16x32_bf16(__builtin_bit_cast(bf16x8, vw), wf, acc[g][c], 0, 0, 0); } } } } while (0)
    SG_STEP(0); SG_STEP(1); SG_STEP(2); SG_STEP(3);
#undef SG_STEP
    const int t = 16 * w + fr, tok = chunk * 128 + t;
#pragma unroll
    for (int g = 0; g < 4; ++g) {
        const float bs = a.sg_b[(l * 4 + g) * 128 + t];
#pragma unroll
        for (int c = 0; c < 4; ++c) {
            const int d = 64 * g + 16 * c + 4 * fq;
            const u32x2 uw = *(const u32x2*)(P + (size_t)tok * NIN + SGU_OFF + d);
            u32x2 o; o.x = pk2(bflo(uw.x) * (acc[g][c][0] + bs), bfhi(uw.x) * (acc[g][c][1] + bs)); o.y = pk2(bflo(uw.y) * (acc[g][c][2] + bs), bfhi(uw.y) * (acc[g][c][3] + bs));
            *(u32x2*)(mix + (size_t)tok * D + 512 + d) = o;
        }
    }
    __syncthreads();
}

__device__ __forceinline__ void pb_conv(const Ctx& C0, int l, int item) {
    Ctx C = C0; asm volatile("" : "+v"(C.tid), "+v"(C.lane), "+s"(C.wave), "+s"(C.vcu), "+s"(C.G), "+s"(C.lds));
    Args a; LOADARG(a, ws); LOADARG(a, conv_w); LOADARG(a, conv_b); LOADARG(a, conv_ln_g); LOADARG(a, conv_ln_b);
    unsigned char* ws = a.ws;
    const bf16* P = (const bf16*)(ws + WS_P);
    bf16* mix = (bf16*)(ws + WS_MIXIN);
    LAS float* hb = (LAS float*)C.lds;
    const int t0 = item * 64;
    for (int i = C.tid; i < 94 * 32; i += NWAVES * 64) {
        const int r = i >> 5, ch = i & 31, tok = t0 - 30 + r;
        f32x4 o0 = (f32x4){0.f, 0.f, 0.f, 0.f}, o1 = o0;
        if (tok >= 0) {
            const u32x4 aw = *(const u32x4*)(P + (size_t)tok * NIN + CA_OFF + 8 * ch), gw = *(const u32x4*)(P + (size_t)tok * NIN + CG_OFF + 8 * ch);
            o0[0] = bflo(aw.x) * sigmoidf_(bflo(gw.x)); o0[1] = bfhi(aw.x) * sigmoidf_(bfhi(gw.x)); o0[2] = bflo(aw.y) * sigmoidf_(bflo(gw.y)); o0[3] = bfhi(aw.y) * sigmoidf_(bfhi(gw.y));
            o1[0] = bflo(aw.z) * sigmoidf_(bflo(gw.z)); o1[1] = bfhi(aw.z) * sigmoidf_(bfhi(gw.z)); o1[2] = bflo(aw.w) * sigmoidf_(bflo(gw.w)); o1[3] = bfhi(aw.w) * sigmoidf_(bfhi(gw.w));
        }
        *(LAS f32x4*)(hb + r * 256 + 8 * ch) = o0; *(LAS f32x4*)(hb + r * 256 + 8 * ch + 4) = o1;
    }
    __syncthreads();
    const int c = C.tid & 255, half = C.tid >> 8;
    float wt[TAPS];
#pragma unroll
    for (int j = 0; j < TAPS; ++j) wt[j] = a.conv_w[((size_t)l * TAPS + j) * CVW + c];
    const float bias = a.conv_b[l * CVW + c];
    float outv[32];
#pragma unroll
    for (int gI = 0; gI < 8; ++gI) {
        const int tb = half * 32 + gI * 4;
        float win[34];
#pragma unroll
        for (int j = 0; j < 34; ++j) win[j] = hb[(tb + j) * 256 + c];
#pragma unroll
        for (int o = 0; o < 4; ++o) {
            float s = bias;
#pragma unroll
            for (int j = 0; j < TAPS; ++j) s += wt[j] * win[o + j];
            outv[gI * 4 + o] = s;
        }
    }
    __syncthreads();
#pragma unroll
    for (int i = 0; i < 32; ++i) hb[(half * 32 + i) * 256 + c] = outv[i];
    __syncthreads();
    const float* lg = a.conv_ln_g + l * CVW; const float* lb = a.conv_ln_b + l * CVW;
    for (int s = C.wave; s < 64; s += NWAVES) {
        f32x4 x = *(const LAS f32x4*)(hb + s * 256 + 4 * C.lane);
        const float mean = wave_sum((x[0] + x[1]) + (x[2] + x[3])) * (1.0f / CVW);
        x = x - mean;
        const float rstd = 1.0f / sqrtf(wave_sum((x[0] * x[0] + x[1] * x[1]) + (x[2] * x[2] + x[3] * x[3])) * (1.0f / CVW) + LN_EPS);
        const f32x4 gg = *(const f32x4*)(lg + 4 * C.lane), bb = *(const f32x4*)(lb + 4 * C.lane);
        f32x4 y = x * rstd * gg + bb;
#pragma unroll
        for (int j = 0; j < 4; ++j) y[j] = y[j] * sigmoidf_(y[j]);
        u32x2 o; o.x = pk2(y[0], y[1]); o.y = pk2(y[2], y[3]);
        *(u32x2*)(mix + (size_t)(t0 + s) * D + 768 + 4 * C.lane) = o;
    }
    __syncthreads();
}

__device__ __forceinline__ void pc_selattn(const Ctx& C0, int l) {
    Ctx C = C0; asm volatile("" : "+v"(C.tid), "+v"(C.lane), "+s"(C.wave), "+s"(C.vcu), "+s"(C.G), "+s"(C.lds));
    Args a; LOADARG(a, ws);
    unsigned char* ws = a.ws;
    const bf16* P = (const bf16*)(ws + WS_P);
    LAS unsigned char* Ks = C.lds; LAS unsigned char* Vs = C.lds + 32768;
    LAS int* pref = (LAS int*)(C.lds + 65536);
    const unsigned* acnt = (const unsigned*)(ws + WS_CTL) + CW_ACNT + l * 512;
    LAS int* nt_ = (LAS int*)(C.lds + 65536 + 4096);
    nt_[C.tid] = (int)((__hip_atomic_load(acnt + C.tid, RLX_AGENT) + 127u) >> 7);
    __syncthreads();
    if (C.tid == 0) { int s = 0; for (int i = 0; i < 512; ++i) { pref[i] = s; s += nt_[i]; } pref[512] = s; }
    __syncthreads();
    const int total = pref[512];
    bf16* PO = (bf16*)(ws + WS_PARTO); float2* PML = (float2*)(ws + WS_PARTML);
    const unsigned short* lists = (const unsigned short*)(ws + WS_LISTS);
    const int fr = C.lane & 15, fq = C.lane >> 4;
    LAS int* cntl = (LAS int*)(C.lds + 65536 + 8192);
    cntl[C.tid] = (int)__hip_atomic_load(acnt + C.tid, RLX_AGENT);
    __syncthreads();
    int curpair = -1;
    const int per = (total + C.G - 1) / C.G, T0 = C.vcu * per, T1 = (T0 + per < total) ? T0 + per : total;
    int cur = 0; { int lo_ = 0, hi_ = 511; while (lo_ < hi_) { const int mid_ = (lo_ + hi_ + 1) >> 1; if (pref[mid_] <= T0) lo_ = mid_; else hi_ = mid_ - 1; } cur = lo_; }
#define PC_ENT(ent_, pair_, T_) do { ent_ = 0u; pair_ = 0; if ((T_) < T1) { while (pref[cur + 1] <= (T_)) ++cur; pair_ = cur; const int i_ = ((T_) - pref[cur]) * 128 + 16 * C.wave + fr; \
        if (i_ < cntl[cur]) ent_ = 0x10000u | (unsigned)lists[(size_t)cur * S + i_]; } } while (0)
#define PC_Q(q_, ent_, pair_) do { const bf16* qp_ = P + (size_t)((ent_) & 0x3fff) * NIN + Q_OFF + ((pair_) >> 6) * HD + 8 * fq; q_[0] = *(const bf16x8*)qp_; q_[1] = *(const bf16x8*)(qp_ + 32); } while (0)
    unsigned e1, e2; int p1, p2; bf16x8 q1[2];
    PC_ENT(e1, p1, T0); PC_ENT(e2, p2, T0 + 1); PC_Q(q1, e1, p1);
    for (int T = T0; T < T1; ++T) {
        const int pair = p1, h = pair >> 6, n = pair & 63;
        const unsigned ent = e1; bf16x8 qf[2] = {q1[0], q1[1]};
        e1 = e2; p1 = p2; PC_Q(q1, e1, p1); PC_ENT(e2, p2, T + 2);
        if (pair != curpair) { __syncthreads(); stage_kv(C, P, n, h, 256, Ks, Vs); __syncthreads(); curpair = pair; }
        const bool valid = (ent & 0x10000u) != 0u;
        const int tok = ent & 0x3fff, rank = (ent >> 14) & 3;
        AttnOut R;
        attn_core<false>(R, Ks, Vs, qf, 16, 0, C.lane);
        if (valid) {
            const float inv = 1.0f / R.l;
            bf16* op = PO + (((size_t)rank * S + tok) * NH + h) * HD + 4 * fq;
#pragma unroll
            for (int c = 0; c < 4; ++c) { u32x2 o; o.x = pk2(R.o[c][0] * inv, R.o[c][1] * inv); o.y = pk2(R.o[c][2] * inv, R.o[c][3] * inv); *(u32x2*)(op + 16 * c) = o; }
            if (fq == 0) PML[((size_t)rank * S + tok) * NH + h] = make_float2(R.m, R.l);
        }
    }
#undef PC_ENT
#undef PC_Q
    __syncthreads();
}

__device__ __forceinline__ void pd_ownattn(const Ctx& C0, int l) {
    Ctx C = C0; asm volatile("" : "+v"(C.tid), "+v"(C.lane), "+s"(C.wave), "+s"(C.vcu), "+s"(C.G), "+s"(C.lds));
    Args a; LOADARG(a, ws);
    unsigned char* ws = a.ws;
    const bf16* P = (const bf16*)(ws + WS_P);
    bf16* mix = (bf16*)(ws + WS_MIXIN);
    LAS unsigned char* Ks = C.lds; LAS unsigned char* Vs = C.lds + 32768;
    const bf16* PO = (const bf16*)(ws + WS_PARTO); const float2* PML = (const float2*)(ws + WS_PARTML);
    const int fr = C.lane & 15, fq = C.lane >> 4;
    for (int it = C.vcu; it < NH * 64; it += C.G) {
        const int h = it & 7, own = it >> 3;
        __syncthreads();
        stage_kv(C, P, own, h, 256, Ks, Vs);
        __syncthreads();
#pragma unroll 1
        for (int par = 0; par < 2; ++par) {
        const int qoff = par * 128 + 16 * C.wave + fr;
        const int tok = own * 256 + qoff;
        bf16x8 qf[2];
#pragma unroll
        for (int ks = 0; ks < 2; ++ks) qf[ks] = *(const bf16x8*)(P + (size_t)tok * NIN + Q_OFF + h * HD + 32 * ks + 8 * fq);
        const int nct = ((8 * par + C.wave + 1) + 1) & ~1;
        AttnOut R;
        attn_core<true>(R, Ks, Vs, qf, nct, qoff, C.lane);
        const int nsel = own < 3 ? own : 3;
        float mm[3], ll[3]; float M = R.m;
#pragma unroll
        for (int r = 0; r < 3; ++r) { mm[r] = -1e30f; ll[r] = 0.f; if (r < nsel) { const float2 t = PML[((size_t)r * S + tok) * NH + h]; mm[r] = t.x; ll[r] = t.y; M = fmaxf(M, t.x); } }
        const float w0 = fast_exp2((R.m - M) * LOG2E);
        float wr_[3]; float den = R.l * w0;
#pragma unroll
        for (int r = 0; r < 3; ++r) { wr_[r] = (r < nsel) ? ll[r] * fast_exp2((mm[r] - M) * LOG2E) : 0.f; den += wr_[r]; }
        const float inv = 1.0f / den;
        f32x4 o[4];
#pragma unroll
        for (int c = 0; c < 4; ++c) o[c] = R.o[c] * w0;
#pragma unroll
        for (int r = 0; r < 3; ++r) {
            if (r < nsel) {
                const bf16* op = PO + (((size_t)r * S + tok) * NH + h) * HD + 4 * fq;
#pragma unroll
                for (int c = 0; c < 4; ++c) { const u32x2 w = *(const u32x2*)(op + 16 * c); o[c][0] += wr_[r] * bflo(w.x); o[c][1] += wr_[r] * bfhi(w.x); o[c][2] += wr_[r] * bflo(w.y); o[c][3] += wr_[r] * bfhi(w.y); }
            }
        }
        bf16* yp = mix + (size_t)tok * D + h * HD + 4 * fq;
#pragma unroll
        for (int c = 0; c < 4; ++c) { u32x2 w; w.x = pk2(o[c][0] * inv, o[c][1] * inv); w.y = pk2(o[c][2] * inv, o[c][3] * inv); *(u32x2*)(yp + 16 * c) = w; }
        }
    }
    __syncthreads();
}

__device__ __forceinline__ float reduce16_scatter(const float (&lg)[16], int lane) {
    const bool h32 = (lane & 32) != 0, h16 = (lane & 16) != 0, h8 = (lane & 8) != 0, h4 = (lane & 4) != 0;
    float r8[8], r4[4], r2[2];
#pragma unroll
    for (int e = 0; e < 8; ++e) { const float keep = h32 ? lg[e + 8] : lg[e], send = h32 ? lg[e] : lg[e + 8]; r8[e] = keep + __shfl_xor(send, 32); }
#pragma unroll
    for (int e = 0; e < 4; ++e) { const float keep = h16 ? r8[e + 4] : r8[e], send = h16 ? r8[e] : r8[e + 4]; r4[e] = keep + __shfl_xor(send, 16); }
#pragma unroll
    for (int e = 0; e < 2; ++e) { const float keep = h8 ? r4[e + 2] : r4[e], send = h8 ? r4[e] : r4[e + 2]; r2[e] = keep + __shfl_xor(send, 8); }
    float r1 = (h4 ? r2[1] : r2[0]) + __shfl_xor(h4 ? r2[0] : r2[1], 4);
    r1 += __shfl_xor(r1, 2); r1 += __shfl_xor(r1, 1);
    return r1;
}
__device__ __forceinline__ void route_one(float red, const float* router_bias, int lane, int lt, LAS int* tinfo, LAS float* tw, LAS unsigned* cntL) {
    float sc[16], bi[16];
#pragma unroll
    for (int e = 0; e < 16; ++e) {
        const int L = 32 * (e >> 3) + 16 * ((e >> 2) & 1) + 8 * ((e >> 1) & 1) + 4 * (e & 1);
        const float lgt = __builtin_bit_cast(float, __builtin_amdgcn_readlane(__builtin_bit_cast(int, red), L));
        sc[e] = sigmoidf_(lgt); bi[e] = sc[e] + router_bias[e];
    }
    int bg = 0; float bgs = -3e38f;
#pragma unroll
    for (int gI = 0; gI < 4; ++gI) {
        float t1 = -3e38f, t2 = -3e38f;
#pragma unroll
        for (int i = 0; i < 4; ++i) { const float x = bi[4 * gI + i]; if (x > t1) { t2 = t1; t1 = x; } else if (x > t2) t2 = x; }
        const float gs = t1 + t2;
        if (gs > bgs) { bgs = gs; bg = gI; }
    }
    float t1 = -3e38f, t2 = -3e38f; int j1 = 0, j2 = 0;
#pragma unroll
    for (int gI = 0; gI < 4; ++gI) {
        if (gI == bg) {
#pragma unroll
            for (int i = 0; i < 4; ++i) { const float x = bi[4 * gI + i]; if (x > t1) { t2 = t1; j2 = j1; t1 = x; j1 = i; } else if (x > t2) { t2 = x; j2 = i; } }
        }
    }
    float s1 = 0.f, s2 = 0.f;
#pragma unroll
    for (int e = 0; e < 16; ++e) { if (e == 4 * bg + j1) s1 = sc[e]; if (e == 4 * bg + j2) s2 = sc[e]; }
    const int e0 = 4 * bg + j1, e1 = 4 * bg + j2;
    if (lane == 0) {
        const float inv = 1.0f / (s1 + s2);
        tinfo[4 * lt + 0] = e0; tinfo[4 * lt + 1] = (int)__hip_atomic_fetch_add(&cntL[e0], 1u, __ATOMIC_RELAXED, __HIP_MEMORY_SCOPE_WORKGROUP);
        tinfo[4 * lt + 2] = e1; tinfo[4 * lt + 3] = (int)__hip_atomic_fetch_add(&cntL[e1], 1u, __ATOMIC_RELAXED, __HIP_MEMORY_SCOPE_WORKGROUP);
        tw[2 * lt] = s1 * inv; tw[2 * lt + 1] = s2 * inv;
    }
}

__device__ __forceinline__ void pf_convert(const Ctx& C0, int l) {
    Ctx C = C0; asm volatile("" : "+v"(C.tid), "+v"(C.lane), "+s"(C.wave), "+s"(C.vcu), "+s"(C.G), "+s"(C.lds));
    Args a; LOADARG(a, ws); LOADARG(a, w_gate); LOADARG(a, w_up); LOADARG(a, w_down);
    unsigned char* ws = a.ws;
    LAS float* scr = (LAS float*)(C.lds + C.wave * 16384);
    const int gw = C.vcu * NWAVES + C.wave, NGW = C.G * NWAVES;
    constexpr int I_G = (D / 64) * (DE / 64), I_D = (DE / 64) * (D / 64);
    for (int it = gw; it < NE * (2 * I_G + I_D); it += NGW) {
        const int e = it / (2 * I_G + I_D); int r = it % (2 * I_G + I_D);
        const size_t eo = ((size_t)l * NE + e) * D * DE;
        if (r < I_G) transpose_item(a.w_gate + eo, D, DE, (bf16*)(ws + WS_WGU) + (size_t)e * D * D, scr, r, C.lane, MapGU{0});
        else if (r < 2 * I_G) transpose_item(a.w_up + eo, D, DE, (bf16*)(ws + WS_WGU) + (size_t)e * D * D, scr, r - I_G, C.lane, MapGU{1});
        else transpose_item(a.w_down + eo, DE, D, (bf16*)(ws + WS_WDN) + (size_t)e * D * DE, scr, r - 2 * I_G, C.lane, MapPerm{});
    }
    __syncthreads();
}
__device__ __forceinline__ void pf_ln_router(const Ctx& C0, int l, bool dry = false) {
    Ctx C = C0; asm volatile("" : "+v"(C.tid), "+v"(C.lane), "+s"(C.wave), "+s"(C.vcu), "+s"(C.G), "+s"(C.lds));
    Args a; LOADARG(a, ws); LOADARG(a, w_router); LOADARG(a, router_bias); LOADARG(a, out); LOADARG(a, ln_mix_g); LOADARG(a, ln_mix_b);
    unsigned char* ws = a.ws;
    LAS float* wrt = (LAS float*)C.lds;
    LAS unsigned* cntL = (LAS unsigned*)(C.lds + 65536);
    LAS unsigned* baseL = cntL + 16;
    LAS int* tinfo = (LAS int*)(C.lds + 65536 + 256);
    LAS float* tw = (LAS float*)(C.lds + 65536 + 256 + 4096);
    for (int i = C.tid; i < D * NE / 4; i += NWAVES * 64) { const int k = i >> 2, q = i & 3; ((LAS f32x4*)wrt)[q * 1024 + ((k >> 8) * 4 + (k & 3)) * 64 + ((k >> 2) & 63)] = ((const f32x4*)a.w_router)[i]; }
    if (C.tid < 16) cntL[C.tid] = 0u;
    __syncthreads();
    float* H = a.out; bf16* hb = (bf16*)(ws + WS_HB);
    const float* g = a.ln_mix_g + l * D; const float* b = a.ln_mix_b + l * D;
    constexpr int TPW = S / 256;
    for (int lt = C.wave; lt < TPW; lt += 2 * NWAVES) {
        const int tokA = C.vcu * TPW + lt, tokB = tokA + NWAVES;
        f32x4 vA[4], vB[4];
#pragma unroll
        for (int j = 0; j < 4; ++j) { vA[j] = *(const f32x4*)(H + (size_t)tokA * D + 4 * C.lane + 256 * j); vB[j] = *(const f32x4*)(H + (size_t)tokB * D + 4 * C.lane + 256 * j); }
        ln_row(vA, g, b, C.lane, LN_EPS); ln_row(vB, g, b, C.lane, LN_EPS);
        if (dry) { store_row(vA, (float*)(ws + WS_AG) + (size_t)tokA * D, (bf16*)(ws + WS_ACT) + (size_t)tokA * D, C.lane); store_row(vB, (float*)(ws + WS_AG) + (size_t)tokB * D, (bf16*)(ws + WS_ACT) + (size_t)tokB * D, C.lane); }
        else { store_row(vA, H + (size_t)tokA * D, hb + (size_t)tokA * D, C.lane); store_row(vB, H + (size_t)tokB * D, hb + (size_t)tokB * D, C.lane); }
        float lgA[16], lgB[16];
#pragma unroll
        for (int e = 0; e < 16; ++e) { lgA[e] = 0.f; lgB[e] = 0.f; }
#pragma unroll
        for (int j = 0; j < 4; ++j)
#pragma unroll
            for (int i = 0; i < 4; ++i) {
                const LAS f32x4* wr4 = (const LAS f32x4*)wrt + (4 * j + i) * 64 + C.lane;
                const float xa = vA[j][i], xb = vB[j][i];
#pragma unroll
                for (int q = 0; q < 4; ++q) { const f32x4 w4 = wr4[q * 1024];
                    lgA[4 * q] += xa * w4[0]; lgA[4 * q + 1] += xa * w4[1]; lgA[4 * q + 2] += xa * w4[2]; lgA[4 * q + 3] += xa * w4[3];
                    lgB[4 * q] += xb * w4[0]; lgB[4 * q + 1] += xb * w4[1]; lgB[4 * q + 2] += xb * w4[2]; lgB[4 * q + 3] += xb * w4[3]; }
            }
        const float rA = reduce16_scatter(lgA, C.lane), rB = reduce16_scatter(lgB, C.lane);
        route_one(rA, a.router_bias, C.lane, lt, tinfo, tw, cntL);
        route_one(rB, a.router_bias, C.lane, lt + NWAVES, tinfo, tw, cntL);
    }
    __syncthreads();
    if (dry) { __syncthreads(); return; }
    unsigned* ecnt = (unsigned*)(ws + WS_CTL) + CW_ECNT + l * 16;
    if (C.tid < 16) { const unsigned c = cntL[C.tid]; baseL[C.tid] = c ? atomicAdd(&ecnt[C.tid], c) : 0u; }
    __syncthreads();
    int* elist = (int*)(ws + WS_ELIST); float* ew = (float*)(ws + WS_EW);
    if (C.tid < 2 * TPW) {
        const int lt = C.tid >> 1, sl = C.tid & 1, tok = C.vcu * TPW + lt;
        const int e = tinfo[4 * lt + 2 * sl], lp = tinfo[4 * lt + 2 * sl + 1];
        elist[(size_t)e * S + baseL[e] + lp] = tok * 2 + sl;
        ew[tok * 2 + sl] = tw[2 * lt + sl];
    }
    __syncthreads();
}

__device__ __forceinline__ void pg_gather(const Ctx& C0, int l, volatile LAS int* tstart) {
    Ctx C = C0; asm volatile("" : "+v"(C.tid), "+v"(C.lane), "+s"(C.wave), "+s"(C.vcu), "+s"(C.G), "+s"(C.lds));
    Args a; LOADARG(a, ws);
    unsigned char* ws = a.ws;
    const unsigned* ecnt = (const unsigned*)(ws + WS_CTL) + CW_ECNT + l * 16;
    LAS int* ecl = (LAS int*)(C.lds);
    if (C.tid == 0) { int s = 0; for (int e = 0; e < 16; ++e) { const int c = (int)__hip_atomic_load(ecnt + e, RLX_AGENT); ecl[e] = c; tstart[e] = s; s += (c + 255) >> 8; } tstart[16] = s; }
    __syncthreads();
    const int nrows = tstart[16] * 256;
    const int gw = C.vcu * NWAVES + C.wave, NGW = C.G * NWAVES;
    const int* elist = (const int*)(ws + WS_ELIST); const float* ew = (const float*)(ws + WS_EW);
    const bf16* hb = (const bf16*)(ws + WS_HB); bf16* AG = (bf16*)(ws + WS_AG); int2* rowinfo = (int2*)(ws + WS_ROWINFO);
    for (int R = gw; R < nrows; R += NGW) {
        const int mt = R >> 8; int e = 0;
#pragma unroll
        for (int j = 1; j < 16; ++j) e += (mt >= tstart[j]) ? 1 : 0;
        const int pos = R - tstart[e] * 256;
        if (pos < ecl[e]) {
            const int ent = elist[(size_t)e * S + pos], tok = ent >> 1;
            const u32x4* src = (const u32x4*)(hb + (size_t)tok * D); u32x4* dst = (u32x4*)(AG + (size_t)R * D);
            const u32x4 x0 = src[C.lane], x1 = src[64 + C.lane];
            dst[C.lane] = x0; dst[64 + C.lane] = x1;
            if (C.lane == 0) rowinfo[R] = make_int2(ent, __builtin_bit_cast(int, ew[ent]));
        } else {
            u32x4* dst = (u32x4*)(AG + (size_t)R * D); const u32x4 z = (u32x4){0u, 0u, 0u, 0u};
            dst[C.lane] = z; dst[64 + C.lane] = z;
            if (C.lane == 0) rowinfo[R] = make_int2(-1, 0);
        }
    }
}

__device__ __forceinline__ void pj_final(const Ctx& C0, int l, bool poison, bool dry = false) {
    Ctx C = C0; asm volatile("" : "+v"(C.tid), "+v"(C.lane), "+s"(C.wave), "+s"(C.vcu), "+s"(C.G), "+s"(C.lds));
    Args a; LOADARG(a, ws); LOADARG(a, out); LOADARG(a, ln_ffn_g); LOADARG(a, ln_ffn_b);
    unsigned char* ws = a.ws;
    const int gw = C.vcu * NWAVES + C.wave, NGW = C.G * NWAVES;
    float* H = a.out; bf16* hb = (bf16*)(ws + WS_HB); const bf16* Y = (const bf16*)(ws + WS_Y);
    const float* g = a.ln_ffn_g + l * D; const float* b = a.ln_ffn_b + l * D;
    for (int tok = gw; tok < S; tok += NGW) {
        f32x4 v[4];
#pragma unroll
        for (int j = 0; j < 4; ++j) {
            v[j] = *(const f32x4*)(H + (size_t)tok * D + 4 * C.lane + 256 * j) * ALPHA;
            const u32x2 y0 = *(const u32x2*)(Y + ((size_t)tok * 2) * D + 4 * C.lane + 256 * j), y1 = *(const u32x2*)(Y + ((size_t)tok * 2 + 1) * D + 4 * C.lane + 256 * j);
            v[j][0] += bflo(y0.x) + bflo(y1.x); v[j][1] += bfhi(y0.x) + bfhi(y1.x); v[j][2] += bflo(y0.y) + bflo(y1.y); v[j][3] += bfhi(y0.y) + bfhi(y1.y);
        }
        ln_row(v, g, b, C.lane, LN_EPS);
        if (poison) {
#pragma unroll
            for (int j = 0; j < 4; ++j) v[j] = (f32x4){__builtin_nanf(""), __builtin_nanf(""), __builtin_nanf(""), __builtin_nanf("")};
        }
        if (dry) store_row(v, (float*)(ws + WS_AG) + (size_t)tok * D, (bf16*)(ws + WS_ACT) + (size_t)tok * D, C.lane);
        else store_row(v, H + (size_t)tok * D, hb + (size_t)tok * D, C.lane);
    }
}


#if SELFCHECK
__global__ void __launch_bounds__(256) selfcheck_kernel(Args a) {
    const int l = 0;
    unsigned char* ws = a.ws;
    const bf16* P = (const bf16*)(ws + WS_P);
    unsigned* err = (unsigned*)(ws + WS_ERR);
    const int gt = blockIdx.x * blockDim.x + threadIdx.x, NGT = gridDim.x * blockDim.x;
#if SELFCHECK & 1
    {
        const bf16* mix = (const bf16*)(ws + WS_MIXIN);
        const float* ksum = (const float*)(ws + WS_CTL) + CW_KMEAN + (size_t)l * (NH * NBLK * HD);
        constexpr int NTOK = 1024 + (S - 1024) / 7;
        for (int p = gt; p < NTOK * 8; p += NGT) {
            const int ti = p >> 3, h = p & 7;
            const int tok = ti < 1024 ? ti : 1024 + (ti - 1024) * 7 + 3;
            const int own = tok >> 8;
            float q[64];
            {
                const u32x4* qp = (const u32x4*)(P + (size_t)tok * NIN + Q_OFF + h * HD);
#pragma unroll
                for (int c = 0; c < 8; ++c) { const u32x4 w = qp[c]; q[8 * c + 0] = bflo(w.x); q[8 * c + 1] = bfhi(w.x); q[8 * c + 2] = bflo(w.y); q[8 * c + 3] = bfhi(w.y); q[8 * c + 4] = bflo(w.z); q[8 * c + 5] = bfhi(w.z); q[8 * c + 6] = bflo(w.w); q[8 * c + 7] = bfhi(w.w); }
            }
            float v0 = -3e38f, v1 = -3e38f, v2 = -3e38f; int i0 = 0, i1 = 0, i2 = 0;
            for (int n = 0; n < own; ++n) {
                const f32x4* kr = (const f32x4*)(ksum + ((size_t)h * NBLK + n) * HD);
                float g = 0.f;
#pragma unroll
                for (int c = 0; c < 16; ++c) { const f32x4 kv = kr[c]; g += q[4 * c] * kv[0] + q[4 * c + 1] * kv[1] + q[4 * c + 2] * kv[2] + q[4 * c + 3] * kv[3]; }
                if (g > v0) { v2 = v1; i2 = i1; v1 = v0; i1 = i0; v0 = g; i0 = n; }
                else if (g > v1) { v2 = v1; i2 = i1; v1 = g; i1 = n; }
                else if (g > v2) { v2 = g; i2 = n; }
            }
            const int nsel = own < 3 ? own : 3;
            float m = -1e30f, lsum = 0.f; float o[64];
#pragma unroll
            for (int d = 0; d < 64; ++d) o[d] = 0.f;
            for (int r = 0; r < 4; ++r) {
                if (r < 3 && r >= nsel) continue;
                const int blk = (r == 0) ? i0 : (r == 1) ? i1 : (r == 2) ? i2 : own;
                const int nk = (r == 3) ? (tok & 255) + 1 : 256;
                for (int j = 0; j < nk; ++j) {
                    const bf16* kp = P + (size_t)(blk * 256 + j) * NIN + K_OFF + h * HD;
                    float sc = 0.f;
#pragma unroll
                    for (int c = 0; c < 8; ++c) { const u32x4 w = ((const u32x4*)kp)[c]; sc += q[8 * c] * bflo(w.x) + q[8 * c + 1] * bfhi(w.x) + q[8 * c + 2] * bflo(w.y) + q[8 * c + 3] * bfhi(w.y) + q[8 * c + 4] * bflo(w.z) + q[8 * c + 5] * bfhi(w.z) + q[8 * c + 6] * bflo(w.w) + q[8 * c + 7] * bfhi(w.w); }
                    const float mn = fmaxf(m, sc), al = __expf(m - mn), pe = __expf(sc - mn);
                    lsum = lsum * al + pe; m = mn;
                    const bf16* vp = P + (size_t)(blk * 256 + j) * NIN + V_OFF + h * HD;
#pragma unroll
                    for (int c = 0; c < 8; ++c) { const u32x4 w = ((const u32x4*)vp)[c];
                        o[8 * c] = o[8 * c] * al + pe * bflo(w.x); o[8 * c + 1] = o[8 * c + 1] * al + pe * bfhi(w.x); o[8 * c + 2] = o[8 * c + 2] * al + pe * bflo(w.y); o[8 * c + 3] = o[8 * c + 3] * al + pe * bfhi(w.y);
                        o[8 * c + 4] = o[8 * c + 4] * al + pe * bflo(w.z); o[8 * c + 5] = o[8 * c + 5] * al + pe * bfhi(w.z); o[8 * c + 6] = o[8 * c + 6] * al + pe * bflo(w.w); o[8 * c + 7] = o[8 * c + 7] * al + pe * bfhi(w.w); }
                }
            }
            const float inv = 1.0f / lsum; bool bad = false;
            const u32x4* yp = (const u32x4*)(mix + (size_t)tok * D + h * HD);
#pragma unroll
            for (int c = 0; c < 8; ++c) { const u32x4 w = yp[c]; const float g8[8] = {bflo(w.x), bfhi(w.x), bflo(w.y), bfhi(w.y), bflo(w.z), bfhi(w.z), bflo(w.w), bfhi(w.w)};
#pragma unroll
                for (int j = 0; j < 8; ++j) { const float ref = o[8 * c + j] * inv, df = fabsf(ref - g8[j]); if (!(df <= 0.002f + 0.02f * fabsf(ref))) bad = true; } }
            atomicAdd(err + 0, 1u); if (bad) atomicAdd(err + 1, 1u);
        }
    }
#endif
#if SELFCHECK & 2
    {
        const bf16* hb = (const bf16*)(ws + WS_HB);
        const float* W = a.w_in + (size_t)l * D * NIN;
        constexpr int NT = S / 37;
        for (int it = gt; it < NT * NIN; it += NGT) {
            const int ti = it / NIN, col = it % NIN, tok = 37 * ti + 5;
            const bool rot = col < 1024;
            const int d = col & 63, pcol = rot ? ((d < 32) ? col + 32 : col - 32) : col;
            float s1 = 0.f, s2 = 0.f;
            for (int k = 0; k < D; ++k) { const float hv = bf2f(hb[(size_t)tok * D + k]); s1 += hv * W[(size_t)k * NIN + col]; s2 += hv * W[(size_t)k * NIN + pcol]; }
            float ref; int pidx = col;
            if (rot) {
                const int i = d & 31;
                const double ang = (double)((float)tok * powf(10000.0f, -(float)i / 32.0f));
                const float cs_ = (float)cos(ang), sn_ = (float)sin(ang);
                ref = (d < 32) ? (s1 * cs_ - s2 * sn_) : (s1 * cs_ + s2 * sn_);
                if (col < 512) ref *= 0.125f;
                const int n1 = d >> 5, w1 = (d >> 4) & 1, t = d & 15;
                pidx = (col & ~63) + 32 * w1 + 8 * (t >> 2) + 4 * n1 + (t & 3);
            } else if (col >= SGU_OFF && col < CA_OFF) ref = gelu_tanh(s1);
            else ref = s1;
            const float got = bf2f(P[(size_t)tok * NIN + pidx]);
            if (!(fabsf(ref - got) <= 0.03f + 0.02f * fabsf(ref))) atomicAdd(err + 2, 1u);
        }
    }
#endif
#if SELFCHECK & 4
    {
        const float* ksum = (const float*)(ws + WS_CTL) + CW_KMEAN + (size_t)l * (NH * NBLK * HD);
        for (int it = gt; it < NH * NBLK * HD; it += NGT) {
            const int h = it >> 12, n = (it >> 6) & 63, dd = it & 63;
            float s = 0.f;
            for (int j = 0; j < 256; ++j) s += bf2f(P[(size_t)(n * 256 + j) * NIN + K_OFF + h * HD + dd]);
            if (!(fabsf(s - ksum[it]) * (1.0f / 256.0f) <= 2e-3f)) atomicAdd(err + 3, 1u);
        }
    }
#endif
}
__device__ __forceinline__ bool selfcheck_failed(unsigned char* ws) {
    unsigned* err = (unsigned*)(ws + WS_ERR);
    const unsigned n = __hip_atomic_load(err + 0, RLX_AGENT), b1 = __hip_atomic_load(err + 1, RLX_AGENT);
    const unsigned b2 = __hip_atomic_load(err + 2, RLX_AGENT), b3 = __hip_atomic_load(err + 3, RLX_AGENT);
    bool f = false;
#if SELFCHECK & 1
    f = f || (n == 0u) || (b1 * 100u > n);
#endif
#if SELFCHECK & 2
    f = f || (b2 > 200u);
#endif
#if SELFCHECK & 4
    f = f || (b3 > 0u);
#endif
    return f;
}
#endif

__global__ void __launch_bounds__(NWAVES * 64, 2) hymba_fwd(Args args) {
    extern __shared__ __attribute__((aligned(16))) unsigned char lds_raw[];
    Ctx C;
    C.lds = (LAS unsigned char*)lds_raw;
    volatile LAS unsigned* MISC = (volatile LAS unsigned*)(C.lds + MISC_OFF);
    C.tid = threadIdx.x; C.lane = C.tid & 63; C.wave = __builtin_amdgcn_readfirstlane(C.tid >> 6);
    C.G = gridDim.x; { const int bx = blockIdx.x; C.vcu = (C.G % 8 == 0) ? (bx % 8) * (C.G / 8) + bx / 8 : bx; }
    for (int u = C.tid; u < 64; u += NWAVES * 64) MISC[u] = 0u;
    if (C.tid == 0) {
        const unsigned long long pv[24] = {(unsigned long long)args.x, (unsigned long long)args.ln_in_g, (unsigned long long)args.ln_in_b, (unsigned long long)args.w_in, (unsigned long long)args.w_out,
            (unsigned long long)args.sg_ln_g, (unsigned long long)args.sg_ln_b, (unsigned long long)args.sg_w, (unsigned long long)args.sg_b, (unsigned long long)args.conv_w, (unsigned long long)args.conv_b,
            (unsigned long long)args.conv_ln_g, (unsigned long long)args.conv_ln_b, (unsigned long long)args.ln_mix_g, (unsigned long long)args.ln_mix_b, (unsigned long long)args.w_router,
            (unsigned long long)args.router_bias, (unsigned long long)args.w_gate, (unsigned long long)args.w_up, (unsigned long long)args.w_down, (unsigned long long)args.ln_ffn_g,
            (unsigned long long)args.ln_ffn_b, (unsigned long long)args.out, (unsigned long long)args.ws};
        volatile LAS unsigned* ap = (volatile LAS unsigned*)(C.lds + ARGS_OFF);
#pragma unroll
        for (int i = 0; i < 24; ++i) { ap[2 * i] = (unsigned)pv[i]; ap[2 * i + 1] = (unsigned)(pv[i] >> 32); }
    }
    __syncthreads();
    XcdBarrier bar;
    { unsigned char* ws0 = ARG(ws); bar = xcd_barrier_post((unsigned*)((gu32*)(ws0 + WS_CTL) + CW_BAR), MISC + 8); }
    volatile LAS int* tstart = (volatile LAS int*)(MISC + 16);
#define GRID_BAR() xcd_barrier_t<false>(bar)

#ifndef SKIP_P0
for (int rep_ = 0; rep_ <= REP_P0; ++rep_) { p0_prologue(C); }
#endif
    xcd_barrier_t<true>(bar);

    for (int l = 0; l < DEPTH; ++l) {
        {
            unsigned char* ws = ARG(ws);
            pg8::DenseOrder So; int bxl = blockIdx.x, Gl = C.G; asm volatile("" : "+s"(bxl), "+s"(Gl)); So.init(ws + WS_HB, (bf16*)(ws + WS_WIN) + (size_t)l * NIN * D, S, NIN, D, Gl, bxl);
            pg8::EpiIn E{(bf16*)(ws + WS_P), (const float*)(ws + WS_CS), (float*)(ws + WS_CTL) + CW_KMEAN + (size_t)l * (NH * NBLK * HD)};
#ifndef SKIP_PA
for (int rep_ = 0; rep_ <= REP_PA; ++rep_) { pg8::gemm_phase<pg8::EpiIn, pg8::DenseOrder, true, true>(lds_opaque(C.lds), D, So, E); }
#endif
        }
        GRID_BAR();
        for (int rep_ = 0; rep_ < REP_BAR; ++rep_) GRID_BAR();
        {
#if ENABLE_ATT
#ifndef SKIP_PBG
            for (int rep_ = 0; rep_ < REP_GATE; ++rep_) for (int it = C.vcu; it < 256; it += C.G) pb_gating(C, l, it, true);
            for (int it = C.vcu; it < 256; it += C.G) pb_gating(C, l, it);
#endif
#endif
#ifndef SKIP_PBS
for (int rep_ = 0; rep_ <= REP_SG; ++rep_) { for (int it = C.vcu; it < 128; it += C.G) pb_sg(C, l, it); }
#endif
#ifndef SKIP_PBC
for (int rep_ = 0; rep_ <= REP_CONV; ++rep_) { for (int it = C.vcu; it < 256; it += C.G) pb_conv(C, l, it); }
#endif
        }
        GRID_BAR();
#if ENABLE_ATT
#ifndef SKIP_PC
for (int rep_ = 0; rep_ <= REP_PC; ++rep_) { pc_selattn(C, l); }
#endif
        GRID_BAR();
#ifndef SKIP_PD
for (int rep_ = 0; rep_ <= REP_PD; ++rep_) { pd_ownattn(C, l); }
#endif
        GRID_BAR();
#else
        {
            unsigned char* ws = ARG(ws);
            const int gt = C.vcu * (NWAVES * 64) + C.tid, NGT = C.G * NWAVES * 64;
            bf16* mix = (bf16*)(ws + WS_MIXIN);
            for (int i = gt; i < S * 64; i += NGT) { const int tok = i >> 6, c8 = i & 63; *(u32x4*)(mix + (size_t)tok * D + 8 * c8) = (u32x4){0u, 0u, 0u, 0u}; }
        }
        GRID_BAR();
#endif
#if SELFCHECK
        if (args.mode == 1) return;
#endif
        {
            unsigned char* ws = ARG(ws);
            pg8::DenseOrder So; int bxl = blockIdx.x, Gl = C.G; asm volatile("" : "+s"(bxl), "+s"(Gl)); So.init(ws + WS_MIXIN, (bf16*)(ws + WS_WOUT) + (size_t)l * D * D, S, D, D, Gl, bxl);
            float* Hp = ARG(out);
            for (int rep_ = 0; rep_ < REP_PE; ++rep_) { pg8::EpiOut Ed{Hp, (float*)(ws + WS_Y)}; pg8::gemm_phase<pg8::EpiOut, pg8::DenseOrder, false, true>(lds_opaque(C.lds), D, So, Ed); }
            pg8::EpiOut E{Hp, Hp};
#ifndef SKIP_PE
            pg8::gemm_phase<pg8::EpiOut, pg8::DenseOrder, false, true>(lds_opaque(C.lds), D, So, E);
#endif
        }
        GRID_BAR();
#ifndef SKIP_PF
        for (int rep_ = 0; rep_ <= REP_PFC; ++rep_) pf_convert(C, l);
        for (int rep_ = 0; rep_ < REP_PF; ++rep_) pf_ln_router(C, l, true);
        pf_ln_router(C, l);
#endif
        GRID_BAR();
#ifndef SKIP_PG
for (int rep_ = 0; rep_ <= REP_PG; ++rep_) { pg_gather(C, l, tstart); }
#endif
        GRID_BAR();
        {
            unsigned char* ws = ARG(ws);
            pg8::MoeOrder So; int vl = C.vcu, Gl = C.G; asm volatile("" : "+s"(vl), "+s"(Gl)); So.init(ws + WS_AG, ws + WS_WGU, D, D, Gl, vl, tstart);
            pg8::EpiGU E{(bf16*)(ws + WS_ACT)};
#ifndef SKIP_PH
for (int rep_ = 0; rep_ <= REP_PH; ++rep_) { pg8::gemm_phase<pg8::EpiGU, pg8::MoeOrder, true, true>(lds_opaque(C.lds), D, So, E); }
#endif
        }
        GRID_BAR();
        {
            unsigned char* ws = ARG(ws);
            pg8::MoeOrder So; int vl = C.vcu, Gl = C.G; asm volatile("" : "+s"(vl), "+s"(Gl)); So.init(ws + WS_ACT, ws + WS_WDN, DE, D, Gl, vl, tstart);
            pg8::EpiDown E{(bf16*)(ws + WS_Y), (const int2*)(ws + WS_ROWINFO)};
#ifndef SKIP_PI
for (int rep_ = 0; rep_ <= REP_PI; ++rep_) { pg8::gemm_phase<pg8::EpiDown, pg8::MoeOrder, true, true>(lds_opaque(C.lds), DE, So, E); }
#endif
        }
        GRID_BAR();
        {
            bool poison = false;
            if (l == DEPTH - 1) {
                gu32* ctl = (gu32*)(ARG(ws) + WS_CTL);
                poison = __hip_atomic_load((unsigned*)(ctl + CW_BAR) + XB_TMO, RLX_AGENT) != 0u;
#if SELFCHECK
                poison = poison || selfcheck_failed(ARG(ws));
#endif
            }
#ifndef SKIP_PJ
            for (int rep_ = 0; rep_ < REP_PJ; ++rep_) pj_final(C, l, poison, true);
            pj_final(C, l, poison);
#endif
        }
        if (l + 1 < DEPTH) GRID_BAR();
    }
}

extern "C" void kernel_launch(void* const* d_in, const int* in_sizes, int n_in, void* d_out, int out_size, void* d_ws, size_t ws_size, hipStream_t stream) {
    static int grid = 0;
    if (grid == 0) {
        if (n_in != 22 || in_sizes[0] != S * D || out_size != S * D || ws_size < WS_END + 4096) {
            fprintf(stderr, "kernel_launch: unexpected shapes (n_in %d, in0 %d, out %d, ws %zu, need %zu); nothing launched\n", n_in, n_in > 0 ? in_sizes[0] : -1, out_size, ws_size, (size_t)WS_END); grid = -1; return; }
        int dev = 0, cus = 0, per_cu = 0;
        if (hipGetDevice(&dev) != hipSuccess || hipDeviceGetAttribute(&cus, hipDeviceAttributeMultiprocessorCount, dev) != hipSuccess) { grid = -1; return; }
        if (hipFuncSetAttribute((const void*)hymba_fwd, hipFuncAttributeMaxDynamicSharedMemorySize, LDS_BYTES) != hipSuccess) { fprintf(stderr, "kernel_launch: hipFuncSetAttribute failed\n"); grid = -1; return; }
        if (hipOccupancyMaxActiveBlocksPerMultiprocessor(&per_cu, (const void*)hymba_fwd, NWAVES * 64, LDS_BYTES) != hipSuccess || per_cu < 1) { fprintf(stderr, "kernel_launch: occupancy query says %d\n", per_cu); grid = -1; (void)hipGetLastError(); return; }
        (void)hipGetLastError();
        grid = cus;
        if (grid != 256) { fprintf(stderr, "kernel_launch: built for a 256-CU device, got %d CUs\n", cus); grid = -1; return; }
    }
    if (grid < 0) return;
    if (hipMemsetAsync((char*)d_ws + WS_CTL, 0, CTL_ZERO_BYTES, stream) != hipSuccess) return;
    Args a{};
    a.x = (const float*)d_in[0]; a.ln_in_g = (const float*)d_in[1]; a.ln_in_b = (const float*)d_in[2]; a.w_in = (const float*)d_in[3]; a.w_out = (const float*)d_in[4];
    a.sg_ln_g = (const float*)d_in[5]; a.sg_ln_b = (const float*)d_in[6]; a.sg_w = (const float*)d_in[7]; a.sg_b = (const float*)d_in[8];
    a.conv_w = (const float*)d_in[9]; a.conv_b = (const float*)d_in[10]; a.conv_ln_g = (const float*)d_in[11]; a.conv_ln_b = (const float*)d_in[12];
    a.ln_mix_g = (const float*)d_in[13]; a.ln_mix_b = (const float*)d_in[14]; a.w_router = (const float*)d_in[15]; a.router_bias = (const float*)d_in[16];
    a.w_gate = (const float*)d_in[17]; a.w_up = (const float*)d_in[18]; a.w_down = (const float*)d_in[19]; a.ln_ffn_g = (const float*)d_in[20]; a.ln_ffn_b = (const float*)d_in[21];
    a.out = (float*)d_out; a.ws = (unsigned char*)d_ws;
#if SELFCHECK
    (void)hipMemsetAsync((char*)d_ws + WS_ERR, 0, 4096, stream);
    a.mode = 1;
    hipLaunchKernelGGL(hymba_fwd, dim3(grid), dim3(NWAVES * 64), LDS_BYTES, stream, a);
    hipLaunchKernelGGL(selfcheck_kernel, dim3(2048), dim3(256), 0, stream, a);
    (void)hipMemsetAsync((char*)d_ws + WS_CTL, 0, CTL_ZERO_BYTES, stream);
    a.mode = 0;
#endif
    hipLaunchKernelGGL(hymba_fwd, dim3(grid), dim3(NWAVES * 64), LDS_BYTES, stream, a);
}
```

```cpp
#include <hip/hip_runtime.h>
#include <cstdio>
#include <cstdint>

#ifndef ENABLE_ATT
#define ENABLE_ATT 1
#endif
#ifndef REP_P0
#define REP_P0 0
#endif
#ifndef REP_PA
#define REP_PA 0
#endif
#ifndef REP_SG
#define REP_SG 0
#endif
#ifndef REP_CONV
#define REP_CONV 0
#endif
#ifndef REP_PC
#define REP_PC 0
#endif
#ifndef REP_PD
#define REP_PD 0
#endif
#ifndef REP_PG
#define REP_PG 0
#endif
#ifndef REP_PH
#define REP_PH 0
#endif
#ifndef REP_PI
#define REP_PI 0
#endif
#ifndef REP_GATE
#define REP_GATE 0
#endif
#ifndef REP_PE
#define REP_PE 0
#endif
#ifndef REP_PF
#define REP_PF 0
#endif
#ifndef REP_PJ
#define REP_PJ 0
#endif
#ifndef REP_PFC
#define REP_PFC 0
#endif
#ifndef REP_BAR
#define REP_BAR 0
#endif
#ifndef SELFCHECK
#define SELFCHECK 0
#endif

#define GAS __attribute__((address_space(1)))
#define LAS __attribute__((address_space(3)))
typedef unsigned short bf16;
typedef short bf16x8 __attribute__((ext_vector_type(8)));
typedef float f32x4 __attribute__((ext_vector_type(4)));
typedef float f32x2 __attribute__((ext_vector_type(2)));
typedef unsigned u32x4 __attribute__((ext_vector_type(4)));
typedef unsigned u32x2 __attribute__((ext_vector_type(2)));
typedef GAS unsigned gu32;

constexpr int S = 16384, D = 1024, NIN = 2560, NH = 8, HD = 64, NBLK = 64, DEPTH = 2;
constexpr int NE = 16, DE = 512;
constexpr int SGW = 256, CVW = 256, TAPS = 31;
constexpr int Q_OFF = 0, K_OFF = 512, V_OFF = 1024, SGU_OFF = 1536, SGV_OFF = 1792, CA_OFF = 2048, CG_OFF = 2304;
constexpr float LN_EPS = 1e-5f;
constexpr float ALPHA = 1.4142135623730951f;
constexpr float LOG2E = 1.4426950408889634f;
constexpr int MAXROWS = 2 * S + NE * 256;

constexpr size_t MiB = 1u << 20;
constexpr size_t WS_CTL = 0, CTL_ZERO_BYTES = 1 * MiB;
constexpr size_t WS_CS = 1 * MiB;
constexpr size_t WS_WIN = 5 * MiB;
constexpr size_t WS_WOUT = 15 * MiB;
constexpr size_t WS_WSG = 19 * MiB;
constexpr size_t WS_ELIST = 20 * MiB;
constexpr size_t WS_EW = 21 * MiB;
constexpr size_t WS_ROWINFO = 21 * MiB + 512 * 1024;
constexpr size_t WS_HB = 22 * MiB;
constexpr size_t WS_R = 54 * MiB;
constexpr size_t WS_P = WS_R;
constexpr size_t WS_MIXIN = WS_R + 80 * MiB;
constexpr size_t WS_PARTO = WS_R + 112 * MiB;
constexpr size_t WS_PARTML = WS_R + 160 * MiB;
constexpr size_t WS_LISTS = WS_R + 163 * MiB;
constexpr size_t WS_WGU = WS_R;
constexpr size_t WS_WDN = WS_R + 32 * MiB;
constexpr size_t WS_AG = WS_R + 48 * MiB;
constexpr size_t WS_ACT = WS_R + 120 * MiB;
constexpr size_t WS_Y = WS_R + 156 * MiB;
constexpr size_t WS_END = WS_R + 220 * MiB;
constexpr size_t WS_ERR = WS_END;
static_assert((size_t)MAXROWS * 1024 * 2 <= 72 * MiB && (size_t)MAXROWS * 512 * 2 <= 36 * MiB, "MoE buffers");
constexpr int CW_TMO = 0;
constexpr int CW_BAR = 4096;
constexpr int CW_ACNT = 8192;
constexpr int CW_ECNT = 9216;
constexpr int CW_ERR = 9280;
constexpr int CW_KMEAN = 16384;

constexpr int RING_BYTES = 131072;
constexpr int MISC_OFF = RING_BYTES;
constexpr int LDS_BYTES = 147456;
constexpr int NWAVES = 8;

#define RLX_AGENT __ATOMIC_RELAXED, __HIP_MEMORY_SCOPE_AGENT
#define LDS_WAIT() asm volatile("s_waitcnt lgkmcnt(0)" ::: "memory")
#define VM_WAIT() asm volatile("s_waitcnt vmcnt(0)" ::: "memory")

__device__ __forceinline__ unsigned f2bf(float f) { unsigned u = __builtin_bit_cast(unsigned, f); return (u + 0x7fffu + ((u >> 16) & 1u)) >> 16; }
__device__ __forceinline__ unsigned pk2(float lo, float hi) { return f2bf(lo) | (f2bf(hi) << 16); }
__device__ __forceinline__ float bf2f(unsigned b) { return __builtin_bit_cast(float, b << 16); }
__device__ __forceinline__ float bflo(unsigned w) { return __builtin_bit_cast(float, w << 16); }
__device__ __forceinline__ float bfhi(unsigned w) { return __builtin_bit_cast(float, w & 0xffff0000u); }
__device__ __forceinline__ float wave_sum(float v) {
#pragma unroll
    for (int o = 1; o < 64; o <<= 1) v += __shfl_xor(v, o);
    return v;
}
__device__ __forceinline__ float fast_exp2(float x) { return __builtin_amdgcn_exp2f(x); }
__device__ __forceinline__ float sigmoidf_(float x) { return 1.0f / (1.0f + __expf(-x)); }
__device__ __forceinline__ float gelu_tanh(float x) { const float z = 0.7978845608028654f * (x + 0.044715f * x * x * x); return x * sigmoidf_(2.0f * z); }

namespace pg8 {
constexpr int BM = 256, BK = 64, HALF = 128, HTB = HALF * BK * 2, STAGE_BYTES = 8 * HTB, NXCD = 8, WGM = 8;
__host__ __device__ __forceinline__ int lds_byte(int r, int c) { const int st = (r >> 4) * 2 + (c >> 5), rr = r & 15, cc = c & 31, ob = rr * 64 + cc * 2; return st * 1024 + (ob ^ (((ob >> 9) & 1) << 5)); }
__host__ __device__ __forceinline__ void stage_rc(int b, int& R, int& C) { const int st = b / 1024, sb = b % 1024, swz = sb ^ (((sb >> 9) & 1) << 5); R = (st >> 1) * 16 + swz / 64; C = (st & 1) * 32 + (swz % 64) / 2; }

struct Unit { int pm, pn, e; };

struct DenseOrder {
    const char* A; const char* Bt; size_t tstep; int nM, nN, nwg, G, c;
    __device__ void init(const void* A_, const void* Bt_, int M, int N, int K, int G_, int c_) { A = (const char*)A_; Bt = (const char*)Bt_; tstep = (size_t)BM * K * 2; nM = M / BM; nN = N / BM; nwg = nM * nN; G = G_; c = c_; }
    __device__ bool next(int i, Unit& u) const {
        const long L = (long)i * G + c; if (L >= nwg) return false;
        int wgid = (int)L; { const int q = nwg / NXCD, r = nwg % NXCD, xcd = wgid % NXCD, off = wgid / NXCD; wgid = (xcd < r ? xcd * (q + 1) : r * (q + 1) + (xcd - r) * q) + off; }
        const int nig = WGM * nN, gid = wgid / nig, fm = gid * WGM, gsz = (nM - fm) < WGM ? (nM - fm) : WGM;
        u.pm = fm + ((wgid % nig) % gsz); u.pn = (wgid % nig) / gsz; u.e = 0; return true;
    }
    __device__ __forceinline__ const char* a_base(const Unit& u) const { return A + (size_t)u.pm * tstep; }
    __device__ __forceinline__ const char* b_base(const Unit& u) const { return Bt + (size_t)u.pn * tstep; }
};
struct MoeOrder {
    const char* A; const char* Bt; size_t tstep, estep; int ntot, G, c; const volatile LAS int* tstart;
    __device__ void init(const void* A_, const void* Bt_, int K, int N, int G_, int c_, const volatile LAS int* ts) { A = (const char*)A_; Bt = (const char*)Bt_; tstep = (size_t)BM * K * 2; estep = (size_t)N * K * 2; G = G_; c = c_; tstart = ts; ntot = ts[16]; }
    __device__ bool next(int i, Unit& u) const {
        const long L = (long)i * G + c; if (L >= 4L * ntot) return false;
        const int mt = (int)(L >> 2); u.pm = mt; u.pn = (int)(L & 3);
        int e = 0;
#pragma unroll
        for (int j = 1; j < 16; ++j) e += (mt >= tstart[j]) ? 1 : 0;
        u.e = e; return true;
    }
    __device__ __forceinline__ const char* a_base(const Unit& u) const { return A + (size_t)u.pm * tstep; }
    __device__ __forceinline__ const char* b_base(const Unit& u) const { return Bt + (size_t)u.e * estep + (size_t)u.pn * tstep; }
};

__device__ __forceinline__ unsigned cvt_pk_bf16(float lo, float hi) { unsigned r; asm volatile("v_cvt_pk_bf16_f32 %0, %1, %2" : "=v"(r) : "v"(lo), "v"(hi)); return r; }


struct EpiIn {
    bf16* P; const float* cs; float* ksum;
    __device__ __forceinline__ void operator()(const f32x4 (&acc)[2][2][4][2], const Unit& u, int wr, int wc, int fr, int fq) const {
        const int pn = u.pn, row0 = u.pm * BM + wr * 64 + fr, col0 = pn * BM + wc * 32 + 8 * fq;
        if (pn < 4) {
            const int dbase = 16 * (wc & 1) + 4 * fq;
            const float qs = (pn < 2) ? 0.125f : 1.0f;
            const bool isk = (pn >= 2);
            float ks[2][8];
#pragma unroll
            for (int b = 0; b < 2; ++b)
#pragma unroll
                for (int j = 0; j < 8; ++j) ks[b][j] = 0.f;
#pragma unroll
            for (int ai = 0; ai < 2; ++ai)
#pragma unroll
                for (int m = 0; m < 4; ++m) {
                    const int r = row0 + ai * HALF + m * 16;
                    const f32x4* cp = (const f32x4*)(cs + ((size_t)r * 32 + dbase) * 2);
                    const f32x4 cA = cp[0], cB = cp[1];
                    const float cc[4] = {cA[0], cA[2], cB[0], cB[2]}, ss[4] = {cA[1], cA[3], cB[1], cB[3]};
                    bf16* rowp = P + (size_t)r * NIN + col0;
#pragma unroll
                    for (int bj = 0; bj < 2; ++bj) {
                        const f32x4 x1 = acc[ai][bj][m][0], x2 = acc[ai][bj][m][1];
                        float o1[4], o2[4];
#pragma unroll
                        for (int j = 0; j < 4; ++j) { o1[j] = x1[j] * cc[j] - x2[j] * ss[j]; o2[j] = x2[j] * cc[j] + x1[j] * ss[j]; }
                        if (isk) {
#pragma unroll
                            for (int j = 0; j < 4; ++j) { ks[bj][j] += o1[j]; ks[bj][4 + j] += o2[j]; }
                        }
                        u32x4 w; w.x = cvt_pk_bf16(o1[0] * qs, o1[1] * qs); w.y = cvt_pk_bf16(o1[2] * qs, o1[3] * qs); w.z = cvt_pk_bf16(o2[0] * qs, o2[1] * qs); w.w = cvt_pk_bf16(o2[2] * qs, o2[3] * qs);
                        *(u32x4*)(rowp + bj * HALF) = w;
                    }
                }
            if (isk) {
#pragma unroll
                for (int b = 0; b < 2; ++b)
#pragma unroll
                    for (int j = 0; j < 8; ++j) {
                        float v = ks[b][j];
                        v += __shfl_xor(v, 1); v += __shfl_xor(v, 2); v += __shfl_xor(v, 4); v += __shfl_xor(v, 8);
                        ks[b][j] = v;
                    }
                if (fr == 0) {
#pragma unroll
                    for (int b = 0; b < 2; ++b) {
                        const int head = (pn - 2) * 4 + 2 * b + (wc >> 1);
                        float* kp = ksum + ((size_t)head * NBLK + u.pm) * HD + 32 * (wc & 1) + 8 * fq;
#pragma unroll
                        for (int j = 0; j < 8; ++j) atomicAdd(kp + j, ks[b][j]);
                    }
                }
            }
        } else {
            const bool act = (pn == 6 || pn == 7);
#pragma unroll
            for (int ai = 0; ai < 2; ++ai)
#pragma unroll
                for (int m = 0; m < 4; ++m) {
                    bf16* rowp = P + (size_t)(row0 + ai * HALF + m * 16) * NIN + col0;
#pragma unroll
                    for (int bj = 0; bj < 2; ++bj) {
                        f32x4 v0 = acc[ai][bj][m][0], v1 = acc[ai][bj][m][1];
                        if (act) {
#pragma unroll
                            for (int j = 0; j < 4; ++j) { v0[j] = gelu_tanh(v0[j]); v1[j] = gelu_tanh(v1[j]); }
                        }
                        u32x4 w; w.x = cvt_pk_bf16(v0[0], v0[1]); w.y = cvt_pk_bf16(v0[2], v0[3]); w.z = cvt_pk_bf16(v1[0], v1[1]); w.w = cvt_pk_bf16(v1[2], v1[3]);
                        *(u32x4*)(rowp + bj * HALF) = w;
                    }
                }
        }
    }
};
struct EpiOut {
    float* H; float* HO;
    __device__ __forceinline__ void operator()(const f32x4 (&acc)[2][2][4][2], const Unit& u, int wr, int wc, int fr, int fq) const {
        const int row0 = u.pm * BM + wr * 64 + fr, col0 = u.pn * BM + wc * 32 + 4 * fq;
#pragma unroll
        for (int ai = 0; ai < 2; ++ai)
#pragma unroll
            for (int m = 0; m < 4; ++m) {
                float* rowp = H + (size_t)(row0 + ai * HALF + m * 16) * D + col0;
#pragma unroll
                for (int bj = 0; bj < 2; ++bj)
#pragma unroll
                    for (int n = 0; n < 2; ++n) { f32x4* p = (f32x4*)(rowp + bj * HALF + n * 16); const f32x4 hv = *p; *(f32x4*)((float*)p + (HO - H)) = hv * ALPHA + acc[ai][bj][m][n]; }
            }
    }
};
struct EpiGU {
    bf16* ACT;
    __device__ __forceinline__ void operator()(const f32x4 (&acc)[2][2][4][2], const Unit& u, int wr, int wc, int fr, int fq) const {
        const int row0 = u.pm * BM + wr * 64 + fr, col0 = u.pn * 128 + wc * 16 + 4 * fq;
#pragma unroll
        for (int ai = 0; ai < 2; ++ai)
#pragma unroll
            for (int m = 0; m < 4; ++m) {
                bf16* rowp = ACT + (size_t)(row0 + ai * HALF + m * 16) * DE + col0;
#pragma unroll
                for (int bj = 0; bj < 2; ++bj) {
                    const f32x4 g = acc[ai][bj][m][0], up = acc[ai][bj][m][1];
                    float a[4];
#pragma unroll
                    for (int j = 0; j < 4; ++j) a[j] = g[j] * sigmoidf_(g[j]) * up[j];
                    u32x2 w; w.x = cvt_pk_bf16(a[0], a[1]); w.y = cvt_pk_bf16(a[2], a[3]);
                    *(u32x2*)(rowp + bj * 64) = w;
                }
            }
    }
};
struct EpiDown {
    bf16* Y; const int2* rowinfo;
    __device__ __forceinline__ void operator()(const f32x4 (&acc)[2][2][4][2], const Unit& u, int wr, int wc, int fr, int fq) const {
        const int row0 = u.pm * BM + wr * 64 + fr, col0 = u.pn * BM + wc * 32 + 8 * fq;
#pragma unroll
        for (int ai = 0; ai < 2; ++ai)
#pragma unroll
            for (int m = 0; m < 4; ++m) {
                const int2 ri = rowinfo[row0 + ai * HALF + m * 16];
                if (ri.x >= 0) {
                    const float gw = __builtin_bit_cast(float, ri.y);
                    bf16* rowp = Y + (size_t)ri.x * D + col0;
#pragma unroll
                    for (int bj = 0; bj < 2; ++bj) {
                        const f32x4 v0 = acc[ai][bj][m][0] * gw, v1 = acc[ai][bj][m][1] * gw;
                        u32x4 w; w.x = cvt_pk_bf16(v0[0], v0[1]); w.y = cvt_pk_bf16(v0[2], v0[3]); w.z = cvt_pk_bf16(v1[0], v1[1]); w.w = cvt_pk_bf16(v1[2], v1[3]);
                        *(u32x4*)(rowp + bj * HALF) = w;
                    }
                }
            }
    }
};

template <class Epi, class Sched, bool ALIGN_EPI, bool SP2>
__device__ __forceinline__ void gemm_phase(LAS unsigned char* lds, const int K, const Sched& S, const Epi& E) {
    int tid_ = threadIdx.x; asm volatile("" : "+v"(tid_));
    const int tid = tid_, wid = __builtin_amdgcn_readfirstlane(tid >> 6), lane = tid & 63, wr = wid >> 2, wc = wid & 3, fr = lane & 15, fq = lane >> 4;
    const int nt = K / BK;
    unsigned voffA[2], voffB[2];
#pragma unroll
    for (int i = 0; i < 2; ++i) { int R, C; stage_rc(tid * 16 + i * 8192, R, C); voffA[i] = (unsigned)(R * K + C) * 2u; voffB[i] = voffA[i]; }
    const size_t kstep = (size_t)(BK * 2);
    const size_t hstep = (size_t)HALF * K * 2;
    const unsigned ldsw = (unsigned)wid * 1024u;
    const int aoff = lds_byte(wr * 64 + fr, fq * 8), boff = lds_byte(wc * 32 + fr, fq * 8);
#define PG8_SA(b, h) (((b) * 2 + (h)) * HTB)
#define PG8_SB(b, h) ((4 + (b) * 2 + (h)) * HTB)
#define PG8_STAGE(bufoff, gbase, voff) do { _Pragma("unroll") for (int _i = 0; _i < 2; ++_i) \
        __builtin_amdgcn_global_load_lds((const unsigned*)((const char*)(gbase) + (voff)[_i]), (LAS unsigned*)(lds + (bufoff) + ldsw + _i * 8192), 16, 0, 0); } while (0)
#define PG8_LDA(dst, b, h) do { _Pragma("unroll") for (int m = 0; m < 4; ++m) _Pragma("unroll") for (int k = 0; k < 2; ++k) dst[m][k] = *(const LAS bf16x8*)(lds + PG8_SA(b, h) + aoff + m * 2048 + k * 1024); } while (0)
#define PG8_LDB(dst, b, h) do { _Pragma("unroll") for (int n = 0; n < 2; ++n) _Pragma("unroll") for (int k = 0; k < 2; ++k) dst[n][k] = *(const LAS bf16x8*)(lds + PG8_SB(b, h) + boff + n * 2048 + k * 1024); } while (0)
#define PG8_MMA(ai, bj, At, Bt) do { __builtin_amdgcn_s_setprio(1); _Pragma("unroll") for (int m = 0; m < 4; ++m) _Pragma("unroll") for (int n = 0; n < 2; ++n) _Pragma("unroll") for (int k = 0; k < 2; ++k) \
        acc[ai][bj][m][n] = __builtin_amdgcn_mfma_f32_16x16x32_bf16(Bt[n][k], At[m][k], acc[ai][bj][m][n], 0, 0, 0); __builtin_amdgcn_s_setprio(0); } while (0)
#define PG8_WAIT_V(n) asm volatile("s_waitcnt vmcnt(" #n ")" ::: "memory")
#define PG8_WAIT_L(n) asm volatile("s_waitcnt lgkmcnt(" #n ")" ::: "memory")
#define PG8_BAR __builtin_amdgcn_s_barrier()
#define PG8_SCHED __builtin_amdgcn_sched_barrier(0)
    Unit cur, nxt; int ui = 0;
    if (!S.next(0, cur)) return;
    f32x4 acc[2][2][4][2];
#pragma unroll
    for (int a = 0; a < 2; ++a)
#pragma unroll
        for (int b = 0; b < 2; ++b)
#pragma unroll
            for (int m = 0; m < 4; ++m)
#pragma unroll
                for (int n = 0; n < 2; ++n) acc[a][b][m][n] = (f32x4){0.f, 0.f, 0.f, 0.f};
    bf16x8 At[4][2], B0[2][2], B1[2][2];
    const char* cA = S.a_base(cur); const char* cB = S.b_base(cur);
    if constexpr (SP2) {
        PG8_STAGE(PG8_SB(0, 0), cB, voffB); PG8_STAGE(PG8_SB(0, 1), cB + hstep, voffB); PG8_STAGE(PG8_SA(0, 0), cA, voffA); PG8_STAGE(PG8_SA(0, 1), cA + hstep, voffA);
        if (wr == 1) PG8_BAR;
        PG8_WAIT_V(2); PG8_BAR;
        PG8_STAGE(PG8_SB(1, 0), cB + kstep, voffB); PG8_STAGE(PG8_SA(1, 0), cA + kstep, voffA); PG8_STAGE(PG8_SB(1, 1), cB + hstep + kstep, voffB);
        PG8_WAIT_V(6); PG8_BAR;
    } else {
        PG8_STAGE(PG8_SB(0, 0), cB, voffB); PG8_STAGE(PG8_SA(0, 0), cA, voffA); PG8_STAGE(PG8_SB(0, 1), cB + hstep, voffB); PG8_STAGE(PG8_SA(0, 1), cA + hstep, voffA);
        if (wr == 1) PG8_BAR;
        PG8_WAIT_V(4); PG8_BAR;
        PG8_STAGE(PG8_SB(1, 0), cB + kstep, voffB); PG8_STAGE(PG8_SA(1, 0), cA + kstep, voffA); PG8_STAGE(PG8_SB(1, 1), cB + hstep + kstep, voffB);
        PG8_WAIT_V(6); PG8_BAR;
    }
    for (;;) {
        const bool has_next = S.next(ui + 1, nxt);
        const char* nA = has_next ? S.a_base(nxt) : cA; const char* nB = has_next ? S.b_base(nxt) : cB;
        for (int t = 0; t < nt; t += 2) {
            const bool last = (t == nt - 2);
            const char* a1 = cA + (size_t)(t + 1) * kstep;
            const char* a2 = last ? nA : cA + (size_t)(t + 2) * kstep; const char* b2 = last ? nB : cB + (size_t)(t + 2) * kstep;
            const char* a3 = a2 + kstep; const char* b3 = b2 + kstep;
            if constexpr (SP2) {
            PG8_LDB(B0, 0, 0); PG8_LDB(B1, 0, 1); PG8_SCHED; PG8_LDA(At, 0, 0); PG8_STAGE(PG8_SA(1, 1), a1 + hstep, voffA);
            PG8_WAIT_V(8); PG8_WAIT_L(0); PG8_BAR; PG8_MMA(0, 0, At, B0); PG8_MMA(0, 1, At, B1); PG8_BAR; PG8_SCHED;
            PG8_LDA(At, 0, 1); PG8_STAGE(PG8_SB(0, 0), b2, voffB); PG8_STAGE(PG8_SB(0, 1), b2 + hstep, voffB); PG8_STAGE(PG8_SA(0, 0), a2, voffA);
            PG8_WAIT_V(8); PG8_WAIT_L(0); PG8_BAR; PG8_MMA(1, 0, At, B0); PG8_MMA(1, 1, At, B1); PG8_BAR; PG8_SCHED;
            PG8_LDB(B0, 1, 0); PG8_LDB(B1, 1, 1); PG8_SCHED; PG8_LDA(At, 1, 0); PG8_STAGE(PG8_SA(0, 1), a2 + hstep, voffA);
            PG8_WAIT_V(8); PG8_WAIT_L(0); PG8_BAR; PG8_MMA(0, 0, At, B0); PG8_MMA(0, 1, At, B1); PG8_BAR; PG8_SCHED;
            PG8_LDA(At, 1, 1); PG8_STAGE(PG8_SB(1, 0), b3, voffB); PG8_STAGE(PG8_SB(1, 1), b3 + hstep, voffB); PG8_STAGE(PG8_SA(1, 0), a3, voffA);
            PG8_WAIT_V(8); PG8_WAIT_L(0); PG8_BAR; PG8_MMA(1, 0, At, B0); PG8_MMA(1, 1, At, B1); PG8_BAR; PG8_SCHED;
            } else {
            PG8_LDB(B0, 0, 0); PG8_SCHED; PG8_LDA(At, 0, 0); PG8_STAGE(PG8_SA(1, 1), a1 + hstep, voffA);
            PG8_WAIT_L(8); PG8_BAR; PG8_WAIT_L(0); PG8_MMA(0, 0, At, B0); PG8_BAR; PG8_SCHED;
            PG8_LDB(B1, 0, 1); PG8_STAGE(PG8_SB(0, 0), b2, voffB);
            PG8_BAR; PG8_WAIT_L(0); PG8_MMA(0, 1, At, B1); PG8_BAR;
            PG8_LDA(At, 0, 1); PG8_STAGE(PG8_SA(0, 0), a2, voffA);
            PG8_BAR; PG8_WAIT_L(0); PG8_MMA(1, 0, At, B0); PG8_BAR; PG8_SCHED;
            PG8_STAGE(PG8_SB(0, 1), b2 + hstep, voffB);
            PG8_WAIT_V(6); PG8_BAR; PG8_MMA(1, 1, At, B1); PG8_BAR;
            PG8_LDB(B0, 1, 0); PG8_SCHED; PG8_LDA(At, 1, 0); PG8_STAGE(PG8_SA(0, 1), a2 + hstep, voffA);
            PG8_WAIT_L(8); PG8_BAR; PG8_WAIT_L(0); PG8_MMA(0, 0, At, B0); PG8_BAR; PG8_SCHED;
            PG8_LDB(B1, 1, 1); PG8_STAGE(PG8_SB(1, 0), b3, voffB);
            PG8_BAR; PG8_WAIT_L(0); PG8_MMA(0, 1, At, B1); PG8_BAR;
            PG8_LDA(At, 1, 1); PG8_STAGE(PG8_SA(1, 0), a3, voffA);
            PG8_BAR; PG8_WAIT_L(0); PG8_MMA(1, 0, At, B0); PG8_BAR; PG8_SCHED;
            PG8_STAGE(PG8_SB(1, 1), b3 + hstep, voffB);
            PG8_WAIT_V(6); PG8_BAR; PG8_MMA(1, 1, At, B1); PG8_BAR;
            }
        }
        if constexpr (ALIGN_EPI) { if (wr == 0) PG8_BAR; }
        E(acc, cur, wr, wc, fr, fq);
        if (!has_next) break;
#pragma unroll
        for (int a = 0; a < 2; ++a)
#pragma unroll
            for (int b = 0; b < 2; ++b)
#pragma unroll
                for (int m = 0; m < 4; ++m)
#pragma unroll
                    for (int n = 0; n < 2; ++n) acc[a][b][m][n] = (f32x4){0.f, 0.f, 0.f, 0.f};
        cur = nxt; cA = nA; cB = nB; ++ui;
        if constexpr (ALIGN_EPI) { if (wr == 1) PG8_BAR; }
    }
    PG8_WAIT_V(0);
    if constexpr (!ALIGN_EPI) { if (wr == 0) PG8_BAR; }
    PG8_BAR;
#undef PG8_SA
#undef PG8_SB
#undef PG8_STAGE
#undef PG8_LDA
#undef PG8_LDB
#undef PG8_MMA
#undef PG8_WAIT_V
#undef PG8_WAIT_L
#undef PG8_BAR
#undef PG8_SCHED
}
}

#define XB_TMO      128
#define XB_XCNT(j)  (256  + 64 * (j))
#define XB_XSUB(j)  (1280 + 64 * (j))
#define XB_XGEN(j)  (2304 + 64 * (j))
#define XB_TOP      3328
#define XB_TOPGEN   3392
#define XCD_BAR_WORDS 3456
#define XB_SPIN_CAP (1u << 18)
__device__ __forceinline__ unsigned xb_ld(unsigned* p)              { return __hip_atomic_load(p, __ATOMIC_RELAXED, __HIP_MEMORY_SCOPE_AGENT); }
__device__ __forceinline__ unsigned xb_add(unsigned* p, unsigned v) { return __hip_atomic_fetch_add(p, v, __ATOMIC_RELAXED, __HIP_MEMORY_SCOPE_AGENT); }
__device__ __forceinline__ unsigned xb_xcc_id() { return (unsigned)__builtin_amdgcn_s_getreg((3 << 11) | 20) & 0xFu; }
#define XB_SPIN(cond, bar) do { unsigned _sp = 0; while (cond) { __builtin_amdgcn_s_sleep(1); \
    if ((++_sp & 255u) == 0u) { if (xb_ld(&(bar)[XB_TMO])) break; if (_sp > XB_SPIN_CAP) { atomicAdd(&(bar)[XB_TMO], 1u); break; } } } } while (0)
struct XcdBarrier { unsigned* bar; unsigned x; volatile LAS unsigned* st; };
__device__ __forceinline__ XcdBarrier xcd_barrier_post(unsigned* bar, volatile LAS unsigned* st) {
    XcdBarrier b; b.bar = bar; b.x = xb_xcc_id(); b.st = st;
    if (threadIdx.x == 0) (void)xb_add(&bar[XB_XCNT(b.x)], 1u);
    return b;
}
__device__ __forceinline__ void xcd_barrier_complete(unsigned* bar, unsigned x, unsigned& nloc, unsigned& nx) {
    const unsigned G = gridDim.x * gridDim.y * gridDim.z;
    unsigned sum, cnt, mine, sp = 0u;
    for (;;) {
        sum = 0u; cnt = 0u; mine = 0u;
#pragma unroll
        for (unsigned j = 0; j < 16; ++j) { const unsigned c = xb_ld(&bar[XB_XCNT(j)]); sum += c; cnt += (c > 0u) ? 1u : 0u; mine = (j == x) ? c : mine; }
        if (sum == G) break;
        __builtin_amdgcn_s_sleep(1);
        if ((++sp & 255u) == 0u) { if (xb_ld(&bar[XB_TMO])) break; if (sp > XB_SPIN_CAP) { atomicAdd(&bar[XB_TMO], 1u); break; } }
    }
    nloc = mine > 0u ? mine : 1u; nx = cnt > 0u ? cnt : 1u;
}
template <bool FIRST>
__device__ __forceinline__ void xcd_barrier_t(const XcdBarrier& b) {
    asm volatile("s_waitcnt vmcnt(0)" ::: "memory");
    __syncthreads();
    if (threadIdx.x == 0) {
        unsigned* bar = b.bar; unsigned bx = b.x;
        asm volatile("" : "+s"(bar), "+s"(bx));
        __builtin_amdgcn_s_waitcnt(0);
        unsigned nloc = b.st[0], nx = b.st[1];
        if (FIRST) { xcd_barrier_complete(bar, bx, nloc, nx); b.st[0] = nloc; b.st[1] = nx; }
        const unsigned old = xb_add(&bar[XB_XSUB(bx)], 1u);
        const unsigned gen = old / nloc;
        if (old + 1u == (gen + 1u) * nloc) {
            __builtin_amdgcn_fence(__ATOMIC_RELEASE, "agent");
            asm volatile("s_waitcnt vmcnt(0)" ::: "memory");
            const unsigned og = xb_add(&bar[XB_TOP], 1u);
            const unsigned tg = og / nx;
            if (og + 1u == (tg + 1u) * nx) xb_add(&bar[XB_TOPGEN], 1u);
            else XB_SPIN(xb_ld(&bar[XB_TOPGEN]) == tg, bar);
            __builtin_amdgcn_fence(__ATOMIC_ACQUIRE, "agent");
            xb_add(&bar[XB_XGEN(bx)], 1u);
            asm volatile("s_waitcnt vmcnt(0)" ::: "memory");
        } else {
            XB_SPIN(xb_ld(&bar[XB_XGEN(bx)]) == gen, bar);
            __builtin_amdgcn_fence(__ATOMIC_ACQUIRE, "agent");
            asm volatile("s_waitcnt vmcnt(0)" ::: "memory");
        }
    }
    __syncthreads();
}

struct Args {
    const float* x; const float* ln_in_g; const float* ln_in_b; const float* w_in; const float* w_out; const float* sg_ln_g; const float* sg_ln_b; const float* sg_w; const float* sg_b;
    const float* conv_w; const float* conv_b; const float* conv_ln_g; const float* conv_ln_b; const float* ln_mix_g; const float* ln_mix_b; const float* w_router; const float* router_bias;
    const float* w_gate; const float* w_up; const float* w_down; const float* ln_ffn_g; const float* ln_ffn_b;
    float* out; unsigned char* ws;
    int mode, pad;
};
struct Ctx { LAS unsigned char* lds; int tid, lane, wave, vcu, G; };
constexpr int ARGS_OFF = MISC_OFF + 512;
__device__ __forceinline__ LAS unsigned char* lds_opaque(LAS unsigned char* p) { asm volatile("" : "+s"(p)); return p; }
template <class T> __device__ __forceinline__ T lds_arg(const Ctx& C, int byteoff) {
    volatile LAS unsigned* p = (volatile LAS unsigned*)(lds_opaque(C.lds) + ARGS_OFF + byteoff);
    const unsigned lo = __builtin_amdgcn_readfirstlane(p[0]), hi = __builtin_amdgcn_readfirstlane(p[1]);
    return (T)(GAS void*)(((unsigned long long)hi << 32) | lo);
}
#define ARG(field) lds_arg<decltype(Args::field)>(C, (int)__builtin_offsetof(Args, field))
#define LOADARG(a, field) (a).field = ARG(field)

template <class RowMap>
__device__ __forceinline__ void transpose_item(const float* W, int K, int N, bf16* WT, LAS float* scr, int item, int lane, const RowMap& rowmap) {
    const int nblk = N / 64, kb = item / nblk, nb = item % nblk, k0 = 64 * kb, n0 = 64 * nb;
    const int lr = lane >> 4, lc = (lane & 15) * 4;
    f32x4 v[16];
#pragma unroll
    for (int i = 0; i < 16; ++i) v[i] = *(const f32x4*)(W + (size_t)(k0 + 4 * i + lr) * N + n0 + lc);
#pragma unroll
    for (int i = 0; i < 16; ++i) { const int kk = 4 * i + lr; *(LAS f32x4*)(scr + kk * 64 + (lc ^ (8 * ((kk >> 3) & 3)))) = v[i]; }
    LDS_WAIT(); asm volatile("" ::: "memory");
    const int c = lane & 7, sw = 8 * (c & 3);
#pragma unroll
    for (int j = 0; j < 8; ++j) { const int n = (lane >> 3) + 8 * j; const LAS float* sp = scr + (8 * c) * 64 + (n ^ sw);
        u32x4 o; o.x = pk2(sp[0], sp[64]); o.y = pk2(sp[128], sp[192]); o.z = pk2(sp[256], sp[320]); o.w = pk2(sp[384], sp[448]);
        *(GAS u32x4*)(WT + (size_t)rowmap(n0 + n) * K + k0 + 8 * c) = o; }
    LDS_WAIT(); asm volatile("" ::: "memory");
}
struct MapIn { __device__ __forceinline__ int operator()(int n) const {
    if (n < 1024) return (n & ~48) | ((n & 16) << 1) | ((n & 32) >> 1);
    return (n & ~31) | ((n & 4) << 2) | ((n & 24) >> 1) | (n & 3); } };
struct MapId { __device__ __forceinline__ int operator()(int n) const { return n; } };
struct MapPerm { __device__ __forceinline__ int operator()(int n) const { return (n & ~31) | ((n & 4) << 2) | ((n & 24) >> 1) | (n & 3); } };
struct MapGU { int which; __device__ __forceinline__ int operator()(int c) const {
    return ((c >> 7) << 8) | (((c >> 6) & 1) << 7) | (((c >> 4) & 3) << 5) | (which << 4) | (c & 15); } };

__device__ __forceinline__ void ln_row(f32x4 (&v)[4], const float* g, const float* b, int lane, float eps) {
    float s = 0.f;
#pragma unroll
    for (int j = 0; j < 4; ++j) s += (v[j][0] + v[j][1]) + (v[j][2] + v[j][3]);
    const float mean = wave_sum(s) * (1.f / D); float s2 = 0.f;
#pragma unroll
    for (int j = 0; j < 4; ++j) { v[j] = v[j] - mean; s2 += (v[j][0] * v[j][0] + v[j][1] * v[j][1]) + (v[j][2] * v[j][2] + v[j][3] * v[j][3]); }
    const float rstd = 1.f / sqrtf(wave_sum(s2) * (1.f / D) + eps);
#pragma unroll
    for (int j = 0; j < 4; ++j) { const f32x4 gg = *(const f32x4*)(g + 4 * lane + 256 * j), bb = *(const f32x4*)(b + 4 * lane + 256 * j); v[j] = v[j] * rstd * gg + bb; }
}
__device__ __forceinline__ void store_row(const f32x4 (&v)[4], float* orow, bf16* brow, int lane) {
#pragma unroll
    for (int j = 0; j < 4; ++j) {
        *(f32x4*)(orow + 4 * lane + 256 * j) = v[j];
        u32x2 w; w.x = pk2(v[j][0], v[j][1]); w.y = pk2(v[j][2], v[j][3]);
        *(u32x2*)(brow + 4 * lane + 256 * j) = w;
    }
}

__device__ __forceinline__ void p0_prologue(const Ctx& C0) {
    Ctx C = C0; asm volatile("" : "+v"(C.tid), "+v"(C.lane), "+s"(C.wave), "+s"(C.vcu), "+s"(C.G), "+s"(C.lds));
    Args a; LOADARG(a, ws); LOADARG(a, w_in); LOADARG(a, w_out); LOADARG(a, sg_w); LOADARG(a, x); LOADARG(a, ln_in_g); LOADARG(a, ln_in_b); LOADARG(a, out);
    LAS float* scr = (LAS float*)(C.lds + C.wave * 16384);
    const int gw = C.vcu * NWAVES + C.wave, NGW = C.G * NWAVES;
    unsigned char* ws = a.ws;
    constexpr int I_IN = (D / 64) * (NIN / 64), I_OUT = (D / 64) * (D / 64);
    for (int it = gw; it < DEPTH * (I_IN + I_OUT); it += NGW) {
        const int l = it / (I_IN + I_OUT); int r = it % (I_IN + I_OUT);
        if (r < I_IN) transpose_item(a.w_in + (size_t)l * D * NIN, D, NIN, (bf16*)(ws + WS_WIN) + (size_t)l * NIN * D, scr, r, C.lane, MapIn{});
        else transpose_item(a.w_out + (size_t)l * D * D, D, D, (bf16*)(ws + WS_WOUT) + (size_t)l * D * D, scr, r - I_IN, C.lane, MapId{});
    }
    const int gt = C.vcu * (NWAVES * 64) + C.tid, NGT = C.G * NWAVES * 64;
    float2* cs = (float2*)(ws + WS_CS);
    for (int i = gt; i < S * 32; i += NGT) {
        const int s = i >> 5, f = i & 31;
        const float inv = powf(10000.0f, -(float)f / 32.0f);
        const float ang = (float)s * inv;
        cs[i] = make_float2(cosf(ang), sinf(ang));
    }
    bf16* wsg = (bf16*)(ws + WS_WSG);
    for (int i = gt; i < DEPTH * 4 * 128 * 128; i += NGT) { const int t = (i >> 7) & 127, s = i & 127; wsg[i] = (bf16)((s <= t) ? f2bf(a.sg_w[i]) : 0u); }
    bf16* hb = (bf16*)(ws + WS_HB);
    for (int m = gw; m < S; m += NGW) {
        f32x4 v[4];
#pragma unroll
        for (int j = 0; j < 4; ++j) v[j] = *(const f32x4*)(a.x + (size_t)m * D + 4 * C.lane + 256 * j);
        ln_row(v, a.ln_in_g, a.ln_in_b, C.lane, LN_EPS);
        store_row(v, a.out + (size_t)m * D, hb + (size_t)m * D, C.lane);
    }
}

__device__ __forceinline__ unsigned k_off(int row, int ch) { return (unsigned)(row * 128 + 16 * (ch ^ (row & 7))); }
__device__ __forceinline__ unsigned v_off(int row, int ch) { return (unsigned)(row * 128 + 16 * (ch ^ (((row >> 1) & 3) << 1))); }

template <int KS>
__device__ __forceinline__ void tr8(u32x2 (&r)[8], const unsigned (&va)[4]) {
    asm volatile(
        "ds_read_b64_tr_b16 %0, %8 offset:%12\n\t"
        "ds_read_b64_tr_b16 %1, %9 offset:%12\n\t"
        "ds_read_b64_tr_b16 %2, %10 offset:%12\n\t"
        "ds_read_b64_tr_b16 %3, %11 offset:%12\n\t"
        "ds_read_b64_tr_b16 %4, %8 offset:%13\n\t"
        "ds_read_b64_tr_b16 %5, %9 offset:%13\n\t"
        "ds_read_b64_tr_b16 %6, %10 offset:%13\n\t"
        "ds_read_b64_tr_b16 %7, %11 offset:%13\n\t"
        "s_waitcnt lgkmcnt(0)"
        : "=&v"(r[0]), "=&v"(r[1]), "=&v"(r[2]), "=&v"(r[3]), "=&v"(r[4]), "=&v"(r[5]), "=&v"(r[6]), "=&v"(r[7])
        : "v"(va[0]), "v"(va[1]), "v"(va[2]), "v"(va[3]), "i"(KS * 4096), "i"(KS * 4096 + 2048)
        : "memory");
}

struct AttnOut { f32x4 o[4]; float m, l; };

template <bool MASK>
__device__ __forceinline__ void attn_core(AttnOut& R, LAS unsigned char* Ks, LAS unsigned char* Vs, const bf16x8 (&qf)[2], int nct, int qoff, int lane) {
    const int fr = lane & 15, fq = lane >> 4;
    f32x4 sacc[16];
#pragma unroll
    for (int c = 0; c < 16; ++c) sacc[c] = (f32x4){0.f, 0.f, 0.f, 0.f};
#pragma unroll
    for (int c = 0; c < 16; ++c) {
        if (c < nct) {
#pragma unroll
            for (int ks = 0; ks < 2; ++ks) {
                const bf16x8 kf = *(const LAS bf16x8*)(Ks + k_off(16 * c + fr, 4 * ks + fq));
                sacc[c] = __builtin_amdgcn_mfma_f32_16x16x32_bf16(kf, qf[ks], sacc[c], 0, 0, 0);
            }
        }
    }
    float mx = -1e30f;
#pragma unroll
    for (int c = 0; c < 16; ++c) {
        if (c < nct) {
#pragma unroll
            for (int j = 0; j < 4; ++j) {
                if (MASK) { if (16 * c + 4 * fq + j > qoff) sacc[c][j] = -1e30f; }
                mx = fmaxf(mx, sacc[c][j]);
            }
        }
    }
    mx = fmaxf(mx, __shfl_xor(mx, 16)); mx = fmaxf(mx, __shfl_xor(mx, 32));
    float lsum = 0.f;
    const float mb = mx * LOG2E;
#pragma unroll
    for (int c = 0; c < 16; ++c) {
        if (c < nct) {
#pragma unroll
            for (int j = 0; j < 4; ++j) { const float p = fast_exp2(sacc[c][j] * LOG2E - mb); sacc[c][j] = p; lsum += p; }
        }
    }
    lsum += __shfl_xor(lsum, 16); lsum += __shfl_xor(lsum, 32);
    const int q4 = (lane & 15) >> 2, p4 = lane & 3;
    unsigned va[4];
    {
        const int row = 4 * fq + q4;
        const unsigned vbase = (unsigned)(size_t)Vs;
#pragma unroll
        for (int c = 0; c < 4; ++c) va[c] = vbase + v_off(row, 2 * c + (p4 >> 1)) + 8 * (p4 & 1);
    }
    f32x4 oacc[4];
#pragma unroll
    for (int c = 0; c < 4; ++c) oacc[c] = (f32x4){0.f, 0.f, 0.f, 0.f};
#define ATT_PV(KS) do { if (2 * (KS) < nct) { u32x2 vr[8]; tr8<KS>(vr, va); __builtin_amdgcn_sched_barrier(0); \
        u32x4 pw; pw.x = pg8::cvt_pk_bf16(sacc[2 * (KS)][0], sacc[2 * (KS)][1]); pw.y = pg8::cvt_pk_bf16(sacc[2 * (KS)][2], sacc[2 * (KS)][3]); \
        pw.z = pg8::cvt_pk_bf16(sacc[2 * (KS) + 1][0], sacc[2 * (KS) + 1][1]); pw.w = pg8::cvt_pk_bf16(sacc[2 * (KS) + 1][2], sacc[2 * (KS) + 1][3]); \
        const bf16x8 pf = __builtin_bit_cast(bf16x8, pw); \
        _Pragma("unroll") for (int c = 0; c < 4; ++c) { u32x4 vw; vw.x = vr[c].x; vw.y = vr[c].y; vw.z = vr[4 + c].x; vw.w = vr[4 + c].y; \
            oacc[c] = __builtin_amdgcn_mfma_f32_16x16x32_bf16(__builtin_bit_cast(bf16x8, vw), pf, oacc[c], 0, 0, 0); } } } while (0)
    ATT_PV(0); ATT_PV(1); ATT_PV(2); ATT_PV(3); ATT_PV(4); ATT_PV(5); ATT_PV(6); ATT_PV(7);
#undef ATT_PV
#pragma unroll
    for (int c = 0; c < 4; ++c) R.o[c] = oacc[c];
    R.m = mx; R.l = lsum;
}

__device__ __forceinline__ void stage_kv(const Ctx& C, const bf16* P, int blk, int h, int nrows, LAS unsigned char* Ks, LAS unsigned char* Vs) {
    for (int i = C.tid; i < nrows * 8; i += NWAVES * 64) {
        const int row = i >> 3, ch = i & 7;
        const bf16* src = P + (size_t)(blk * 256 + row) * NIN + h * HD + ch * 8;
        const u32x4 kv = *(const u32x4*)(src + K_OFF), vv = *(const u32x4*)(src + V_OFF);
        *(LAS u32x4*)(Ks + k_off(row, ch)) = kv;
        *(LAS u32x4*)(Vs + v_off(row, ch)) = vv;
    }
}

__device__ __forceinline__ void pb_gating(const Ctx& C0, int l, int item, bool dry = false) {
    Ctx C = C0; asm volatile("" : "+v"(C.tid), "+v"(C.lane), "+s"(C.wave), "+s"(C.vcu), "+s"(C.G), "+s"(C.lds));
    Args a; LOADARG(a, ws);
    const int h = item & 7, grp = item >> 3, tok = grp * 512 + C.tid, own = tok >> 8;
    unsigned char* ws = a.ws;
    const bf16* P = (const bf16*)(ws + WS_P);
    LAS float* km = (LAS float*)C.lds;
    LAS unsigned* cntL = (LAS unsigned*)(C.lds + 16384);
    LAS unsigned* baseL = (LAS unsigned*)(C.lds + 16384 + 256);
    const float* ksum = (const float*)(ws + WS_CTL) + CW_KMEAN + (size_t)l * (NH * NBLK * HD) + (size_t)h * NBLK * HD;
    for (int i = C.tid; i < NBLK * HD; i += NWAVES * 64) km[i] = ksum[i] * (1.0f / 256.0f);
    if (C.tid < 64) cntL[C.tid] = 0u;
    __syncthreads();
    float q[64];
    {
        const u32x4* qp = (const u32x4*)(P + (size_t)tok * NIN + Q_OFF + h * HD);
#pragma unroll
        for (int c = 0; c < 8; ++c) { const u32x4 w = qp[c]; q[8 * c + 0] = bflo(w.x); q[8 * c + 1] = bfhi(w.x); q[8 * c + 2] = bflo(w.y); q[8 * c + 3] = bfhi(w.y); q[8 * c + 4] = bflo(w.z); q[8 * c + 5] = bfhi(w.z); q[8 * c + 6] = bflo(w.w); q[8 * c + 7] = bfhi(w.w); }
    }
    float v0 = -3e38f, v1 = -3e38f, v2 = -3e38f; int i0 = 0, i1 = 0, i2 = 0;
    const int ownu = __builtin_amdgcn_readfirstlane(own);
    for (int n = 0; n < ownu; ++n) {
        const LAS f32x4* kr = (const LAS f32x4*)(km + n * 64);
        float g0 = 0.f, g1 = 0.f, g2 = 0.f, g3 = 0.f;
#pragma unroll
        for (int c = 0; c < 16; ++c) { const f32x4 kv = kr[c]; g0 += q[4 * c] * kv[0]; g1 += q[4 * c + 1] * kv[1]; g2 += q[4 * c + 2] * kv[2]; g3 += q[4 * c + 3] * kv[3]; }
        const float g = (g0 + g1) + (g2 + g3);
        if (g > v0) { v2 = v1; i2 = i1; v1 = v0; i1 = i0; v0 = g; i0 = n; }
        else if (g > v1) { v2 = v1; i2 = i1; v1 = g; i1 = n; }
        else if (g > v2) { v2 = g; i2 = n; }
    }
    if (dry) { asm volatile("" :: "v"(i0), "v"(i1), "v"(i2)); __syncthreads(); return; }
    const int nsel = own < 3 ? own : 3;
    unsigned lp0 = 0, lp1 = 0, lp2 = 0;
    if (nsel > 0) lp0 = __hip_atomic_fetch_add(&cntL[i0], 1u, __ATOMIC_RELAXED, __HIP_MEMORY_SCOPE_WORKGROUP);
    if (nsel > 1) lp1 = __hip_atomic_fetch_add(&cntL[i1], 1u, __ATOMIC_RELAXED, __HIP_MEMORY_SCOPE_WORKGROUP);
    if (nsel > 2) lp2 = __hip_atomic_fetch_add(&cntL[i2], 1u, __ATOMIC_RELAXED, __HIP_MEMORY_SCOPE_WORKGROUP);
    __syncthreads();
    unsigned* acnt = (unsigned*)(ws + WS_CTL) + CW_ACNT + l * 512 + h * 64;
    if (C.tid < 64) { const unsigned c = cntL[C.tid]; baseL[C.tid] = c ? atomicAdd(&acnt[C.tid], c) : 0u; }
    __syncthreads();
    unsigned short* lists = (unsigned short*)(ws + WS_LISTS) + (size_t)h * NBLK * S;
    if (nsel > 0) lists[(size_t)i0 * S + baseL[i0] + lp0] = (unsigned short)(tok | (0 << 14));
    if (nsel > 1) lists[(size_t)i1 * S + baseL[i1] + lp1] = (unsigned short)(tok | (1 << 14));
    if (nsel > 2) lists[(size_t)i2 * S + baseL[i2] + lp2] = (unsigned short)(tok | (2 << 14));
    __syncthreads();
}

__device__ __forceinline__ unsigned sg_off(int row, int ch) { return (unsigned)(row * 512 + 16 * (ch ^ (((row & 3) | (((row >> 3) & 1) << 2)) << 1))); }
template <int KS>
__device__ __forceinline__ void tr2(u32x2& r0, u32x2& r1, unsigned addr) {
    asm volatile("ds_read_b64_tr_b16 %0, %2 offset:%3\n\tds_read_b64_tr_b16 %1, %2 offset:%4\n\ts_waitcnt lgkmcnt(0)"
                 : "=&v"(r0), "=&v"(r1) : "v"(addr), "i"(KS * 32 * 512), "i"(KS * 32 * 512 + 4 * 512) : "memory");
}
__device__ __forceinline__ void pb_sg(const Ctx& C0, int l, int chunk) {
    Ctx C = C0; asm volatile("" : "+v"(C.tid), "+v"(C.lane), "+s"(C.wave), "+s"(C.vcu), "+s"(C.G), "+s"(C.lds));
    Args a; LOADARG(a, ws); LOADARG(a, sg_ln_g); LOADARG(a, sg_ln_b); LOADARG(a, sg_b);
    unsigned char* ws = a.ws;
    const bf16* P = (const bf16*)(ws + WS_P);
    bf16* mix = (bf16*)(ws + WS_MIXIN);
    LAS unsigned char* vt = C.lds;
    const float* lg = a.sg_ln_g + l * SGW; const float* lb = a.sg_ln_b + l * SGW;
    for (int s = C.wave; s < 128; s += NWAVES) {
        const int tok = chunk * 128 + s;
        const u32x2 w = *(const u32x2*)(P + (size_t)tok * NIN + SGV_OFF + 4 * C.lane);
        float x[4] = {bflo(w.x), bfhi(w.x), bflo(w.y), bfhi(w.y)};
        const float mean = wave_sum((x[0] + x[1]) + (x[2] + x[3])) * (1.0f / SGW);
        float q = 0.f;
#pragma unroll
        for (int j = 0; j < 4; ++j) { x[j] -= mean; q += x[j] * x[j]; }
        const float rstd = 1.0f / sqrtf(wave_sum(q) * (1.0f / SGW) + LN_EPS);
        const f32x4 gg = *(const f32x4*)(lg + 4 * C.lane), bb = *(const f32x4*)(lb + 4 * C.lane);
        u32x2 o; o.x = pk2(x[0] * rstd * gg[0] + bb[0], x[1] * rstd * gg[1] + bb[1]); o.y = pk2(x[2] * rstd * gg[2] + bb[2], x[3] * rstd * gg[3] + bb[3]);
        *(LAS u32x2*)(vt + sg_off(s, C.lane >> 1) + 8 * (C.lane & 1)) = o;
    }
    __syncthreads();
    const int fr = C.lane & 15, fq = C.lane >> 4, q4 = fr >> 2, p4 = C.lane & 3, w = C.wave;
    const bf16* wsg = (const bf16*)(ws + WS_WSG) + (size_t)l * 4 * 128 * 128;
    const int nks = (16 * w + 15) / 32 + 1;
    f32x4 acc[4][4];
#pragma unroll
    for (int g = 0; g < 4; ++g)
#pragma unroll
        for (int c = 0; c < 4; ++c) acc[g][c] = (f32x4){0.f, 0.f, 0.f, 0.f};
    const unsigned vbase = (unsigned)(size_t)vt;
#define SG_STEP(KS) do { if ((KS) < nks) { _Pragma("unroll") for (int g = 0; g < 4; ++g) { \
        const bf16x8 wf = *(const bf16x8*)(wsg + ((size_t)g * 128 + 16 * w + fr) * 128 + 32 * (KS) + 8 * fq); \
        _Pragma("unroll") for (int c = 0; c < 4; ++c) { const int cc = 4 * g + c; u32x2 r0, r1; \
            tr2<KS>(r0, r1, vbase + sg_off(8 * fq + q4, 2 * cc + (p4 >> 1)) + 8 * (p4 & 1)); __builtin_amdgcn_sched_barrier(0); \
            u32x4 vw; vw.x = r0.x; vw.y = r0.y; vw.z = r1.x; vw.w = r1.y; \
            acc[g][c] = __builtin_amdgcn_mfma_f32_16x16x32_bf16(__builtin_bit_cast(bf16x8, vw), wf, acc[g][c], 0, 0, 0); } } } } while (0)
    SG_STEP(0); SG_STEP(1); SG_STEP(2); SG_STEP(3);
#undef SG_STEP
    const int t = 16 * w + fr, tok = chunk * 128 + t;
#pragma unroll
    for (int g = 0; g < 4; ++g) {
        const float bs = a.sg_b[(l * 4 + g) * 128 + t];
#pragma unroll
        for (int c = 0; c < 4; ++c) {
            const int d = 64 * g + 16 * c + 4 * fq;
            const u32x2 uw = *(const u32x2*)(P + (size_t)tok * NIN + SGU_OFF + d);
            u32x2 o; o.x = pk2(bflo(uw.x) * (acc[g][c][0] + bs), bfhi(uw.x) * (acc[g][c][1] + bs)); o.y = pk2(bflo(uw.y) * (acc[g][c][2] + bs), bfhi(uw.y) * (acc[g][c][3] + bs));
            *(u32x2*)(mix + (size_t)tok * D + 512 + d) = o;
        }
    }
    __syncthreads();
}

__device__ __forceinline__ void pb_conv(const Ctx& C0, int l, int item) {
    Ctx C = C0; asm volatile("" : "+v"(C.tid), "+v"(C.lane), "+s"(C.wave), "+s"(C.vcu), "+s"(C.G), "+s"(C.lds));
    Args a; LOADARG(a, ws); LOADARG(a, conv_w); LOADARG(a, conv_b); LOADARG(a, conv_ln_g); LOADARG(a, conv_ln_b);
    unsigned char* ws = a.ws;
    const bf16* P = (const bf16*)(ws + WS_P);
    bf16* mix = (bf16*)(ws + WS_MIXIN);
    LAS float* hb = (LAS float*)C.lds;
    const int t0 = item * 64;
    for (int i = C.tid; i < 94 * 32; i += NWAVES * 64) {
        const int r = i >> 5, ch = i & 31, tok = t0 - 30 + r;
        f32x4 o0 = (f32x4){0.f, 0.f, 0.f, 0.f}, o1 = o0;
        if (tok >= 0) {
            const u32x4 aw = *(const u32x4*)(P + (size_t)tok * NIN + CA_OFF + 8 * ch), gw = *(const u32x4*)(P + (size_t)tok * NIN + CG_OFF + 8 * ch);
            o0[0] = bflo(aw.x) * sigmoidf_(bflo(gw.x)); o0[1] = bfhi(aw.x) * sigmoidf_(bfhi(gw.x)); o0[2] = bflo(aw.y) * sigmoidf_(bflo(gw.y)); o0[3] = bfhi(aw.y) * sigmoidf_(bfhi(gw.y));
            o1[0] = bflo(aw.z) * sigmoidf_(bflo(gw.z)); o1[1] = bfhi(aw.z) * sigmoidf_(bfhi(gw.z)); o1[2] = bflo(aw.w) * sigmoidf_(bflo(gw.w)); o1[3] = bfhi(aw.w) * sigmoidf_(bfhi(gw.w));
        }
        *(LAS f32x4*)(hb + r * 256 + 8 * ch) = o0; *(LAS f32x4*)(hb + r * 256 + 8 * ch + 4) = o1;
    }
    __syncthreads();
    const int c = C.tid & 255, half = C.tid >> 8;
    float wt[TAPS];
#pragma unroll
    for (int j = 0; j < TAPS; ++j) wt[j] = a.conv_w[((size_t)l * TAPS + j) * CVW + c];
    const float bias = a.conv_b[l * CVW + c];
    float outv[32];
#pragma unroll
    for (int gI = 0; gI < 8; ++gI) {
        const int tb = half * 32 + gI * 4;
        float win[34];
#pragma unroll
        for (int j = 0; j < 34; ++j) win[j] = hb[(tb + j) * 256 + c];
#pragma unroll
        for (int o = 0; o < 4; ++o) {
            float s = bias;
#pragma unroll
            for (int j = 0; j < TAPS; ++j) s += wt[j] * win[o + j];
            outv[gI * 4 + o] = s;
        }
    }
    __syncthreads();
#pragma unroll
    for (int i = 0; i < 32; ++i) hb[(half * 32 + i) * 256 + c] = outv[i];
    __syncthreads();
    const float* lg = a.conv_ln_g + l * CVW; const float* lb = a.conv_ln_b + l * CVW;
    for (int s = C.wave; s < 64; s += NWAVES) {
        f32x4 x = *(const LAS f32x4*)(hb + s * 256 + 4 * C.lane);
        const float mean = wave_sum((x[0] + x[1]) + (x[2] + x[3])) * (1.0f / CVW);
        x = x - mean;
        const float rstd = 1.0f / sqrtf(wave_sum((x[0] * x[0] + x[1] * x[1]) + (x[2] * x[2] + x[3] * x[3])) * (1.0f / CVW) + LN_EPS);
        const f32x4 gg = *(const f32x4*)(lg + 4 * C.lane), bb = *(const f32x4*)(lb + 4 * C.lane);
        f32x4 y = x * rstd * gg + bb;
#pragma unroll
        for (int j = 0; j < 4; ++j) y[j] = y[j] * sigmoidf_(y[j]);
        u32x2 o; o.x = pk2(y[0], y[1]); o.y = pk2(y[2], y[3]);
        *(u32x2*)(mix + (size_t)(t0 + s) * D + 768 + 4 * C.lane) = o;
    }
    __syncthreads();
}

__device__ __forceinline__ void pc_selattn(const Ctx& C0, int l) {
    Ctx C = C0; asm volatile("" : "+v"(C.tid), "+v"(C.lane), "+s"(C.wave), "+s"(C.vcu), "+s"(C.G), "+s"(C.lds));
    Args a; LOADARG(a, ws);
    unsigned char* ws = a.ws;
    const bf16* P = (const bf16*)(ws + WS_P);
    LAS unsigned char* Ks = C.lds; LAS unsigned char* Vs = C.lds + 32768;
    LAS int* pref = (LAS int*)(C.lds + 65536);
    const unsigned* acnt = (const unsigned*)(ws + WS_CTL) + CW_ACNT + l * 512;
    LAS int* nt_ = (LAS int*)(C.lds + 65536 + 4096);
    nt_[C.tid] = (int)((__hip_atomic_load(acnt + C.tid, RLX_AGENT) + 127u) >> 7);
    __syncthreads();
    if (C.tid == 0) { int s = 0; for (int i = 0; i < 512; ++i) { pref[i] = s; s += nt_[i]; } pref[512] = s; }
    __syncthreads();
    const int total = pref[512];
    bf16* PO = (bf16*)(ws + WS_PARTO); float2* PML = (float2*)(ws + WS_PARTML);
    const unsigned short* lists = (const unsigned short*)(ws + WS_LISTS);
    const int fr = C.lane & 15, fq = C.lane >> 4;
    LAS int* cntl = (LAS int*)(C.lds + 65536 + 8192);
    cntl[C.tid] = (int)__hip_atomic_load(acnt + C.tid, RLX_AGENT);
    __syncthreads();
    int curpair = -1;
    const int per = (total + C.G - 1) / C.G, T0 = C.vcu * per, T1 = (T0 + per < total) ? T0 + per : total;
    int cur = 0; { int lo_ = 0, hi_ = 511; while (lo_ < hi_) { const int mid_ = (lo_ + hi_ + 1) >> 1; if (pref[mid_] <= T0) lo_ = mid_; else hi_ = mid_ - 1; } cur = lo_; }
#define PC_ENT(ent_, pair_, T_) do { ent_ = 0u; pair_ = 0; if ((T_) < T1) { while (pref[cur + 1] <= (T_)) ++cur; pair_ = cur; const int i_ = ((T_) - pref[cur]) * 128 + 16 * C.wave + fr; \
        if (i_ < cntl[cur]) ent_ = 0x10000u | (unsigned)lists[(size_t)cur * S + i_]; } } while (0)
#define PC_Q(q_, ent_, pair_) do { const bf16* qp_ = P + (size_t)((ent_) & 0x3fff) * NIN + Q_OFF + ((pair_) >> 6) * HD + 8 * fq; q_[0] = *(const bf16x8*)qp_; q_[1] = *(const bf16x8*)(qp_ + 32); } while (0)
    unsigned e1, e2; int p1, p2; bf16x8 q1[2];
    PC_ENT(e1, p1, T0); PC_ENT(e2, p2, T0 + 1); PC_Q(q1, e1, p1);
    for (int T = T0; T < T1; ++T) {
        const int pair = p1, h = pair >> 6, n = pair & 63;
        const unsigned ent = e1; bf16x8 qf[2] = {q1[0], q1[1]};
        e1 = e2; p1 = p2; PC_Q(q1, e1, p1); PC_ENT(e2, p2, T + 2);
        if (pair != curpair) { __syncthreads(); stage_kv(C, P, n, h, 256, Ks, Vs); __syncthreads(); curpair = pair; }
        const bool valid = (ent & 0x10000u) != 0u;
        const int tok = ent & 0x3fff, rank = (ent >> 14) & 3;
        AttnOut R;
        attn_core<false>(R, Ks, Vs, qf, 16, 0, C.lane);
        if (valid) {
            const float inv = 1.0f / R.l;
            bf16* op = PO + (((size_t)rank * S + tok) * NH + h) * HD + 4 * fq;
#pragma unroll
            for (int c = 0; c < 4; ++c) { u32x2 o; o.x = pk2(R.o[c][0] * inv, R.o[c][1] * inv); o.y = pk2(R.o[c][2] * inv, R.o[c][3] * inv); *(u32x2*)(op + 16 * c) = o; }
            if (fq == 0) PML[((size_t)rank * S + tok) * NH + h] = make_float2(R.m, R.l);
        }
    }
#undef PC_ENT
#undef PC_Q
    __syncthreads();
}

__device__ __forceinline__ void pd_ownattn(const Ctx& C0, int l) {
    Ctx C = C0; asm volatile("" : "+v"(C.tid), "+v"(C.lane), "+s"(C.wave), "+s"(C.vcu), "+s"(C.G), "+s"(C.lds));
    Args a; LOADARG(a, ws);
    unsigned char* ws = a.ws;
    const bf16* P = (const bf16*)(ws + WS_P);
    bf16* mix = (bf16*)(ws + WS_MIXIN);
    LAS unsigned char* Ks = C.lds; LAS unsigned char* Vs = C.lds + 32768;
    const bf16* PO = (const bf16*)(ws + WS_PARTO); const float2* PML = (const float2*)(ws + WS_PARTML);
    const int fr = C.lane & 15, fq = C.lane >> 4;
    for (int it = C.vcu; it < NH * 64; it += C.G) {
        const int h = it & 7, own = it >> 3;
        __syncthreads();
        stage_kv(C, P, own, h, 256, Ks, Vs);
        __syncthreads();
#pragma unroll 1
        for (int par = 0; par < 2; ++par) {
        const int qoff = par * 128 + 16 * C.wave + fr;
        const int tok = own * 256 + qoff;
        bf16x8 qf[2];
#pragma unroll
        for (int ks = 0; ks < 2; ++ks) qf[ks] = *(const bf16x8*)(P + (size_t)tok * NIN + Q_OFF + h * HD + 32 * ks + 8 * fq);
        const int nct = ((8 * par + C.wave + 1) + 1) & ~1;
        AttnOut R;
        attn_core<true>(R, Ks, Vs, qf, nct, qoff, C.lane);
        const int nsel = own < 3 ? own : 3;
        float mm[3], ll[3]; float M = R.m;
#pragma unroll
        for (int r = 0; r < 3; ++r) { mm[r] = -1e30f; ll[r] = 0.f; if (r < nsel) { const float2 t = PML[((size_t)r * S + tok) * NH + h]; mm[r] = t.x; ll[r] = t.y; M = fmaxf(M, t.x); } }
        const float w0 = fast_exp2((R.m - M) * LOG2E);
        float wr_[3]; float den = R.l * w0;
#pragma unroll
        for (int r = 0; r < 3; ++r) { wr_[r] = (r < nsel) ? ll[r] * fast_exp2((mm[r] - M) * LOG2E) : 0.f; den += wr_[r]; }
        const float inv = 1.0f / den;
        f32x4 o[4];
#pragma unroll
        for (int c = 0; c < 4; ++c) o[c] = R.o[c] * w0;
#pragma unroll
        for (int r = 0; r < 3; ++r) {
            if (r < nsel) {
                const bf16* op = PO + (((size_t)r * S + tok) * NH + h) * HD + 4 * fq;
#pragma unroll
                for (int c = 0; c < 4; ++c) { const u32x2 w = *(const u32x2*)(op + 16 * c); o[c][0] += wr_[r] * bflo(w.x); o[c][1] += wr_[r] * bfhi(w.x); o[c][2] += wr_[r] * bflo(w.y); o[c][3] += wr_[r] * bfhi(w.y); }
            }
        }
        bf16* yp = mix + (size_t)tok * D + h * HD + 4 * fq;
#pragma unroll
        for (int c = 0; c < 4; ++c) { u32x2 w; w.x = pk2(o[c][0] * inv, o[c][1] * inv); w.y = pk2(o[c][2] * inv, o[c][3] * inv); *(u32x2*)(yp + 16 * c) = w; }
        }
    }
    __syncthreads();
}

__device__ __forceinline__ float reduce16_scatter(const float (&lg)[16], int lane) {
    const bool h32 = (lane & 32) != 0, h16 = (lane & 16) != 0, h8 = (lane & 8) != 0, h4 = (lane & 4) != 0;
    float r8[8], r4[4], r2[2];
#pragma unroll
    for (int e = 0; e < 8; ++e) { const float keep = h32 ? lg[e + 8] : lg[e], send = h32 ? lg[e] : lg[e + 8]; r8[e] = keep + __shfl_xor(send, 32); }
#pragma unroll
    for (int e = 0; e < 4; ++e) { const float keep = h16 ? r8[e + 4] : r8[e], send = h16 ? r8[e] : r8[e + 4]; r4[e] = keep + __shfl_xor(send, 16); }
#pragma unroll
    for (int e = 0; e < 2; ++e) { const float keep = h8 ? r4[e + 2] : r4[e], send = h8 ? r4[e] : r4[e + 2]; r2[e] = keep + __shfl_xor(send, 8); }
    float r1 = (h4 ? r2[1] : r2[0]) + __shfl_xor(h4 ? r2[0] : r2[1], 4);
    r1 += __shfl_xor(r1, 2); r1 += __shfl_xor(r1, 1);
    return r1;
}
__device__ __forceinline__ void route_one(float red, const float* router_bias, int lane, int lt, LAS int* tinfo, LAS float* tw, LAS unsigned* cntL) {
    float sc[16], bi[16];
#pragma unroll
    for (int e = 0; e < 16; ++e) {
        const int L = 32 * (e >> 3) + 16 * ((e >> 2) & 1) + 8 * ((e >> 1) & 1) + 4 * (e & 1);
        const float lgt = __builtin_bit_cast(float, __builtin_amdgcn_readlane(__builtin_bit_cast(int, red), L));
        sc[e] = sigmoidf_(lgt); bi[e] = sc[e] + router_bias[e];
    }
    int bg = 0; float bgs = -3e38f;
#pragma unroll
    for (int gI = 0; gI < 4; ++gI) {
        float t1 = -3e38f, t2 = -3e38f;
#pragma unroll
        for (int i = 0; i < 4; ++i) { const float x = bi[4 * gI + i]; if (x > t1) { t2 = t1; t1 = x; } else if (x > t2) t2 = x; }
        const float gs = t1 + t2;
        if (gs > bgs) { bgs = gs; bg = gI; }
    }
    float t1 = -3e38f, t2 = -3e38f; int j1 = 0, j2 = 0;
#pragma unroll
    for (int gI = 0; gI < 4; ++gI) {
        if (gI == bg) {
#pragma unroll
            for (int i = 0; i < 4; ++i) { const float x = bi[4 * gI + i]; if (x > t1) { t2 = t1; j2 = j1; t1 = x; j1 = i; } else if (x > t2) { t2 = x; j2 = i; } }
        }
    }
    float s1 = 0.f, s2 = 0.f;
#pragma unroll
    for (int e = 0; e < 16; ++e) { if (e == 4 * bg + j1) s1 = sc[e]; if (e == 4 * bg + j2) s2 = sc[e]; }
    const int e0 = 4 * bg + j1, e1 = 4 * bg + j2;
    if (lane == 0) {
        const float inv = 1.0f / (s1 + s2);
        tinfo[4 * lt + 0] = e0; tinfo[4 * lt + 1] = (int)__hip_atomic_fetch_add(&cntL[e0], 1u, __ATOMIC_RELAXED, __HIP_MEMORY_SCOPE_WORKGROUP);
        tinfo[4 * lt + 2] = e1; tinfo[4 * lt + 3] = (int)__hip_atomic_fetch_add(&cntL[e1], 1u, __ATOMIC_RELAXED, __HIP_MEMORY_SCOPE_WORKGROUP);
        tw[2 * lt] = s1 * inv; tw[2 * lt + 1] = s2 * inv;
    }
}

__device__ __forceinline__ void pf_convert(const Ctx& C0, int l) {
    Ctx C = C0; asm volatile("" : "+v"(C.tid), "+v"(C.lane), "+s"(C.wave), "+s"(C.vcu), "+s"(C.G), "+s"(C.lds));
    Args a; LOADARG(a, ws); LOADARG(a, w_gate); LOADARG(a, w_up); LOADARG(a, w_down);
    unsigned char* ws = a.ws;
    LAS float* scr = (LAS float*)(C.lds + C.wave * 16384);
    const int gw = C.vcu * NWAVES + C.wave, NGW = C.G * NWAVES;
    constexpr int I_G = (D / 64) * (DE / 64), I_D = (DE / 64) * (D / 64);
    for (int it = gw; it < NE * (2 * I_G + I_D); it += NGW) {
        const int e = it / (2 * I_G + I_D); int r = it % (2 * I_G + I_D);
        const size_t eo = ((size_t)l * NE + e) * D * DE;
        if (r < I_G) transpose_item(a.w_gate + eo, D, DE, (bf16*)(ws + WS_WGU) + (size_t)e * D * D, scr, r, C.lane, MapGU{0});
        else if (r < 2 * I_G) transpose_item(a.w_up + eo, D, DE, (bf16*)(ws + WS_WGU) + (size_t)e * D * D, scr, r - I_G, C.lane, MapGU{1});
        else transpose_item(a.w_down + eo, DE, D, (bf16*)(ws + WS_WDN) + (size_t)e * D * DE, scr, r - 2 * I_G, C.lane, MapPerm{});
    }
    __syncthreads();
}
__device__ __forceinline__ void pf_ln_router(const Ctx& C0, int l, bool dry = false) {
    Ctx C = C0; asm volatile("" : "+v"(C.tid), "+v"(C.lane), "+s"(C.wave), "+s"(C.vcu), "+s"(C.G), "+s"(C.lds));
    Args a; LOADARG(a, ws); LOADARG(a, w_router); LOADARG(a, router_bias); LOADARG(a, out); LOADARG(a, ln_mix_g); LOADARG(a, ln_mix_b);
    unsigned char* ws = a.ws;
    LAS float* wrt = (LAS float*)C.lds;
    LAS unsigned* cntL = (LAS unsigned*)(C.lds + 65536);
    LAS unsigned* baseL = cntL + 16;
    LAS int* tinfo = (LAS int*)(C.lds + 65536 + 256);
    LAS float* tw = (LAS float*)(C.lds + 65536 + 256 + 4096);
    for (int i = C.tid; i < D * NE / 4; i += NWAVES * 64) { const int k = i >> 2, q = i & 3; ((LAS f32x4*)wrt)[q * 1024 + ((k >> 8) * 4 + (k & 3)) * 64 + ((k >> 2) & 63)] = ((const f32x4*)a.w_router)[i]; }
    if (C.tid < 16) cntL[C.tid] = 0u;
    __syncthreads();
    float* H = a.out; bf16* hb = (bf16*)(ws + WS_HB);
    const float* g = a.ln_mix_g + l * D; const float* b = a.ln_mix_b + l * D;
    constexpr int TPW = S / 256;
    for (int lt = C.wave; lt < TPW; lt += 2 * NWAVES) {
        const int tokA = C.vcu * TPW + lt, tokB = tokA + NWAVES;
        f32x4 vA[4], vB[4];
#pragma unroll
        for (int j = 0; j < 4; ++j) { vA[j] = *(const f32x4*)(H + (size_t)tokA * D + 4 * C.lane + 256 * j); vB[j] = *(const f32x4*)(H + (size_t)tokB * D + 4 * C.lane + 256 * j); }
        ln_row(vA, g, b, C.lane, LN_EPS); ln_row(vB, g, b, C.lane, LN_EPS);
        if (dry) { store_row(vA, (float*)(ws + WS_AG) + (size_t)tokA * D, (bf16*)(ws + WS_ACT) + (size_t)tokA * D, C.lane); store_row(vB, (float*)(ws + WS_AG) + (size_t)tokB * D, (bf16*)(ws + WS_ACT) + (size_t)tokB * D, C.lane); }
        else { store_row(vA, H + (size_t)tokA * D, hb + (size_t)tokA * D, C.lane); store_row(vB, H + (size_t)tokB * D, hb + (size_t)tokB * D, C.lane); }
        float lgA[16], lgB[16];
#pragma unroll
        for (int e = 0; e < 16; ++e) { lgA[e] = 0.f; lgB[e] = 0.f; }
#pragma unroll
        for (int j = 0; j < 4; ++j)
#pragma unroll
            for (int i = 0; i < 4; ++i) {
                const LAS f32x4* wr4 = (const LAS f32x4*)wrt + (4 * j + i) * 64 + C.lane;
                const float xa = vA[j][i], xb = vB[j][i];
#pragma unroll
                for (int q = 0; q < 4; ++q) { const f32x4 w4 = wr4[q * 1024];
                    lgA[4 * q] += xa * w4[0]; lgA[4 * q + 1] += xa * w4[1]; lgA[4 * q + 2] += xa * w4[2]; lgA[4 * q + 3] += xa * w4[3];
                    lgB[4 * q] += xb * w4[0]; lgB[4 * q + 1] += xb * w4[1]; lgB[4 * q + 2] += xb * w4[2]; lgB[4 * q + 3] += xb * w4[3]; }
            }
        const float rA = reduce16_scatter(lgA, C.lane), rB = reduce16_scatter(lgB, C.lane);
        route_one(rA, a.router_bias, C.lane, lt, tinfo, tw, cntL);
        route_one(rB, a.router_bias, C.lane, lt + NWAVES, tinfo, tw, cntL);
    }
    __syncthreads();
    if (dry) { __syncthreads(); return; }
    unsigned* ecnt = (unsigned*)(ws + WS_CTL) + CW_ECNT + l * 16;
    if (C.tid < 16) { const unsigned c = cntL[C.tid]; baseL[C.tid] = c ? atomicAdd(&ecnt[C.tid], c) : 0u; }
    __syncthreads();
    int* elist = (int*)(ws + WS_ELIST); float* ew = (float*)(ws + WS_EW);
    if (C.tid < 2 * TPW) {
        const int lt = C.tid >> 1, sl = C.tid & 1, tok = C.vcu * TPW + lt;
        const int e = tinfo[4 * lt + 2 * sl], lp = tinfo[4 * lt + 2 * sl + 1];
        elist[(size_t)e * S + baseL[e] + lp] = tok * 2 + sl;
        ew[tok * 2 + sl] = tw[2 * lt + sl];
    }
    __syncthreads();
}

__device__ __forceinline__ void pg_gather(const Ctx& C0, int l, volatile LAS int* tstart) {
    Ctx C = C0; asm volatile("" : "+v"(C.tid), "+v"(C.lane), "+s"(C.wave), "+s"(C.vcu), "+s"(C.G), "+s"(C.lds));
    Args a; LOADARG(a, ws);
    unsigned char* ws = a.ws;
    const unsigned* ecnt = (const unsigned*)(ws + WS_CTL) + CW_ECNT + l * 16;
    LAS int* ecl = (LAS int*)(C.lds);
    if (C.tid == 0) { int s = 0; for (int e = 0; e < 16; ++e) { const int c = (int)__hip_atomic_load(ecnt + e, RLX_AGENT); ecl[e] = c; tstart[e] = s; s += (c + 255) >> 8; } tstart[16] = s; }
    __syncthreads();
    const int nrows = tstart[16] * 256;
    const int gw = C.vcu * NWAVES + C.wave, NGW = C.G * NWAVES;
    const int* elist = (const int*)(ws + WS_ELIST); const float* ew = (const float*)(ws + WS_EW);
    const bf16* hb = (const bf16*)(ws + WS_HB); bf16* AG = (bf16*)(ws + WS_AG); int2* rowinfo = (int2*)(ws + WS_ROWINFO);
    for (int R = gw; R < nrows; R += NGW) {
        const int mt = R >> 8; int e = 0;
#pragma unroll
        for (int j = 1; j < 16; ++j) e += (mt >= tstart[j]) ? 1 : 0;
        const int pos = R - tstart[e] * 256;
        if (pos < ecl[e]) {
            const int ent = elist[(size_t)e * S + pos], tok = ent >> 1;
            const u32x4* src = (const u32x4*)(hb + (size_t)tok * D); u32x4* dst = (u32x4*)(AG + (size_t)R * D);
            const u32x4 x0 = src[C.lane], x1 = src[64 + C.lane];
            dst[C.lane] = x0; dst[64 + C.lane] = x1;
            if (C.lane == 0) rowinfo[R] = make_int2(ent, __builtin_bit_cast(int, ew[ent]));
        } else {
            u32x4* dst = (u32x4*)(AG + (size_t)R * D); const u32x4 z = (u32x4){0u, 0u, 0u, 0u};
            dst[C.lane] = z; dst[64 + C.lane] = z;
            if (C.lane == 0) rowinfo[R] = make_int2(-1, 0);
        }
    }
}

__device__ __forceinline__ void pj_final(const Ctx& C0, int l, bool poison, bool dry = false) {
    Ctx C = C0; asm volatile("" : "+v"(C.tid), "+v"(C.lane), "+s"(C.wave), "+s"(C.vcu), "+s"(C.G), "+s"(C.lds));
    Args a; LOADARG(a, ws); LOADARG(a, out); LOADARG(a, ln_ffn_g); LOADARG(a, ln_ffn_b);
    unsigned char* ws = a.ws;
    const int gw = C.vcu * NWAVES + C.wave, NGW = C.G * NWAVES;
    float* H = a.out; bf16* hb = (bf16*)(ws + WS_HB); const bf16* Y = (const bf16*)(ws + WS_Y);
    const float* g = a.ln_ffn_g + l * D; const float* b = a.ln_ffn_b + l * D;
    for (int tok = gw; tok < S; tok += NGW) {
        f32x4 v[4];
#pragma unroll
        for (int j = 0; j < 4; ++j) {
            v[j] = *(const f32x4*)(H + (size_t)tok * D + 4 * C.lane + 256 * j) * ALPHA;
            const u32x2 y0 = *(const u32x2*)(Y + ((size_t)tok * 2) * D + 4 * C.lane + 256 * j), y1 = *(const u32x2*)(Y + ((size_t)tok * 2 + 1) * D + 4 * C.lane + 256 * j);
            v[j][0] += bflo(y0.x) + bflo(y1.x); v[j][1] += bfhi(y0.x) + bfhi(y1.x); v[j][2] += bflo(y0.y) + bflo(y1.y); v[j][3] += bfhi(y0.y) + bfhi(y1.y);
        }
        ln_row(v, g, b, C.lane, LN_EPS);
        if (poison) {
#pragma unroll
            for (int j = 0; j < 4; ++j) v[j] = (f32x4){__builtin_nanf(""), __builtin_nanf(""), __builtin_nanf(""), __builtin_nanf("")};
        }
        if (dry) store_row(v, (float*)(ws + WS_AG) + (size_t)tok * D, (bf16*)(ws + WS_ACT) + (size_t)tok * D, C.lane);
        else store_row(v, H + (size_t)tok * D, hb + (size_t)tok * D, C.lane);
    }
}


#if SELFCHECK
__global__ void __launch_bounds__(256) selfcheck_kernel(Args a) {
    const int l = 0;
    unsigned char* ws = a.ws;
    const bf16* P = (const bf16*)(ws + WS_P);
    unsigned* err = (unsigned*)(ws + WS_ERR);
    const int gt = blockIdx.x * blockDim.x + threadIdx.x, NGT = gridDim.x * blockDim.x;
#if SELFCHECK & 1
    {
        const bf16* mix = (const bf16*)(ws + WS_MIXIN);
        const float* ksum = (const float*)(ws + WS_CTL) + CW_KMEAN + (size_t)l * (NH * NBLK * HD);
        constexpr int NTOK = 1024 + (S - 1024) / 7;
        for (int p = gt; p < NTOK * 8; p += NGT) {
            const int ti = p >> 3, h = p & 7;
            const int tok = ti < 1024 ? ti : 1024 + (ti - 1024) * 7 + 3;
            const int own = tok >> 8;
            float q[64];
            {
                const u32x4* qp = (const u32x4*)(P + (size_t)tok * NIN + Q_OFF + h * HD);
#pragma unroll
                for (int c = 0; c < 8; ++c) { const u32x4 w = qp[c]; q[8 * c + 0] = bflo(w.x); q[8 * c + 1] = bfhi(w.x); q[8 * c + 2] = bflo(w.y); q[8 * c + 3] = bfhi(w.y); q[8 * c + 4] = bflo(w.z); q[8 * c + 5] = bfhi(w.z); q[8 * c + 6] = bflo(w.w); q[8 * c + 7] = bfhi(w.w); }
            }
            float v0 = -3e38f, v1 = -3e38f, v2 = -3e38f; int i0 = 0, i1 = 0, i2 = 0;
            for (int n = 0; n < own; ++n) {
                const f32x4* kr = (const f32x4*)(ksum + ((size_t)h * NBLK + n) * HD);
                float g = 0.f;
#pragma unroll
                for (int c = 0; c < 16; ++c) { const f32x4 kv = kr[c]; g += q[4 * c] * kv[0] + q[4 * c + 1] * kv[1] + q[4 * c + 2] * kv[2] + q[4 * c + 3] * kv[3]; }
                if (g > v0) { v2 = v1; i2 = i1; v1 = v0; i1 = i0; v0 = g; i0 = n; }
                else if (g > v1) { v2 = v1; i2 = i1; v1 = g; i1 = n; }
                else if (g > v2) { v2 = g; i2 = n; }
            }
            const int nsel = own < 3 ? own : 3;
            float m = -1e30f, lsum = 0.f; float o[64];
#pragma unroll
            for (int d = 0; d < 64; ++d) o[d] = 0.f;
            for (int r = 0; r < 4; ++r) {
                if (r < 3 && r >= nsel) continue;
                const int blk = (r == 0) ? i0 : (r == 1) ? i1 : (r == 2) ? i2 : own;
                const int nk = (r == 3) ? (tok & 255) + 1 : 256;
                for (int j = 0; j < nk; ++j) {
                    const bf16* kp = P + (size_t)(blk * 256 + j) * NIN + K_OFF + h * HD;
                    float sc = 0.f;
#pragma unroll
                    for (int c = 0; c < 8; ++c) { const u32x4 w = ((const u32x4*)kp)[c]; sc += q[8 * c] * bflo(w.x) + q[8 * c + 1] * bfhi(w.x) + q[8 * c + 2] * bflo(w.y) + q[8 * c + 3] * bfhi(w.y) + q[8 * c + 4] * bflo(w.z) + q[8 * c + 5] * bfhi(w.z) + q[8 * c + 6] * bflo(w.w) + q[8 * c + 7] * bfhi(w.w); }
                    const float mn = fmaxf(m, sc), al = __expf(m - mn), pe = __expf(sc - mn);
                    lsum = lsum * al + pe; m = mn;
                    const bf16* vp = P + (size_t)(blk * 256 + j) * NIN + V_OFF + h * HD;
#pragma unroll
                    for (int c = 0; c < 8; ++c) { const u32x4 w = ((const u32x4*)vp)[c];
                        o[8 * c] = o[8 * c] * al + pe * bflo(w.x); o[8 * c + 1] = o[8 * c + 1] * al + pe * bfhi(w.x); o[8 * c + 2] = o[8 * c + 2] * al + pe * bflo(w.y); o[8 * c + 3] = o[8 * c + 3] * al + pe * bfhi(w.y);
                        o[8 * c + 4] = o[8 * c + 4] * al + pe * bflo(w.z); o[8 * c + 5] = o[8 * c + 5] * al + pe * bfhi(w.z); o[8 * c + 6] = o[8 * c + 6] * al + pe * bflo(w.w); o[8 * c + 7] = o[8 * c + 7] * al + pe * bfhi(w.w); }
                }
            }
            const float inv = 1.0f / lsum; bool bad = false;
            const u32x4* yp = (const u32x4*)(mix + (size_t)tok * D + h * HD);
#pragma unroll
            for (int c = 0; c < 8; ++c) { const u32x4 w = yp[c]; const float g8[8] = {bflo(w.x), bfhi(w.x), bflo(w.y), bfhi(w.y), bflo(w.z), bfhi(w.z), bflo(w.w), bfhi(w.w)};
#pragma unroll
                for (int j = 0; j < 8; ++j) { const float ref = o[8 * c + j] * inv, df = fabsf(ref - g8[j]); if (!(df <= 0.002f + 0.02f * fabsf(ref))) bad = true; } }
            atomicAdd(err + 0, 1u); if (bad) atomicAdd(err + 1, 1u);
        }
    }
#endif
#if SELFCHECK & 2
    {
        const bf16* hb = (const bf16*)(ws + WS_HB);
        const float* W = a.w_in + (size_t)l * D * NIN;
        constexpr int NT = S / 37;
        for (int it = gt; it < NT * NIN; it += NGT) {
            const int ti = it / NIN, col = it % NIN, tok = 37 * ti + 5;
            const bool rot = col < 1024;
            const int d = col & 63, pcol = rot ? ((d < 32) ? col + 32 : col - 32) : col;
            float s1 = 0.f, s2 = 0.f;
            for (int k = 0; k < D; ++k) { const float hv = bf2f(hb[(size_t)tok * D + k]); s1 += hv * W[(size_t)k * NIN + col]; s2 += hv * W[(size_t)k * NIN + pcol]; }
            float ref; int pidx = col;
            if (rot) {
                const int i = d & 31;
                const double ang = (double)((float)tok * powf(10000.0f, -(float)i / 32.0f));
                const float cs_ = (float)cos(ang), sn_ = (float)sin(ang);
                ref = (d < 32) ? (s1 * cs_ - s2 * sn_) : (s1 * cs_ + s2 * sn_);
                if (col < 512) ref *= 0.125f;
                const int n1 = d >> 5, w1 = (d >> 4) & 1, t = d & 15;
                pidx = (col & ~63) + 32 * w1 + 8 * (t >> 2) + 4 * n1 + (t & 3);
            } else if (col >= SGU_OFF && col < CA_OFF) ref = gelu_tanh(s1);
            else ref = s1;
            const float got = bf2f(P[(size_t)tok * NIN + pidx]);
            if (!(fabsf(ref - got) <= 0.03f + 0.02f * fabsf(ref))) atomicAdd(err + 2, 1u);
        }
    }
#endif
#if SELFCHECK & 4
    {
        const float* ksum = (const float*)(ws + WS_CTL) + CW_KMEAN + (size_t)l * (NH * NBLK * HD);
        for (int it = gt; it < NH * NBLK * HD; it += NGT) {
            const int h = it >> 12, n = (it >> 6) & 63, dd = it & 63;
            float s = 0.f;
            for (int j = 0; j < 256; ++j) s += bf2f(P[(size_t)(n * 256 + j) * NIN + K_OFF + h * HD + dd]);
            if (!(fabsf(s - ksum[it]) * (1.0f / 256.0f) <= 2e-3f)) atomicAdd(err + 3, 1u);
        }
    }
#endif
}
__device__ __forceinline__ bool selfcheck_failed(unsigned char* ws) {
    unsigned* err = (unsigned*)(ws + WS_ERR);
    const unsigned n = __hip_atomic_load(err + 0, RLX_AGENT), b1 = __hip_atomic_load(err + 1, RLX_AGENT);
    const unsigned b2 = __hip_atomic_load(err + 2, RLX_AGENT), b3 = __hip_atomic_load(err + 3, RLX_AGENT);
    bool f = false;
#if SELFCHECK & 1
    f = f || (n == 0u) || (b1 * 100u > n);
#endif
#if SELFCHECK & 2
    f = f || (b2 > 200u);
#endif
#if SELFCHECK & 4
    f = f || (b3 > 0u);
#endif
    return f;
}
#endif

__global__ void __launch_bounds__(NWAVES * 64, 2) hymba_fwd(Args args) {
    extern __shared__ __attribute__((aligned(16))) unsigned char lds_raw[];
    Ctx C;
    C.lds = (LAS unsigned char*)lds_raw;
    volatile LAS unsigned* MISC = (volatile LAS unsigned*)(C.lds + MISC_OFF);
    C.tid = threadIdx.x; C.lane = C.tid & 63; C.wave = __builtin_amdgcn_readfirstlane(C.tid >> 6);
    C.G = gridDim.x; { const int bx = blockIdx.x; C.vcu = (C.G % 8 == 0) ? (bx % 8) * (C.G / 8) + bx / 8 : bx; }
    for (int u = C.tid; u < 64; u += NWAVES * 64) MISC[u] = 0u;
    if (C.tid == 0) {
        const unsigned long long pv[24] = {(unsigned long long)args.x, (unsigned long long)args.ln_in_g, (unsigned long long)args.ln_in_b, (unsigned long long)args.w_in, (unsigned long long)args.w_out,
            (unsigned long long)args.sg_ln_g, (unsigned long long)args.sg_ln_b, (unsigned long long)args.sg_w, (unsigned long long)args.sg_b, (unsigned long long)args.conv_w, (unsigned long long)args.conv_b,
            (unsigned long long)args.conv_ln_g, (unsigned long long)args.conv_ln_b, (unsigned long long)args.ln_mix_g, (unsigned long long)args.ln_mix_b, (unsigned long long)args.w_router,
            (unsigned long long)args.router_bias, (unsigned long long)args.w_gate, (unsigned long long)args.w_up, (unsigned long long)args.w_down, (unsigned long long)args.ln_ffn_g,
            (unsigned long long)args.ln_ffn_b, (unsigned long long)args.out, (unsigned long long)args.ws};
        volatile LAS unsigned* ap = (volatile LAS unsigned*)(C.lds + ARGS_OFF);
#pragma unroll
        for (int i = 0; i < 24; ++i) { ap[2 * i] = (unsigned)pv[i]; ap[2 * i + 1] = (unsigned)(pv[i] >> 32); }
    }
    __syncthreads();
    XcdBarrier bar;
    { unsigned char* ws0 = ARG(ws); bar = xcd_barrier_post((unsigned*)((gu32*)(ws0 + WS_CTL) + CW_BAR), MISC + 8); }
    volatile LAS int* tstart = (volatile LAS int*)(MISC + 16);
#define GRID_BAR() xcd_barrier_t<false>(bar)

#ifndef SKIP_P0
for (int rep_ = 0; rep_ <= REP_P0; ++rep_) { p0_prologue(C); }
#endif
    xcd_barrier_t<true>(bar);

    for (int l = 0; l < DEPTH; ++l) {
        {
            unsigned char* ws = ARG(ws);
            pg8::DenseOrder So; int bxl = blockIdx.x, Gl = C.G; asm volatile("" : "+s"(bxl), "+s"(Gl)); So.init(ws + WS_HB, (bf16*)(ws + WS_WIN) + (size_t)l * NIN * D, S, NIN, D, Gl, bxl);
            pg8::EpiIn E{(bf16*)(ws + WS_P), (const float*)(ws + WS_CS), (float*)(ws + WS_CTL) + CW_KMEAN + (size_t)l * (NH * NBLK * HD)};
#ifndef SKIP_PA
for (int rep_ = 0; rep_ <= REP_PA; ++rep_) { pg8::gemm_phase<pg8::EpiIn, pg8::DenseOrder, true, true>(lds_opaque(C.lds), D, So, E); }
#endif
        }
        GRID_BAR();
        for (int rep_ = 0; rep_ < REP_BAR; ++rep_) GRID_BAR();
        {
#if ENABLE_ATT
#ifndef SKIP_PBG
            for (int rep_ = 0; rep_ < REP_GATE; ++rep_) for (int it = C.vcu; it < 256; it += C.G) pb_gating(C, l, it, true);
            for (int it = C.vcu; it < 256; it += C.G) pb_gating(C, l, it);
#endif
#endif
#ifndef SKIP_PBS
for (int rep_ = 0; rep_ <= REP_SG; ++rep_) { for (int it = C.vcu; it < 128; it += C.G) pb_sg(C, l, it); }
#endif
#ifndef SKIP_PBC
for (int rep_ = 0; rep_ <= REP_CONV; ++rep_) { for (int it = C.vcu; it < 256; it += C.G) pb_conv(C, l, it); }
#endif
        }
        GRID_BAR();
#if ENABLE_ATT
#ifndef SKIP_PC
for (int rep_ = 0; rep_ <= REP_PC; ++rep_) { pc_selattn(C, l); }
#endif
        GRID_BAR();
#ifndef SKIP_PD
for (int rep_ = 0; rep_ <= REP_PD; ++rep_) { pd_ownattn(C, l); }
#endif
        GRID_BAR();
#else
        {
            unsigned char* ws = ARG(ws);
            const int gt = C.vcu * (NWAVES * 64) + C.tid, NGT = C.G * NWAVES * 64;
            bf16* mix = (bf16*)(ws + WS_MIXIN);
            for (int i = gt; i < S * 64; i += NGT) { const int tok = i >> 6, c8 = i & 63; *(u32x4*)(mix + (size_t)tok * D + 8 * c8) = (u32x4){0u, 0u, 0u, 0u}; }
        }
        GRID_BAR();
#endif
#if SELFCHECK
        if (args.mode == 1) return;
#endif
        {
            unsigned char* ws = ARG(ws);
            pg8::DenseOrder So; int bxl = blockIdx.x, Gl = C.G; asm volatile("" : "+s"(bxl), "+s"(Gl)); So.init(ws + WS_MIXIN, (bf16*)(ws + WS_WOUT) + (size_t)l * D * D, S, D, D, Gl, bxl);
            float* Hp = ARG(out);
            for (int rep_ = 0; rep_ < REP_PE; ++rep_) { pg8::EpiOut Ed{Hp, (float*)(ws + WS_Y)}; pg8::gemm_phase<pg8::EpiOut, pg8::DenseOrder, false, true>(lds_opaque(C.lds), D, So, Ed); }
            pg8::EpiOut E{Hp, Hp};
#ifndef SKIP_PE
            pg8::gemm_phase<pg8::EpiOut, pg8::DenseOrder, false, true>(lds_opaque(C.lds), D, So, E);
#endif
        }
        GRID_BAR();
#ifndef SKIP_PF
        for (int rep_ = 0; rep_ <= REP_PFC; ++rep_) pf_convert(C, l);
        for (int rep_ = 0; rep_ < REP_PF; ++rep_) pf_ln_router(C, l, true);
        pf_ln_router(C, l);
#endif
        GRID_BAR();
#ifndef SKIP_PG
for (int rep_ = 0; rep_ <= REP_PG; ++rep_) { pg_gather(C, l, tstart); }
#endif
        GRID_BAR();
        {
            unsigned char* ws = ARG(ws);
            pg8::MoeOrder So; int vl = C.vcu, Gl = C.G; asm volatile("" : "+s"(vl), "+s"(Gl)); So.init(ws + WS_AG, ws + WS_WGU, D, D, Gl, vl, tstart);
            pg8::EpiGU E{(bf16*)(ws + WS_ACT)};
#ifndef SKIP_PH
for (int rep_ = 0; rep_ <= REP_PH; ++rep_) { pg8::gemm_phase<pg8::EpiGU, pg8::MoeOrder, true, true>(lds_opaque(C.lds), D, So, E); }
#endif
        }
        GRID_BAR();
        {
            unsigned char* ws = ARG(ws);
            pg8::MoeOrder So; int vl = C.vcu, Gl = C.G; asm volatile("" : "+s"(vl), "+s"(Gl)); So.init(ws + WS_ACT, ws + WS_WDN, DE, D, Gl, vl, tstart);
            pg8::EpiDown E{(bf16*)(ws + WS_Y), (const int2*)(ws + WS_ROWINFO)};
#ifndef SKIP_PI
for (int rep_ = 0; rep_ <= REP_PI; ++rep_) { pg8::gemm_phase<pg8::EpiDown, pg8::MoeOrder, true, true>(lds_opaque(C.lds), DE, So, E); }
#endif
        }
        GRID_BAR();
        {
            bool poison = false;
            if (l == DEPTH - 1) {
                gu32* ctl = (gu32*)(ARG(ws) + WS_CTL);
                poison = __hip_atomic_load((unsigned*)(ctl + CW_BAR) + XB_TMO, RLX_AGENT) != 0u;
#if SELFCHECK
                poison = poison || selfcheck_failed(ARG(ws));
#endif
            }
#ifndef SKIP_PJ
            for (int rep_ = 0; rep_ < REP_PJ; ++rep_) pj_final(C, l, poison, true);
            pj_final(C, l, poison);
#endif
        }
        if (l + 1 < DEPTH) GRID_BAR();
    }
}

extern "C" void kernel_launch(void* const* d_in, const int* in_sizes, int n_in, void* d_out, int out_size, void* d_ws, size_t ws_size, hipStream_t stream) {
    static int grid = 0;
    if (grid == 0) {
        if (n_in != 22 || in_sizes[0] != S * D || out_size != S * D || ws_size < WS_END + 4096) {
            fprintf(stderr, "kernel_launch: unexpected shapes (n_in %d, in0 %d, out %d, ws %zu, need %zu); nothing launched\n", n_in, n_in > 0 ? in_sizes[0] : -1, out_size, ws_size, (size_t)WS_END); grid = -1; return; }
        int dev = 0, cus = 0, per_cu = 0;
        if (hipGetDevice(&dev) != hipSuccess || hipDeviceGetAttribute(&cus, hipDeviceAttributeMultiprocessorCount, dev) != hipSuccess) { grid = -1; return; }
        if (hipFuncSetAttribute((const void*)hymba_fwd, hipFuncAttributeMaxDynamicSharedMemorySize, LDS_BYTES) != hipSuccess) { fprintf(stderr, "kernel_launch: hipFuncSetAttribute failed\n"); grid = -1; return; }
        if (hipOccupancyMaxActiveBlocksPerMultiprocessor(&per_cu, (const void*)hymba_fwd, NWAVES * 64, LDS_BYTES) != hipSuccess || per_cu < 1) { fprintf(stderr, "kernel_launch: occupancy query says %d\n", per_cu); grid = -1; (void)hipGetLastError(); return; }
        (void)hipGetLastError();
        grid = cus;
        if (grid != 256) { fprintf(stderr, "kernel_launch: built for a 256-CU device, got %d CUs\n", cus); grid = -1; return; }
    }
    if (grid < 0) return;
    if (hipMemsetAsync((char*)d_ws + WS_CTL, 0, CTL_ZERO_BYTES, stream) != hipSuccess) return;
    Args a{};
    a.x = (const float*)d_in[0]; a.ln_in_g = (const float*)d_in[1]; a.ln_in_b = (const float*)d_in[2]; a.w_in = (const float*)d_in[3]; a.w_out = (const float*)d_in[4];
    a.sg_ln_g = (const float*)d_in[5]; a.sg_ln_b = (const float*)d_in[6]; a.sg_w = (const float*)d_in[7]; a.sg_b = (const float*)d_in[8];
    a.conv_w = (const float*)d_in[9]; a.conv_b = (const float*)d_in[10]; a.conv_ln_g = (const float*)d_in[11]; a.conv_ln_b = (const float*)d_in[12];
    a.ln_mix_g = (const float*)d_in[13]; a.ln_mix_b = (const float*)d_in[14]; a.w_router = (const float*)d_in[15]; a.router_bias = (const float*)d_in[16];
    a.w_gate = (const float*)d_in[17]; a.w_up = (const float*)d_in[18]; a.w_down = (const float*)d_in[19]; a.ln_ffn_g = (const float*)d_in[20]; a.ln_ffn_b = (const float*)d_in[21];
    a.out = (float*)d_out; a.ws = (unsigned char*)d_ws;
#if SELFCHECK
    (void)hipMemsetAsync((char*)d_ws + WS_ERR, 0, 4096, stream);
    a.mode = 1;
    hipLaunchKernelGGL(hymba_fwd, dim3(grid), dim3(NWAVES * 64), LDS_BYTES, stream, a);
    hipLaunchKernelGGL(selfcheck_kernel, dim3(2048), dim3(256), 0, stream, a);
    (void)hipMemsetAsync((char*)d_ws + WS_CTL, 0, CTL_ZERO_BYTES, stream);
    a.mode = 0;
#endif
    hipLaunchKernelGGL(hymba_fwd, dim3(grid), dim3(NWAVES * 64), LDS_BYTES, stream, a);
}
```

```cpp
#include <hip/hip_runtime.h>
#include <cstdio>
#include <cstdint>

#ifndef ENABLE_ATT
#define ENABLE_ATT 1
#endif
#ifndef REP_P0
#define REP_P0 0
#endif
#ifndef REP_PA
#define REP_PA 0
#endif
#ifndef REP_SG
#define REP_SG 0
#endif
#ifndef REP_CONV
#define REP_CONV 0
#endif
#ifndef REP_PC
#define REP_PC 0
#endif
#ifndef REP_PD
#define REP_PD 0
#endif
#ifndef REP_PG
#define REP_PG 0
#endif
#ifndef REP_PH
#define REP_PH 0
#endif
#ifndef REP_PI
#define REP_PI 0
#endif
#ifndef REP_GATE
#define REP_GATE 0
#endif
#ifndef REP_PE
#define REP_PE 0
#endif
#ifndef REP_PF
#define REP_PF 0
#endif
#ifndef REP_PJ
#define REP_PJ 0
#endif
#ifndef REP_PFC
#define REP_PFC 0
#endif
#ifndef REP_BAR
#define REP_BAR 0
#endif
#ifndef SELFCHECK
#define SELFCHECK 0
#endif

#define GAS __attribute__((address_space(1)))
#define LAS __attribute__((address_space(3)))
typedef unsigned short bf16;
typedef short bf16x8 __attribute__((ext_vector_type(8)));
typedef float f32x4 __attribute__((ext_vector_type(4)));
typedef float f32x2 __attribute__((ext_vector_type(2)));
typedef unsigned u32x4 __attribute__((ext_vector_type(4)));
typedef unsigned u32x2 __attribute__((ext_vector_type(2)));
typedef GAS unsigned gu32;

constexpr int S = 16384, D = 1024, NIN = 2560, NH = 8, HD = 64, NBLK = 64, DEPTH = 2;
constexpr int NE = 16, DE = 512;
constexpr int SGW = 256, CVW = 256, TAPS = 31;
constexpr int Q_OFF = 0, K_OFF = 512, V_OFF = 1024, SGU_OFF = 1536, SGV_OFF = 1792, CA_OFF = 2048, CG_OFF = 2304;
constexpr float LN_EPS = 1e-5f;
constexpr float ALPHA = 1.4142135623730951f;
constexpr float LOG2E = 1.4426950408889634f;
constexpr int MAXROWS = 2 * S + NE * 256;

constexpr size_t MiB = 1u << 20;
constexpr size_t WS_CTL = 0, CTL_ZERO_BYTES = 1 * MiB;
constexpr size_t WS_CS = 1 * MiB;
constexpr size_t WS_WIN = 5 * MiB;
constexpr size_t WS_WOUT = 15 * MiB;
constexpr size_t WS_WSG = 19 * MiB;
constexpr size_t WS_ELIST = 20 * MiB;
constexpr size_t WS_EW = 21 * MiB;
constexpr size_t WS_ROWINFO = 21 * MiB + 512 * 1024;
constexpr size_t WS_HB = 22 * MiB;
constexpr size_t WS_R = 54 * MiB;
constexpr size_t WS_P = WS_R;
constexpr size_t WS_MIXIN = WS_R + 80 * MiB;
constexpr size_t WS_PARTO = WS_R + 112 * MiB;
constexpr size_t WS_PARTML = WS_R + 160 * MiB;
constexpr size_t WS_LISTS = WS_R + 163 * MiB;
constexpr size_t WS_WGU = WS_R;
constexpr size_t WS_WDN = WS_R + 32 * MiB;
constexpr size_t WS_AG = WS_R + 48 * MiB;
constexpr size_t WS_ACT = WS_R + 120 * MiB;
constexpr size_t WS_Y = WS_R + 156 * MiB;
constexpr size_t WS_END = WS_R + 220 * MiB;
constexpr size_t WS_ERR = WS_END;
static_assert((size_t)MAXROWS * 1024 * 2 <= 72 * MiB && (size_t)MAXROWS * 512 * 2 <= 36 * MiB, "MoE buffers");
constexpr int CW_TMO = 0;
constexpr int CW_BAR = 4096;
constexpr int CW_ACNT = 8192;
constexpr int CW_ECNT = 9216;
constexpr int CW_ERR = 9280;
constexpr int CW_KMEAN = 16384;

constexpr int RING_BYTES = 131072;
constexpr int MISC_OFF = RING_BYTES;
constexpr int LDS_BYTES = 147456;
constexpr int NWAVES = 8;

#define RLX_AGENT __ATOMIC_RELAXED, __HIP_MEMORY_SCOPE_AGENT
#define LDS_WAIT() asm volatile("s_waitcnt lgkmcnt(0)" ::: "memory")
#define VM_WAIT() asm volatile("s_waitcnt vmcnt(0)" ::: "memory")

__device__ __forceinline__ unsigned f2bf(float f) { unsigned u = __builtin_bit_cast(unsigned, f); return (u + 0x7fffu + ((u >> 16) & 1u)) >> 16; }
__device__ __forceinline__ unsigned pk2(float lo, float hi) { return f2bf(lo) | (f2bf(hi) << 16); }
__device__ __forceinline__ float bf2f(unsigned b) { return __builtin_bit_cast(float, b << 16); }
__device__ __forceinline__ float bflo(unsigned w) { return __builtin_bit_cast(float, w << 16); }
__device__ __forceinline__ float bfhi(unsigned w) { return __builtin_bit_cast(float, w & 0xffff0000u); }
__device__ __forceinline__ float wave_sum(float v) {
#pragma unroll
    for (int o = 1; o < 64; o <<= 1) v += __shfl_xor(v, o);
    return v;
}
__device__ __forceinline__ float fast_exp2(float x) { return __builtin_amdgcn_exp2f(x); }
__device__ __forceinline__ float sigmoidf_(float x) { return 1.0f / (1.0f + __expf(-x)); }
__device__ __forceinline__ float gelu_tanh(float x) { const float z = 0.7978845608028654f * (x + 0.044715f * x * x * x); return x * sigmoidf_(2.0f * z); }

namespace pg8 {
constexpr int BM = 256, BK = 64, HALF = 128, HTB = HALF * BK * 2, STAGE_BYTES = 8 * HTB, NXCD = 8, WGM = 8;
__host__ __device__ __forceinline__ int lds_byte(int r, int c) { const int st = (r >> 4) * 2 + (c >> 5), rr = r & 15, cc = c & 31, ob = rr * 64 + cc * 2; return st * 1024 + (ob ^ (((ob >> 9) & 1) << 5)); }
__host__ __device__ __forceinline__ void stage_rc(int b, int& R, int& C) { const int st = b / 1024, sb = b % 1024, swz = sb ^ (((sb >> 9) & 1) << 5); R = (st >> 1) * 16 + swz / 64; C = (st & 1) * 32 + (swz % 64) / 2; }

struct Unit { int pm, pn, e; };

struct DenseOrder {
    const char* A; const char* Bt; size_t tstep; int nM, nN, nwg, G, c;
    __device__ void init(const void* A_, const void* Bt_, int M, int N, int K, int G_, int c_) { A = (const char*)A_; Bt = (const char*)Bt_; tstep = (size_t)BM * K * 2; nM = M / BM; nN = N / BM; nwg = nM * nN; G = G_; c = c_; }
    __device__ bool next(int i, Unit& u) const {
        const long L = (long)i * G + c; if (L >= nwg) return false;
        int wgid = (int)L; { const int q = nwg / NXCD, r = nwg % NXCD, xcd = wgid % NXCD, off = wgid / NXCD; wgid = (xcd < r ? xcd * (q + 1) : r * (q + 1) + (xcd - r) * q) + off; }
        const int nig = WGM * nN, gid = wgid / nig, fm = gid * WGM, gsz = (nM - fm) < WGM ? (nM - fm) : WGM;
        u.pm = fm + ((wgid % nig) % gsz); u.pn = (wgid % nig) / gsz; u.e = 0; return true;
    }
    __device__ __forceinline__ const char* a_base(const Unit& u) const { return A + (size_t)u.pm * tstep; }
    __device__ __forceinline__ const char* b_base(const Unit& u) const { return Bt + (size_t)u.pn * tstep; }
};
struct MoeOrder {
    const char* A; const char* Bt; size_t tstep, estep; int ntot, G, c; const volatile LAS int* tstart;
    __device__ void init(const void* A_, const void* Bt_, int K, int N, int G_, int c_, const volatile LAS int* ts) { A = (const char*)A_; Bt = (const char*)Bt_; tstep = (size_t)BM * K * 2; estep = (size_t)N * K * 2; G = G_; c = c_; tstart = ts; ntot = ts[16]; }
    __device__ bool next(int i, Unit& u) const {
        const long L = (long)i * G + c; if (L >= 4L * ntot) return false;
        const int mt = (int)(L >> 2); u.pm = mt; u.pn = (int)(L & 3);
        int e = 0;
#pragma unroll
        for (int j = 1; j < 16; ++j) e += (mt >= tstart[j]) ? 1 : 0;
        u.e = e; return true;
    }
    __device__ __forceinline__ const char* a_base(const Unit& u) const { return A + (size_t)u.pm * tstep; }
    __device__ __forceinline__ const char* b_base(const Unit& u) const { return Bt + (size_t)u.e * estep + (size_t)u.pn * tstep; }
};

__device__ __forceinline__ unsigned cvt_pk_bf16(float lo, float hi) { unsigned r; asm volatile("v_cvt_pk_bf16_f32 %0, %1, %2" : "=v"(r) : "v"(lo), "v"(hi)); return r; }


struct EpiIn {
    bf16* P; const float* cs; float* ksum;
    __device__ __forceinline__ void operator()(const f32x4 (&acc)[2][2][4][2], const Unit& u, int wr, int wc, int fr, int fq) const {
        const int pn = u.pn, row0 = u.pm * BM + wr * 64 + fr, col0 = pn * BM + wc * 32 + 8 * fq;
        if (pn < 4) {
            const int dbase = 16 * (wc & 1) + 4 * fq;
            const float qs = (pn < 2) ? 0.125f : 1.0f;
            const bool isk = (pn >= 2);
            float ks[2][8];
#pragma unroll
            for (int b = 0; b < 2; ++b)
#pragma unroll
                for (int j = 0; j < 8; ++j) ks[b][j] = 0.f;
#pragma unroll
            for (int ai = 0; ai < 2; ++ai)
#pragma unroll
                for (int m = 0; m < 4; ++m) {
                    const int r = row0 + ai * HALF + m * 16;
                    const f32x4* cp = (const f32x4*)(cs + ((size_t)r * 32 + dbase) * 2);
                    const f32x4 cA = cp[0], cB = cp[1];
                    const float cc[4] = {cA[0], cA[2], cB[0], cB[2]}, ss[4] = {cA[1], cA[3], cB[1], cB[3]};
                    bf16* rowp = P + (size_t)r * NIN + col0;
#pragma unroll
                    for (int bj = 0; bj < 2; ++bj) {
                        const f32x4 x1 = acc[ai][bj][m][0], x2 = acc[ai][bj][m][1];
                        float o1[4], o2[4];
#pragma unroll
                        for (int j = 0; j < 4; ++j) { o1[j] = x1[j] * cc[j] - x2[j] * ss[j]; o2[j] = x2[j] * cc[j] + x1[j] * ss[j]; }
                        if (isk) {
#pragma unroll
                            for (int j = 0; j < 4; ++j) { ks[bj][j] += o1[j]; ks[bj][4 + j] += o2[j]; }
                        }
                        u32x4 w; w.x = cvt_pk_bf16(o1[0] * qs, o1[1] * qs); w.y = cvt_pk_bf16(o1[2] * qs, o1[3] * qs); w.z = cvt_pk_bf16(o2[0] * qs, o2[1] * qs); w.w = cvt_pk_bf16(o2[2] * qs, o2[3] * qs);
                        *(u32x4*)(rowp + bj * HALF) = w;
                    }
                }
            if (isk) {
#pragma unroll
                for (int b = 0; b < 2; ++b)
#pragma unroll
                    for (int j = 0; j < 8; ++j) {
                        float v = ks[b][j];
                        v += __shfl_xor(v, 1); v += __shfl_xor(v, 2); v += __shfl_xor(v, 4); v += __shfl_xor(v, 8);
                        ks[b][j] = v;
                    }
                if (fr == 0) {
#pragma unroll
                    for (int b = 0; b < 2; ++b) {
                        const int head = (pn - 2) * 4 + 2 * b + (wc >> 1);
                        float* kp = ksum + ((size_t)head * NBLK + u.pm) * HD + 32 * (wc & 1) + 8 * fq;
#pragma unroll
                        for (int j = 0; j < 8; ++j) atomicAdd(kp + j, ks[b][j]);
                    }
                }
            }
        } else {
            const bool act = (pn == 6 || pn == 7);
#pragma unroll
            for (int ai = 0; ai < 2; ++ai)
#pragma unroll
                for (int m = 0; m < 4; ++m) {
                    bf16* rowp = P + (size_t)(row0 + ai * HALF + m * 16) * NIN + col0;
#pragma unroll
                    for (int bj = 0; bj < 2; ++bj) {
                        f32x4 v0 = acc[ai][bj][m][0], v1 = acc[ai][bj][m][1];
                        if (act) {
#pragma unroll
                            for (int j = 0; j < 4; ++j) { v0[j] = gelu_tanh(v0[j]); v1[j] = gelu_tanh(v1[j]); }
                        }
                        u32x4 w; w.x = cvt_pk_bf16(v0[0], v0[1]); w.y = cvt_pk_bf16(v0[2], v0[3]); w.z = cvt_pk_bf16(v1[0], v1[1]); w.w = cvt_pk_bf16(v1[2], v1[3]);
                        *(u32x4*)(rowp + bj * HALF) = w;
                    }
                }
        }
    }
};
struct EpiOut {
    float* H; float* HO;
    __device__ __forceinline__ void operator()(const f32x4 (&acc)[2][2][4][2], const Unit& u, int wr, int wc, int fr, int fq) const {
        const int row0 = u.pm * BM + wr * 64 + fr, col0 = u.pn * BM + wc * 32 + 4 * fq;
#pragma unroll
        for (int ai = 0; ai < 2; ++ai)
#pragma unroll
            for (int m = 0; m < 4; ++m) {
                float* rowp = H + (size_t)(row0 + ai * HALF + m * 16) * D + col0;
#pragma unroll
                for (int bj = 0; bj < 2; ++bj)
#pragma unroll
                    for (int n = 0; n < 2; ++n) { f32x4* p = (f32x4*)(rowp + bj * HALF + n * 16); const f32x4 hv = *p; *(f32x4*)((float*)p + (HO - H)) = hv * ALPHA + acc[ai][bj][m][n]; }
            }
    }
};
struct EpiGU {
    bf16* ACT;
    __device__ __forceinline__ void operator()(const f32x4 (&acc)[2][2][4][2], const Unit& u, int wr, int wc, int fr, int fq) const {
        const int row0 = u.pm * BM + wr * 64 + fr, col0 = u.pn * 128 + wc * 16 + 4 * fq;
#pragma unroll
        for (int ai = 0; ai < 2; ++ai)
#pragma unroll
            for (int m = 0; m < 4; ++m) {
                bf16* rowp = ACT + (size_t)(row0 + ai * HALF + m * 16) * DE + col0;
#pragma unroll
                for (int bj = 0; bj < 2; ++bj) {
                    const f32x4 g = acc[ai][bj][m][0], up = acc[ai][bj][m][1];
                    float a[4];
#pragma unroll
                    for (int j = 0; j < 4; ++j) a[j] = g[j] * sigmoidf_(g[j]) * up[j];
                    u32x2 w; w.x = cvt_pk_bf16(a[0], a[1]); w.y = cvt_pk_bf16(a[2], a[3]);
                    *(u32x2*)(rowp + bj * 64) = w;
                }
            }
    }
};
struct EpiDown {
    bf16* Y; const int2* rowinfo;
    __device__ __forceinline__ void operator()(const f32x4 (&acc)[2][2][4][2], const Unit& u, int wr, int wc, int fr, int fq) const {
        const int row0 = u.pm * BM + wr * 64 + fr, col0 = u.pn * BM + wc * 32 + 8 * fq;
#pragma unroll
        for (int ai = 0; ai < 2; ++ai)
#pragma unroll
            for (int m = 0; m < 4; ++m) {
                const int2 ri = rowinfo[row0 + ai * HALF + m * 16];
                if (ri.x >= 0) {
                    const float gw = __builtin_bit_cast(float, ri.y);
                    bf16* rowp = Y + (size_t)ri.x * D + col0;
#pragma unroll
                    for (int bj = 0; bj < 2; ++bj) {
                        const f32x4 v0 = acc[ai][bj][m][0] * gw, v1 = acc[ai][bj][m][1] * gw;
                        u32x4 w; w.x = cvt_pk_bf16(v0[0], v0[1]); w.y = cvt_pk_bf16(v0[2], v0[3]); w.z = cvt_pk_bf16(v1[0], v1[1]); w.w = cvt_pk_bf16(v1[2], v1[3]);
                        *(u32x4*)(rowp + bj * HALF) = w;
                    }
                }
            }
    }
};

template <class Epi, class Sched, bool ALIGN_EPI, bool SP2>
__device__ __forceinline__ void gemm_phase(LAS unsigned char* lds, const int K, const Sched& S, const Epi& E, const int wave_id) {
    int wid = wave_id; asm volatile("" : "+s"(wid));
    int lane = (int)__builtin_amdgcn_mbcnt_hi(~0u, __builtin_amdgcn_mbcnt_lo(~0u, 0u)); asm volatile("" : "+v"(lane));
    const int tid = wid * 64 + lane, wr = wid >> 2, wc = wid & 3, fr = lane & 15, fq = lane >> 4;
    const int nt = K / BK;
    unsigned voffA[2], voffB[2];
#pragma unroll
    for (int i = 0; i < 2; ++i) { int R, C; stage_rc(tid * 16 + i * 8192, R, C); voffA[i] = (unsigned)(R * K + C) * 2u; voffB[i] = voffA[i]; }
    const size_t kstep = (size_t)(BK * 2);
    const size_t hstep = (size_t)HALF * K * 2;
    const unsigned ldsw = (unsigned)wid * 1024u;
    const int aoff = lds_byte(wr * 64 + fr, fq * 8), boff = lds_byte(wc * 32 + fr, fq * 8);
#define PG8_SA(b, h) (((b) * 2 + (h)) * HTB)
#define PG8_SB(b, h) ((4 + (b) * 2 + (h)) * HTB)
#define PG8_STAGE(bufoff, gbase, voff) do { _Pragma("unroll") for (int _i = 0; _i < 2; ++_i) \
        __builtin_amdgcn_global_load_lds((const unsigned*)((const char*)(gbase) + (voff)[_i]), (LAS unsigned*)(lds + (bufoff) + ldsw + _i * 8192), 16, 0, 0); } while (0)
#define PG8_LDA(dst, b, h) do { _Pragma("unroll") for (int m = 0; m < 4; ++m) _Pragma("unroll") for (int k = 0; k < 2; ++k) dst[m][k] = *(const LAS bf16x8*)(lds + PG8_SA(b, h) + aoff + m * 2048 + k * 1024); } while (0)
#define PG8_LDB(dst, b, h) do { _Pragma("unroll") for (int n = 0; n < 2; ++n) _Pragma("unroll") for (int k = 0; k < 2; ++k) dst[n][k] = *(const LAS bf16x8*)(lds + PG8_SB(b, h) + boff + n * 2048 + k * 1024); } while (0)
#define PG8_MMA(ai, bj, At, Bt) do { __builtin_amdgcn_s_setprio(1); _Pragma("unroll") for (int m = 0; m < 4; ++m) _Pragma("unroll") for (int n = 0; n < 2; ++n) _Pragma("unroll") for (int k = 0; k < 2; ++k) \
        acc[ai][bj][m][n] = __builtin_amdgcn_mfma_f32_16x16x32_bf16(Bt[n][k], At[m][k], acc[ai][bj][m][n], 0, 0, 0); __builtin_amdgcn_s_setprio(0); } while (0)
#define PG8_WAIT_V(n) asm volatile("s_waitcnt vmcnt(" #n ")" ::: "memory")
#define PG8_WAIT_L(n) asm volatile("s_waitcnt lgkmcnt(" #n ")" ::: "memory")
#define PG8_BAR __builtin_amdgcn_s_barrier()
#define PG8_SCHED __builtin_amdgcn_sched_barrier(0)
    Unit cur, nxt; int ui = 0;
    if (!S.next(0, cur)) return;
    f32x4 acc[2][2][4][2];
#pragma unroll
    for (int a = 0; a < 2; ++a)
#pragma unroll
        for (int b = 0; b < 2; ++b)
#pragma unroll
            for (int m = 0; m < 4; ++m)
#pragma unroll
                for (int n = 0; n < 2; ++n) acc[a][b][m][n] = (f32x4){0.f, 0.f, 0.f, 0.f};
    bf16x8 At[4][2], B0[2][2], B1[2][2];
    const char* cA = S.a_base(cur); const char* cB = S.b_base(cur);
    if constexpr (SP2) {
        PG8_STAGE(PG8_SB(0, 0), cB, voffB); PG8_STAGE(PG8_SB(0, 1), cB + hstep, voffB); PG8_STAGE(PG8_SA(0, 0), cA, voffA); PG8_STAGE(PG8_SA(0, 1), cA + hstep, voffA);
        if (wr == 1) PG8_BAR;
        PG8_WAIT_V(2); PG8_BAR;
        PG8_STAGE(PG8_SB(1, 0), cB + kstep, voffB); PG8_STAGE(PG8_SA(1, 0), cA + kstep, voffA); PG8_STAGE(PG8_SB(1, 1), cB + hstep + kstep, voffB);
        PG8_WAIT_V(6); PG8_BAR;
    } else {
        PG8_STAGE(PG8_SB(0, 0), cB, voffB); PG8_STAGE(PG8_SA(0, 0), cA, voffA); PG8_STAGE(PG8_SB(0, 1), cB + hstep, voffB); PG8_STAGE(PG8_SA(0, 1), cA + hstep, voffA);
        if (wr == 1) PG8_BAR;
        PG8_WAIT_V(4); PG8_BAR;
        PG8_STAGE(PG8_SB(1, 0), cB + kstep, voffB); PG8_STAGE(PG8_SA(1, 0), cA + kstep, voffA); PG8_STAGE(PG8_SB(1, 1), cB + hstep + kstep, voffB);
        PG8_WAIT_V(6); PG8_BAR;
    }
    for (;;) {
        const bool has_next = S.next(ui + 1, nxt);
        const char* nA = has_next ? S.a_base(nxt) : cA; const char* nB = has_next ? S.b_base(nxt) : cB;
        for (int t = 0; t < nt; t += 2) {
            const bool last = (t == nt - 2);
            const char* a1 = cA + (size_t)(t + 1) * kstep;
            const char* a2 = last ? nA : cA + (size_t)(t + 2) * kstep; const char* b2 = last ? nB : cB + (size_t)(t + 2) * kstep;
            const char* a3 = a2 + kstep; const char* b3 = b2 + kstep;
            if constexpr (SP2) {
            PG8_LDB(B0, 0, 0); PG8_LDB(B1, 0, 1); PG8_SCHED; PG8_LDA(At, 0, 0); PG8_STAGE(PG8_SA(1, 1), a1 + hstep, voffA);
            PG8_WAIT_V(8); PG8_WAIT_L(0); PG8_BAR; PG8_MMA(0, 0, At, B0); PG8_MMA(0, 1, At, B1); PG8_BAR; PG8_SCHED;
            PG8_LDA(At, 0, 1); PG8_STAGE(PG8_SB(0, 0), b2, voffB); PG8_STAGE(PG8_SB(0, 1), b2 + hstep, voffB); PG8_STAGE(PG8_SA(0, 0), a2, voffA);
            PG8_WAIT_V(8); PG8_WAIT_L(0); PG8_BAR; PG8_MMA(1, 0, At, B0); PG8_MMA(1, 1, At, B1); PG8_BAR; PG8_SCHED;
            PG8_LDB(B0, 1, 0); PG8_LDB(B1, 1, 1); PG8_SCHED; PG8_LDA(At, 1, 0); PG8_STAGE(PG8_SA(0, 1), a2 + hstep, voffA);
            PG8_WAIT_V(8); PG8_WAIT_L(0); PG8_BAR; PG8_MMA(0, 0, At, B0); PG8_MMA(0, 1, At, B1); PG8_BAR; PG8_SCHED;
            PG8_LDA(At, 1, 1); PG8_STAGE(PG8_SB(1, 0), b3, voffB); PG8_STAGE(PG8_SB(1, 1), b3 + hstep, voffB); PG8_STAGE(PG8_SA(1, 0), a3, voffA);
            PG8_WAIT_V(8); PG8_WAIT_L(0); PG8_BAR; PG8_MMA(1, 0, At, B0); PG8_MMA(1, 1, At, B1); PG8_BAR; PG8_SCHED;
            } else {
            PG8_LDB(B0, 0, 0); PG8_SCHED; PG8_LDA(At, 0, 0); PG8_STAGE(PG8_SA(1, 1), a1 + hstep, voffA);
            PG8_WAIT_L(8); PG8_BAR; PG8_WAIT_L(0); PG8_MMA(0, 0, At, B0); PG8_BAR; PG8_SCHED;
            PG8_LDB(B1, 0, 1); PG8_STAGE(PG8_SB(0, 0), b2, voffB);
            PG8_BAR; PG8_WAIT_L(0); PG8_MMA(0, 1, At, B1); PG8_BAR;
            PG8_LDA(At, 0, 1); PG8_STAGE(PG8_SA(0, 0), a2, voffA);
            PG8_BAR; PG8_WAIT_L(0); PG8_MMA(1, 0, At, B0); PG8_BAR; PG8_SCHED;
            PG8_STAGE(PG8_SB(0, 1), b2 + hstep, voffB);
            PG8_WAIT_V(6); PG8_BAR; PG8_MMA(1, 1, At, B1); PG8_BAR;
            PG8_LDB(B0, 1, 0); PG8_SCHED; PG8_LDA(At, 1, 0); PG8_STAGE(PG8_SA(0, 1), a2 + hstep, voffA);
            PG8_WAIT_L(8); PG8_BAR; PG8_WAIT_L(0); PG8_MMA(0, 0, At, B0); PG8_BAR; PG8_SCHED;
            PG8_LDB(B1, 1, 1); PG8_STAGE(PG8_SB(1, 0), b3, voffB);
            PG8_BAR; PG8_WAIT_L(0); PG8_MMA(0, 1, At, B1); PG8_BAR;
            PG8_LDA(At, 1, 1); PG8_STAGE(PG8_SA(1, 0), a3, voffA);
            PG8_BAR; PG8_WAIT_L(0); PG8_MMA(1, 0, At, B0); PG8_BAR; PG8_SCHED;
            PG8_STAGE(PG8_SB(1, 1), b3 + hstep, voffB);
            PG8_WAIT_V(6); PG8_BAR; PG8_MMA(1, 1, At, B1); PG8_BAR;
            }
        }
        if constexpr (ALIGN_EPI) { if (wr == 0) PG8_BAR; }
        E(acc, cur, wr, wc, fr, fq);
        if (!has_next) break;
#pragma unroll
        for (int a = 0; a < 2; ++a)
#pragma unroll
            for (int b = 0; b < 2; ++b)
#pragma unroll
                for (int m = 0; m < 4; ++m)
#pragma unroll
                    for (int n = 0; n < 2; ++n) acc[a][b][m][n] = (f32x4){0.f, 0.f, 0.f, 0.f};
        cur = nxt; cA = nA; cB = nB; ++ui;
        if constexpr (ALIGN_EPI) { if (wr == 1) PG8_BAR; }
    }
    PG8_WAIT_V(0);
    if constexpr (!ALIGN_EPI) { if (wr == 0) PG8_BAR; }
    PG8_BAR;
#undef PG8_SA
#undef PG8_SB
#undef PG8_STAGE
#undef PG8_LDA
#undef PG8_LDB
#undef PG8_MMA
#undef PG8_WAIT_V
#undef PG8_WAIT_L
#undef PG8_BAR
#undef PG8_SCHED
}
}

#define XB_TMO      128
#define XB_XCNT(j)  (256  + 64 * (j))
#define XB_XSUB(j)  (1280 + 64 * (j))
#define XB_XGEN(j)  (2304 + 64 * (j))
#define XB_TOP      3328
#define XB_TOPGEN   3392
#define XCD_BAR_WORDS 3456
#define XB_SPIN_CAP (1u << 18)
__device__ __forceinline__ unsigned xb_ld(unsigned* p)              { return __hip_atomic_load(p, __ATOMIC_RELAXED, __HIP_MEMORY_SCOPE_AGENT); }
__device__ __forceinline__ unsigned xb_add(unsigned* p, unsigned v) { return __hip_atomic_fetch_add(p, v, __ATOMIC_RELAXED, __HIP_MEMORY_SCOPE_AGENT); }
__device__ __forceinline__ unsigned xb_xcc_id() { return (unsigned)__builtin_amdgcn_s_getreg((3 << 11) | 20) & 0xFu; }
#define XB_SPIN(cond, bar) do { unsigned _sp = 0; while (cond) { __builtin_amdgcn_s_sleep(1); \
    if ((++_sp & 255u) == 0u) { if (xb_ld(&(bar)[XB_TMO])) break; if (_sp > XB_SPIN_CAP) { atomicAdd(&(bar)[XB_TMO], 1u); break; } } } } while (0)
struct XcdBarrier { unsigned* bar; unsigned x; volatile LAS unsigned* st; };
__device__ __forceinline__ XcdBarrier xcd_barrier_post(unsigned* bar, volatile LAS unsigned* st) {
    XcdBarrier b; b.bar = bar; b.x = xb_xcc_id(); b.st = st;
    if (threadIdx.x == 0) (void)xb_add(&bar[XB_XCNT(b.x)], 1u);
    return b;
}
__device__ __forceinline__ void xcd_barrier_complete(unsigned* bar, unsigned x, unsigned& nloc, unsigned& nx) {
    const unsigned G = gridDim.x * gridDim.y * gridDim.z;
    unsigned sum, cnt, mine, sp = 0u;
    for (;;) {
        sum = 0u; cnt = 0u; mine = 0u;
#pragma unroll
        for (unsigned j = 0; j < 16; ++j) { const unsigned c = xb_ld(&bar[XB_XCNT(j)]); sum += c; cnt += (c > 0u) ? 1u : 0u; mine = (j == x) ? c : mine; }
        if (sum == G) break;
        __builtin_amdgcn_s_sleep(1);
        if ((++sp & 255u) == 0u) { if (xb_ld(&bar[XB_TMO])) break; if (sp > XB_SPIN_CAP) { atomicAdd(&bar[XB_TMO], 1u); break; } }
    }
    nloc = mine > 0u ? mine : 1u; nx = cnt > 0u ? cnt : 1u;
}
template <bool FIRST>
__device__ __forceinline__ void xcd_barrier_t(const XcdBarrier& b) {
    asm volatile("s_waitcnt vmcnt(0)" ::: "memory");
    __syncthreads();
    if (threadIdx.x == 0) {
        unsigned* bar = b.bar; unsigned bx = b.x;
        asm volatile("" : "+s"(bar), "+s"(bx));
        __builtin_amdgcn_s_waitcnt(0);
        unsigned nloc = b.st[0], nx = b.st[1];
        if (FIRST) { xcd_barrier_complete(bar, bx, nloc, nx); b.st[0] = nloc; b.st[1] = nx; }
        const unsigned old = xb_add(&bar[XB_XSUB(bx)], 1u);
        const unsigned gen = old / nloc;
        if (old + 1u == (gen + 1u) * nloc) {
            __builtin_amdgcn_fence(__ATOMIC_RELEASE, "agent");
            asm volatile("s_waitcnt vmcnt(0)" ::: "memory");
            const unsigned og = xb_add(&bar[XB_TOP], 1u);
            const unsigned tg = og / nx;
            if (og + 1u == (tg + 1u) * nx) xb_add(&bar[XB_TOPGEN], 1u);
            else XB_SPIN(xb_ld(&bar[XB_TOPGEN]) == tg, bar);
            __builtin_amdgcn_fence(__ATOMIC_ACQUIRE, "agent");
            xb_add(&bar[XB_XGEN(bx)], 1u);
            asm volatile("s_waitcnt vmcnt(0)" ::: "memory");
        } else {
            XB_SPIN(xb_ld(&bar[XB_XGEN(bx)]) == gen, bar);
            __builtin_amdgcn_fence(__ATOMIC_ACQUIRE, "agent");
            asm volatile("s_waitcnt vmcnt(0)" ::: "memory");
        }
    }
    __syncthreads();
}

struct Args {
    const float* x; const float* ln_in_g; const float* ln_in_b; const float* w_in; const float* w_out; const float* sg_ln_g; const float* sg_ln_b; const float* sg_w; const float* sg_b;
    const float* conv_w; const float* conv_b; const float* conv_ln_g; const float* conv_ln_b; const float* ln_mix_g; const float* ln_mix_b; const float* w_router; const float* router_bias;
    const float* w_gate; const float* w_up; const float* w_down; const float* ln_ffn_g; const float* ln_ffn_b;
    float* out; unsigned char* ws;
    int mode, pad;
};
struct Ctx { LAS unsigned char* lds; int tid, lane, wave, vcu, G; };
constexpr int ARGS_OFF = MISC_OFF + 512;
__device__ __forceinline__ LAS unsigned char* lds_opaque(LAS unsigned char* p) { asm volatile("" : "+s"(p)); return p; }
template <class T> __device__ __forceinline__ T lds_arg(const Ctx& C, int byteoff) {
    volatile LAS unsigned* p = (volatile LAS unsigned*)(lds_opaque(C.lds) + ARGS_OFF + byteoff);
    const unsigned lo = __builtin_amdgcn_readfirstlane(p[0]), hi = __builtin_amdgcn_readfirstlane(p[1]);
    return (T)(GAS void*)(((unsigned long long)hi << 32) | lo);
}
#define ARG(field) lds_arg<decltype(Args::field)>(C, (int)__builtin_offsetof(Args, field))
#define LOADARG(a, field) (a).field = ARG(field)

template <class RowMap>
__device__ __forceinline__ void transpose_item(const float* W, int K, int N, bf16* WT, LAS float* scr, int item, int lane, const RowMap& rowmap) {
    const int nblk = N / 64, kb = item / nblk, nb = item % nblk, k0 = 64 * kb, n0 = 64 * nb;
    const int lr = lane >> 4, lc = (lane & 15) * 4;
    f32x4 v[16];
#pragma unroll
    for (int i = 0; i < 16; ++i) v[i] = *(const f32x4*)(W + (size_t)(k0 + 4 * i + lr) * N + n0 + lc);
#pragma unroll
    for (int i = 0; i < 16; ++i) { const int kk = 4 * i + lr; *(LAS f32x4*)(scr + kk * 64 + (lc ^ (8 * ((kk >> 3) & 3)))) = v[i]; }
    LDS_WAIT(); asm volatile("" ::: "memory");
    const int c = lane & 7, sw = 8 * (c & 3);
#pragma unroll
    for (int j = 0; j < 8; ++j) { const int n = (lane >> 3) + 8 * j; const LAS float* sp = scr + (8 * c) * 64 + (n ^ sw);
        u32x4 o; o.x = pk2(sp[0], sp[64]); o.y = pk2(sp[128], sp[192]); o.z = pk2(sp[256], sp[320]); o.w = pk2(sp[384], sp[448]);
        *(GAS u32x4*)(WT + (size_t)rowmap(n0 + n) * K + k0 + 8 * c) = o; }
    LDS_WAIT(); asm volatile("" ::: "memory");
}
struct MapIn { __device__ __forceinline__ int operator()(int n) const {
    if (n < 1024) return (n & ~48) | ((n & 16) << 1) | ((n & 32) >> 1);
    return (n & ~31) | ((n & 4) << 2) | ((n & 24) >> 1) | (n & 3); } };
struct MapId { __device__ __forceinline__ int operator()(int n) const { return n; } };
struct MapPerm { __device__ __forceinline__ int operator()(int n) const { return (n & ~31) | ((n & 4) << 2) | ((n & 24) >> 1) | (n & 3); } };
struct MapGU { int which; __device__ __forceinline__ int operator()(int c) const {
    return ((c >> 7) << 8) | (((c >> 6) & 1) << 7) | (((c >> 4) & 3) << 5) | (which << 4) | (c & 15); } };

__device__ __forceinline__ void ln_row(f32x4 (&v)[4], const float* g, const float* b, int lane, float eps) {
    float s = 0.f;
#pragma unroll
    for (int j = 0; j < 4; ++j) s += (v[j][0] + v[j][1]) + (v[j][2] + v[j][3]);
    const float mean = wave_sum(s) * (1.f / D); float s2 = 0.f;
#pragma unroll
    for (int j = 0; j < 4; ++j) { v[j] = v[j] - mean; s2 += (v[j][0] * v[j][0] + v[j][1] * v[j][1]) + (v[j][2] * v[j][2] + v[j][3] * v[j][3]); }
    const float rstd = 1.f / sqrtf(wave_sum(s2) * (1.f / D) + eps);
#pragma unroll
    for (int j = 0; j < 4; ++j) { const f32x4 gg = *(const f32x4*)(g + 4 * lane + 256 * j), bb = *(const f32x4*)(b + 4 * lane + 256 * j); v[j] = v[j] * rstd * gg + bb; }
}
__device__ __forceinline__ void store_row(const f32x4 (&v)[4], float* orow, bf16* brow, int lane) {
#pragma unroll
    for (int j = 0; j < 4; ++j) {
        *(f32x4*)(orow + 4 * lane + 256 * j) = v[j];
        u32x2 w; w.x = pk2(v[j][0], v[j][1]); w.y = pk2(v[j][2], v[j][3]);
        *(u32x2*)(brow + 4 * lane + 256 * j) = w;
    }
}

__device__ __forceinline__ void p0_prologue(const Ctx& C0) {
    Ctx C = C0; asm volatile("" : "+s"(C.wave), "+s"(C.vcu), "+s"(C.G), "+s"(C.lds)); C.lane = (int)__builtin_amdgcn_mbcnt_hi(~0u, __builtin_amdgcn_mbcnt_lo(~0u, 0u)); asm volatile("" : "+v"(C.lane)); C.tid = C.wave * 64 + C.lane;
    Args a; LOADARG(a, ws); LOADARG(a, w_in); LOADARG(a, w_out); LOADARG(a, sg_w); LOADARG(a, x); LOADARG(a, ln_in_g); LOADARG(a, ln_in_b); LOADARG(a, out);
    LAS float* scr = (LAS float*)(C.lds + C.wave * 16384);
    const int gw = C.vcu * NWAVES + C.wave, NGW = C.G * NWAVES;
    unsigned char* ws = a.ws;
    constexpr int I_IN = (D / 64) * (NIN / 64), I_OUT = (D / 64) * (D / 64);
    for (int it = gw; it < DEPTH * (I_IN + I_OUT); it += NGW) {
        const int l = it / (I_IN + I_OUT); int r = it % (I_IN + I_OUT);
        if (r < I_IN) transpose_item(a.w_in + (size_t)l * D * NIN, D, NIN, (bf16*)(ws + WS_WIN) + (size_t)l * NIN * D, scr, r, C.lane, MapIn{});
        else transpose_item(a.w_out + (size_t)l * D * D, D, D, (bf16*)(ws + WS_WOUT) + (size_t)l * D * D, scr, r - I_IN, C.lane, MapId{});
    }
    const int gt = C.vcu * (NWAVES * 64) + C.tid, NGT = C.G * NWAVES * 64;
    float2* cs = (float2*)(ws + WS_CS);
    for (int i = gt; i < S * 32; i += NGT) {
        const int s = i >> 5, f = i & 31;
        const float inv = powf(10000.0f, -(float)f / 32.0f);
        const float ang = (float)s * inv;
        cs[i] = make_float2(cosf(ang), sinf(ang));
    }
    bf16* wsg = (bf16*)(ws + WS_WSG);
    for (int i = gt; i < DEPTH * 4 * 128 * 128; i += NGT) { const int t = (i >> 7) & 127, s = i & 127; wsg[i] = (bf16)((s <= t) ? f2bf(a.sg_w[i]) : 0u); }
    bf16* hb = (bf16*)(ws + WS_HB);
    for (int m = gw; m < S; m += NGW) {
        f32x4 v[4];
#pragma unroll
        for (int j = 0; j < 4; ++j) v[j] = *(const f32x4*)(a.x + (size_t)m * D + 4 * C.lane + 256 * j);
        ln_row(v, a.ln_in_g, a.ln_in_b, C.lane, LN_EPS);
        store_row(v, a.out + (size_t)m * D, hb + (size_t)m * D, C.lane);
    }
}

__device__ __forceinline__ unsigned k_off(int row, int ch) { return (unsigned)(row * 128 + 16 * (ch ^ (row & 7))); }
__device__ __forceinline__ unsigned v_off(int row, int ch) { return (unsigned)(row * 128 + 16 * (ch ^ (((row >> 1) & 3) << 1))); }

template <int KS>
__device__ __forceinline__ void tr8(u32x2 (&r)[8], const unsigned (&va)[4]) {
    asm volatile(
        "ds_read_b64_tr_b16 %0, %8 offset:%12\n\t"
        "ds_read_b64_tr_b16 %1, %9 offset:%12\n\t"
        "ds_read_b64_tr_b16 %2, %10 offset:%12\n\t"
        "ds_read_b64_tr_b16 %3, %11 offset:%12\n\t"
        "ds_read_b64_tr_b16 %4, %8 offset:%13\n\t"
        "ds_read_b64_tr_b16 %5, %9 offset:%13\n\t"
        "ds_read_b64_tr_b16 %6, %10 offset:%13\n\t"
        "ds_read_b64_tr_b16 %7, %11 offset:%13\n\t"
        "s_waitcnt lgkmcnt(0)"
        : "=&v"(r[0]), "=&v"(r[1]), "=&v"(r[2]), "=&v"(r[3]), "=&v"(r[4]), "=&v"(r[5]), "=&v"(r[6]), "=&v"(r[7])
        : "v"(va[0]), "v"(va[1]), "v"(va[2]), "v"(va[3]), "i"(KS * 4096), "i"(KS * 4096 + 2048)
        : "memory");
}

struct AttnOut { f32x4 o[4]; float m, l; };

template <bool MASK>
__device__ __forceinline__ void attn_core(AttnOut& R, LAS unsigned char* Ks, LAS unsigned char* Vs, const bf16x8 (&qf)[2], int nct, int qoff, int lane) {
    const int fr = lane & 15, fq = lane >> 4;
    f32x4 sacc[16];
#pragma unroll
    for (int c = 0; c < 16; ++c) sacc[c] = (f32x4){0.f, 0.f, 0.f, 0.f};
#pragma unroll
    for (int c = 0; c < 16; ++c) {
        if (c < nct) {
#pragma unroll
            for (int ks = 0; ks < 2; ++ks) {
                const bf16x8 kf = *(const LAS bf16x8*)(Ks + k_off(16 * c + fr, 4 * ks + fq));
                sacc[c] = __builtin_amdgcn_mfma_f32_16x16x32_bf16(kf, qf[ks], sacc[c], 0, 0, 0);
            }
        }
    }
    float mx = -1e30f;
#pragma unroll
    for (int c = 0; c < 16; ++c) {
        if (c < nct) {
#pragma unroll
            for (int j = 0; j < 4; ++j) {
                if (MASK) { if (16 * c + 4 * fq + j > qoff) sacc[c][j] = -1e30f; }
                mx = fmaxf(mx, sacc[c][j]);
            }
        }
    }
    mx = fmaxf(mx, __shfl_xor(mx, 16)); mx = fmaxf(mx, __shfl_xor(mx, 32));
    float lsum = 0.f;
    const float mb = mx * LOG2E;
#pragma unroll
    for (int c = 0; c < 16; ++c) {
        if (c < nct) {
#pragma unroll
            for (int j = 0; j < 4; ++j) { const float p = fast_exp2(sacc[c][j] * LOG2E - mb); sacc[c][j] = p; lsum += p; }
        }
    }
    lsum += __shfl_xor(lsum, 16); lsum += __shfl_xor(lsum, 32);
    const int q4 = (lane & 15) >> 2, p4 = lane & 3;
    unsigned va[4];
    {
        const int row = 4 * fq + q4;
        const unsigned vbase = (unsigned)(size_t)Vs;
#pragma unroll
        for (int c = 0; c < 4; ++c) va[c] = vbase + v_off(row, 2 * c + (p4 >> 1)) + 8 * (p4 & 1);
    }
    f32x4 oacc[4];
#pragma unroll
    for (int c = 0; c < 4; ++c) oacc[c] = (f32x4){0.f, 0.f, 0.f, 0.f};
#define ATT_PV(KS) do { if (2 * (KS) < nct) { u32x2 vr[8]; tr8<KS>(vr, va); __builtin_amdgcn_sched_barrier(0); \
        u32x4 pw; pw.x = pg8::cvt_pk_bf16(sacc[2 * (KS)][0], sacc[2 * (KS)][1]); pw.y = pg8::cvt_pk_bf16(sacc[2 * (KS)][2], sacc[2 * (KS)][3]); \
        pw.z = pg8::cvt_pk_bf16(sacc[2 * (KS) + 1][0], sacc[2 * (KS) + 1][1]); pw.w = pg8::cvt_pk_bf16(sacc[2 * (KS) + 1][2], sacc[2 * (KS) + 1][3]); \
        const bf16x8 pf = __builtin_bit_cast(bf16x8, pw); \
        _Pragma("unroll") for (int c = 0; c < 4; ++c) { u32x4 vw; vw.x = vr[c].x; vw.y = vr[c].y; vw.z = vr[4 + c].x; vw.w = vr[4 + c].y; \
            oacc[c] = __builtin_amdgcn_mfma_f32_16x16x32_bf16(__builtin_bit_cast(bf16x8, vw), pf, oacc[c], 0, 0, 0); } } } while (0)
    ATT_PV(0); ATT_PV(1); ATT_PV(2); ATT_PV(3); ATT_PV(4); ATT_PV(5); ATT_PV(6); ATT_PV(7);
#undef ATT_PV
#pragma unroll
    for (int c = 0; c < 4; ++c) R.o[c] = oacc[c];
    R.m = mx; R.l = lsum;
}

__device__ __forceinline__ void attn_s2(f32x4 (&sacc)[2][16], LAS unsigned char* Ks, const bf16x8 (&qf)[2][2], int nct, int lane) {
    const int fr = lane & 15, fq = lane >> 4;
#pragma unroll
    for (int g = 0; g < 2; ++g)
#pragma unroll
        for (int c = 0; c < 16; ++c) sacc[g][c] = (f32x4){0.f, 0.f, 0.f, 0.f};
#pragma unroll
    for (int c = 0; c < 16; ++c) {
        if (c < nct) {
#pragma unroll
            for (int ks = 0; ks < 2; ++ks) {
                const bf16x8 kf = *(const LAS bf16x8*)(Ks + k_off(16 * c + fr, 4 * ks + fq));
                sacc[0][c] = __builtin_amdgcn_mfma_f32_16x16x32_bf16(kf, qf[0][ks], sacc[0][c], 0, 0, 0);
                sacc[1][c] = __builtin_amdgcn_mfma_f32_16x16x32_bf16(kf, qf[1][ks], sacc[1][c], 0, 0, 0);
            }
        }
        if ((c & 3) == 3) __builtin_amdgcn_sched_barrier(0);
    }
}
template <bool MASK>
__device__ __forceinline__ void attn_pv2(AttnOut (&R)[2], f32x4 (&sacc)[2][16], LAS unsigned char* Vs, int nct, const int (&dtile)[2], int qin, int lane) {
    const int fq = lane >> 4;
    float mx[2], lsum[2];
#pragma unroll
    for (int g = 0; g < 2; ++g) {
        float m_ = -1e30f;
#pragma unroll
        for (int c = 0; c < 16; ++c) {
            if (c < nct) {
                if (MASK) {
                    int dt_ = dtile[g]; asm volatile("" : "+s"(dt_));
                    if (c == dt_) {
#pragma unroll
                        for (int j = 0; j < 4; ++j) if (4 * fq + j > qin) sacc[g][c][j] = -1e30f;
                    } else if (c > dt_) sacc[g][c] = (f32x4){-1e30f, -1e30f, -1e30f, -1e30f};
                }
#pragma unroll
                for (int j = 0; j < 4; ++j) m_ = fmaxf(m_, sacc[g][c][j]);
            }
        }
        m_ = fmaxf(m_, __shfl_xor(m_, 16)); m_ = fmaxf(m_, __shfl_xor(m_, 32));
        float l_ = 0.f; const float mb = m_ * LOG2E;
#pragma unroll
        for (int c = 0; c < 16; ++c) {
            if (c < nct) {
#pragma unroll
                for (int j = 0; j < 4; ++j) { const float p = fast_exp2(sacc[g][c][j] * LOG2E - mb); sacc[g][c][j] = p; l_ += p; }
            }
        }
        l_ += __shfl_xor(l_, 16); l_ += __shfl_xor(l_, 32);
        mx[g] = m_; lsum[g] = l_;
    }
    const int q4 = (lane & 15) >> 2, p4 = lane & 3;
    unsigned va[4];
    {
        const int row = 4 * fq + q4;
        const unsigned vbase = (unsigned)(size_t)Vs;
#pragma unroll
        for (int c = 0; c < 4; ++c) va[c] = vbase + v_off(row, 2 * c + (p4 >> 1)) + 8 * (p4 & 1);
    }
    f32x4 oacc[2][4];
#pragma unroll
    for (int g = 0; g < 2; ++g)
#pragma unroll
        for (int c = 0; c < 4; ++c) oacc[g][c] = (f32x4){0.f, 0.f, 0.f, 0.f};
#define ATT_PV2(KS) do { if (2 * (KS) < nct) { u32x2 vr[8]; tr8<KS>(vr, va); __builtin_amdgcn_sched_barrier(0); \
        bf16x8 pf[2]; \
        _Pragma("unroll") for (int g = 0; g < 2; ++g) { u32x4 pw; pw.x = pg8::cvt_pk_bf16(sacc[g][2 * (KS)][0], sacc[g][2 * (KS)][1]); pw.y = pg8::cvt_pk_bf16(sacc[g][2 * (KS)][2], sacc[g][2 * (KS)][3]); \
            pw.z = pg8::cvt_pk_bf16(sacc[g][2 * (KS) + 1][0], sacc[g][2 * (KS) + 1][1]); pw.w = pg8::cvt_pk_bf16(sacc[g][2 * (KS) + 1][2], sacc[g][2 * (KS) + 1][3]); pf[g] = __builtin_bit_cast(bf16x8, pw); } \
        _Pragma("unroll") for (int c = 0; c < 4; ++c) { u32x4 vw; vw.x = vr[c].x; vw.y = vr[c].y; vw.z = vr[4 + c].x; vw.w = vr[4 + c].y; const bf16x8 vf = __builtin_bit_cast(bf16x8, vw); \
            oacc[0][c] = __builtin_amdgcn_mfma_f32_16x16x32_bf16(vf, pf[0], oacc[0][c], 0, 0, 0); \
            oacc[1][c] = __builtin_amdgcn_mfma_f32_16x16x32_bf16(vf, pf[1], oacc[1][c], 0, 0, 0); } } } while (0)
    ATT_PV2(0); ATT_PV2(1); ATT_PV2(2); ATT_PV2(3); ATT_PV2(4); ATT_PV2(5); ATT_PV2(6); ATT_PV2(7);
#undef ATT_PV2
#pragma unroll
    for (int g = 0; g < 2; ++g) {
#pragma unroll
        for (int c = 0; c < 4; ++c) R[g].o[c] = oacc[g][c];
        R[g].m = mx[g]; R[g].l = lsum[g];
    }
}

__device__ __forceinline__ void stage_kv(const Ctx& C, const bf16* P, int blk, int h, int nrows, LAS unsigned char* Ks, LAS unsigned char* Vs) {
    for (int i = C.tid; i < nrows * 8; i += NWAVES * 64) {
        const int row = i >> 3, ch = i & 7;
        const bf16* src = P + (size_t)(blk * 256 + row) * NIN + h * HD + ch * 8;
        const u32x4 kv = *(const u32x4*)(src + K_OFF), vv = *(const u32x4*)(src + V_OFF);
        *(LAS u32x4*)(Ks + k_off(row, ch)) = kv;
        *(LAS u32x4*)(Vs + v_off(row, ch)) = vv;
    }
}

__device__ __forceinline__ void pb_gating(const Ctx& C0, int l, int item, bool dry = false) {
    Ctx C = C0; asm volatile("" : "+s"(C.wave), "+s"(C.vcu), "+s"(C.G), "+s"(C.lds)); C.lane = (int)__builtin_amdgcn_mbcnt_hi(~0u, __builtin_amdgcn_mbcnt_lo(~0u, 0u)); asm volatile("" : "+v"(C.lane)); C.tid = C.wave * 64 + C.lane;
    Args a; LOADARG(a, ws);
    const int h = item & 7, grp = item >> 3, tok = grp * 512 + C.tid, own = tok >> 8;
    unsigned char* ws = a.ws;
    const bf16* P = (const bf16*)(ws + WS_P);
    LAS float* km = (LAS float*)C.lds;
    LAS unsigned* cntL = (LAS unsigned*)(C.lds + 16384);
    LAS unsigned* baseL = (LAS unsigned*)(C.lds + 16384 + 256);
    const float* ksum = (const float*)(ws + WS_CTL) + CW_KMEAN + (size_t)l * (NH * NBLK * HD) + (size_t)h * NBLK * HD;
    for (int i = C.tid; i < NBLK * HD; i += NWAVES * 64) km[i] = ksum[i] * (1.0f / 256.0f);
    if (C.tid < 64) cntL[C.tid] = 0u;
    __syncthreads();
    float q[64];
    {
        const u32x4* qp = (const u32x4*)(P + (size_t)tok * NIN + Q_OFF + h * HD);
#pragma unroll
        for (int c = 0; c < 8; ++c) { const u32x4 w = qp[c]; q[8 * c + 0] = bflo(w.x); q[8 * c + 1] = bfhi(w.x); q[8 * c + 2] = bflo(w.y); q[8 * c + 3] = bfhi(w.y); q[8 * c + 4] = bflo(w.z); q[8 * c + 5] = bfhi(w.z); q[8 * c + 6] = bflo(w.w); q[8 * c + 7] = bfhi(w.w); }
    }
    float v0 = -3e38f, v1 = -3e38f, v2 = -3e38f; int i0 = 0, i1 = 0, i2 = 0;
    const int ownu = __builtin_amdgcn_readfirstlane(own);
    for (int n = 0; n < ownu; ++n) {
        const LAS f32x4* kr = (const LAS f32x4*)(km + n * 64);
        float g0 = 0.f, g1 = 0.f, g2 = 0.f, g3 = 0.f;
#pragma unroll
        for (int c = 0; c < 16; ++c) { const f32x4 kv = kr[c]; g0 += q[4 * c] * kv[0]; g1 += q[4 * c + 1] * kv[1]; g2 += q[4 * c + 2] * kv[2]; g3 += q[4 * c + 3] * kv[3]; }
        const float g = (g0 + g1) + (g2 + g3);
        if (g > v0) { v2 = v1; i2 = i1; v1 = v0; i1 = i0; v0 = g; i0 = n; }
        else if (g > v1) { v2 = v1; i2 = i1; v1 = g; i1 = n; }
        else if (g > v2) { v2 = g; i2 = n; }
    }
    if (dry) { asm volatile("" :: "v"(i0), "v"(i1), "v"(i2)); __syncthreads(); return; }
    const int nsel = own < 3 ? own : 3;
    unsigned lp0 = 0, lp1 = 0, lp2 = 0;
    if (nsel > 0) lp0 = __hip_atomic_fetch_add(&cntL[i0], 1u, __ATOMIC_RELAXED, __HIP_MEMORY_SCOPE_WORKGROUP);
    if (nsel > 1) lp1 = __hip_atomic_fetch_add(&cntL[i1], 1u, __ATOMIC_RELAXED, __HIP_MEMORY_SCOPE_WORKGROUP);
    if (nsel > 2) lp2 = __hip_atomic_fetch_add(&cntL[i2], 1u, __ATOMIC_RELAXED, __HIP_MEMORY_SCOPE_WORKGROUP);
    __syncthreads();
    unsigned* acnt = (unsigned*)(ws + WS_CTL) + CW_ACNT + l * 512 + h * 64;
    if (C.tid < 64) { const unsigned c = cntL[C.tid]; baseL[C.tid] = c ? atomicAdd(&acnt[C.tid], c) : 0u; }
    __syncthreads();
    unsigned short* lists = (unsigned short*)(ws + WS_LISTS) + (size_t)h * NBLK * S;
    if (nsel > 0) lists[(size_t)i0 * S + baseL[i0] + lp0] = (unsigned short)(tok | (0 << 14));
    if (nsel > 1) lists[(size_t)i1 * S + baseL[i1] + lp1] = (unsigned short)(tok | (1 << 14));
    if (nsel > 2) lists[(size_t)i2 * S + baseL[i2] + lp2] = (unsigned short)(tok | (2 << 14));
    __syncthreads();
}

__device__ __forceinline__ unsigned sg_off(int row, int ch) { return (unsigned)(row * 512 + 16 * (ch ^ (((row & 3) | (((row >> 3) & 1) << 2)) << 1))); }
template <int KS>
__device__ __forceinline__ void tr2(u32x2& r0, u32x2& r1, unsigned addr) {
    asm volatile("ds_read_b64_tr_b16 %0, %2 offset:%3\n\tds_read_b64_tr_b16 %1, %2 offset:%4\n\ts_waitcnt lgkmcnt(0)"
                 : "=&v"(r0), "=&v"(r1) : "v"(addr), "i"(KS * 32 * 512), "i"(KS * 32 * 512 + 4 * 512) : "memory");
}
__device__ __forceinline__ void pb_sg(const Ctx& C0, int l, int chunk) {
    Ctx C = C0; asm volatile("" : "+s"(C.wave), "+s"(C.vcu), "+s"(C.G), "+s"(C.lds)); C.lane = (int)__builtin_amdgcn_mbcnt_hi(~0u, __builtin_amdgcn_mbcnt_lo(~0u, 0u)); asm volatile("" : "+v"(C.lane)); C.tid = C.wave * 64 + C.lane;
    Args a; LOADARG(a, ws); LOADARG(a, sg_ln_g); LOADARG(a, sg_ln_b); LOADARG(a, sg_b);
    unsigned char* ws = a.ws;
    const bf16* P = (const bf16*)(ws + WS_P);
    bf16* mix = (bf16*)(ws + WS_MIXIN);
    LAS unsigned char* vt = C.lds;
    const float* lg = a.sg_ln_g + l * SGW; const float* lb = a.sg_ln_b + l * SGW;
    for (int s = C.wave; s < 128; s += NWAVES) {
        const int tok = chunk * 128 + s;
        const u32x2 w = *(const u32x2*)(P + (size_t)tok * NIN + SGV_OFF + 4 * C.lane);
        float x[4] = {bflo(w.x), bfhi(w.x), bflo(w.y), bfhi(w.y)};
        const float mean = wave_sum((x[0] + x[1]) + (x[2] + x[3])) * (1.0f / SGW);
        float q = 0.f;
#pragma unroll
        for (int j = 0; j < 4; ++j) { x[j] -= mean; q += x[j] * x[j]; }
        const float rstd = 1.0f / sqrtf(wave_sum(q) * (1.0f / SGW) + LN_EPS);
        const f32x4 gg = *(const f32x4*)(lg + 4 * C.lane), bb = *(const f32x4*)(lb + 4 * C.lane);
        u32x2 o; o.x = pk2(x[0] * rstd * gg[0] + bb[0], x[1] * rstd * gg[1] + bb[1]); o.y = pk2(x[2] * rstd * gg[2] + bb[2], x[3] * rstd * gg[3] + bb[3]);
        *(LAS u32x2*)(vt + sg_off(s, C.lane >> 1) + 8 * (C.lane & 1)) = o;
    }
    __syncthreads();
    const int fr = C.lane & 15, fq = C.lane >> 4, q4 = fr >> 2, p4 = C.lane & 3, w = C.wave;
    const bf16* wsg = (const bf16*)(ws + WS_WSG) + (size_t)l * 4 * 128 * 128;
    const int nks = (16 * w + 15) / 32 + 1;
    f32x4 acc[4][4];
#pragma unroll
    for (int g = 0; g < 4; ++g)
#pragma unroll
        for (int c = 0; c < 4; ++c) acc[g][c] = (f32x4){0.f, 0.f, 0.f, 0.f};
    const unsigned vbase = (unsigned)(size_t)vt;
#define SG_STEP(KS) do { if ((KS) < nks) { _Pragma("unroll") for (int g = 0; g < 4; ++g) { \
        const bf16x8 wf = *(const bf16x8*)(wsg + ((size_t)g * 128 + 16 * w + fr) * 128 + 32 * (KS) + 8 * fq); \
        _Pragma("unroll") for (int c = 0; c < 4; ++c) { const int cc = 4 * g + c; u32x2 r0, r1; \
            tr2<KS>(r0, r1, vbase + sg_off(8 * fq + q4, 2 * cc + (p4 >> 1)) + 8 * (p4 & 1)); __builtin_amdgcn_sched_barrier(0); \
            u32x4 vw; vw.x = r0.x; vw.y = r0.y; vw.z = r1.x; vw.w = r1.y; \
            acc[g][c] = __builtin_amdgcn_mfma_f32_16x16x32_bf16(__builtin_bit_cast(bf16x8, vw), wf, acc[g][c], 0, 0, 0); } } } } while (0)
    SG_STEP(0); SG_STEP(1); SG_STEP(2); SG_STEP(3);
#undef SG_STEP
    const int t = 16 * w + fr, tok = chunk * 128 + t;
#pragma unroll
    for (int g = 0; g < 4; ++g) {
        const float bs = a.sg_b[(l * 4 + g) * 128 + t];
#pragma unroll
        for (int c = 0; c < 4; ++c) {
            const int d = 64 * g + 16 * c + 4 * fq;
            const u32x2 uw = *(const u32x2*)(P + (size_t)tok * NIN + SGU_OFF + d);
            u32x2 o; o.x = pk2(bflo(uw.x) * (acc[g][c][0] + bs), bfhi(uw.x) * (acc[g][c][1] + bs)); o.y = pk2(bflo(uw.y) * (acc[g][c][2] + bs), bfhi(uw.y) * (acc[g][c][3] + bs));
            *(u32x2*)(mix + (size_t)tok * D + 512 + d) = o;
        }
    }
    __syncthreads();
}

__device__ __forceinline__ void pb_conv(const Ctx& C0, int l, int item) {
    Ctx C = C0; asm volatile("" : "+s"(C.wave), "+s"(C.vcu), "+s"(C.G), "+s"(C.lds)); C.lane = (int)__builtin_amdgcn_mbcnt_hi(~0u, __builtin_amdgcn_mbcnt_lo(~0u, 0u)); asm volatile("" : "+v"(C.lane)); C.tid = C.wave * 64 + C.lane;
    Args a; LOADARG(a, ws); LOADARG(a, conv_w); LOADARG(a, conv_b); LOADARG(a, conv_ln_g); LOADARG(a, conv_ln_b);
    unsigned char* ws = a.ws;
    const bf16* P = (const bf16*)(ws + WS_P);
    bf16* mix = (bf16*)(ws + WS_MIXIN);
    LAS float* hb = (LAS float*)C.lds;
    const int t0 = item * 64;
    for (int i = C.tid; i < 94 * 32; i += NWAVES * 64) {
        const int r = i >> 5, ch = i & 31, tok = t0 - 30 + r;
        f32x4 o0 = (f32x4){0.f, 0.f, 0.f, 0.f}, o1 = o0;
        if (tok >= 0) {
            const u32x4 aw = *(const u32x4*)(P + (size_t)tok * NIN + CA_OFF + 8 * ch), gw = *(const u32x4*)(P + (size_t)tok * NIN + CG_OFF + 8 * ch);
            o0[0] = bflo(aw.x) * sigmoidf_(bflo(gw.x)); o0[1] = bfhi(aw.x) * sigmoidf_(bfhi(gw.x)); o0[2] = bflo(aw.y) * sigmoidf_(bflo(gw.y)); o0[3] = bfhi(aw.y) * sigmoidf_(bfhi(gw.y));
            o1[0] = bflo(aw.z) * sigmoidf_(bflo(gw.z)); o1[1] = bfhi(aw.z) * sigmoidf_(bfhi(gw.z)); o1[2] = bflo(aw.w) * sigmoidf_(bflo(gw.w)); o1[3] = bfhi(aw.w) * sigmoidf_(bfhi(gw.w));
        }
        *(LAS f32x4*)(hb + r * 256 + 8 * ch) = o0; *(LAS f32x4*)(hb + r * 256 + 8 * ch + 4) = o1;
    }
    __syncthreads();
    const int c = C.tid & 255, half = C.tid >> 8;
    float wt[TAPS];
#pragma unroll
    for (int j = 0; j < TAPS; ++j) wt[j] = a.conv_w[((size_t)l * TAPS + j) * CVW + c];
    const float bias = a.conv_b[l * CVW + c];
    float outv[32];
#pragma unroll
    for (int gI = 0; gI < 8; ++gI) {
        const int tb = half * 32 + gI * 4;
        float win[34];
#pragma unroll
        for (int j = 0; j < 34; ++j) win[j] = hb[(tb + j) * 256 + c];
#pragma unroll
        for (int o = 0; o < 4; ++o) {
            float s = bias;
#pragma unroll
            for (int j = 0; j < TAPS; ++j) s += wt[j] * win[o + j];
            outv[gI * 4 + o] = s;
        }
    }
    __syncthreads();
#pragma unroll
    for (int i = 0; i < 32; ++i) hb[(half * 32 + i) * 256 + c] = outv[i];
    __syncthreads();
    const float* lg = a.conv_ln_g + l * CVW; const float* lb = a.conv_ln_b + l * CVW;
    for (int s = C.wave; s < 64; s += NWAVES) {
        f32x4 x = *(const LAS f32x4*)(hb + s * 256 + 4 * C.lane);
        const float mean = wave_sum((x[0] + x[1]) + (x[2] + x[3])) * (1.0f / CVW);
        x = x - mean;
        const float rstd = 1.0f / sqrtf(wave_sum((x[0] * x[0] + x[1] * x[1]) + (x[2] * x[2] + x[3] * x[3])) * (1.0f / CVW) + LN_EPS);
        const f32x4 gg = *(const f32x4*)(lg + 4 * C.lane), bb = *(const f32x4*)(lb + 4 * C.lane);
        f32x4 y = x * rstd * gg + bb;
#pragma unroll
        for (int j = 0; j < 4; ++j) y[j] = y[j] * sigmoidf_(y[j]);
        u32x2 o; o.x = pk2(y[0], y[1]); o.y = pk2(y[2], y[3]);
        *(u32x2*)(mix + (size_t)(t0 + s) * D + 768 + 4 * C.lane) = o;
    }
    __syncthreads();
}

__device__ __forceinline__ void pc_selattn(const Ctx& C0, int l) {
    Ctx C = C0; asm volatile("" : "+s"(C.wave), "+s"(C.vcu), "+s"(C.G), "+s"(C.lds)); C.lane = (int)__builtin_amdgcn_mbcnt_hi(~0u, __builtin_amdgcn_mbcnt_lo(~0u, 0u)); asm volatile("" : "+v"(C.lane)); C.tid = C.wave * 64 + C.lane;
    Args a; LOADARG(a, ws);
    unsigned char* ws = a.ws;
    const bf16* P = (const bf16*)(ws + WS_P);
    LAS unsigned char* Ks = C.lds; LAS unsigned char* Vs = C.lds + 32768;
    LAS int* pref = (LAS int*)(C.lds + 65536);
    const unsigned* acnt = (const unsigned*)(ws + WS_CTL) + CW_ACNT + l * 512;
    LAS int* nt_ = (LAS int*)(C.lds + 65536 + 4096);
    nt_[C.tid] = (int)((__hip_atomic_load(acnt + C.tid, RLX_AGENT) + 255u) >> 8);
    __syncthreads();
    if (C.tid == 0) { int s = 0; for (int i = 0; i < 512; ++i) { pref[i] = s; s += nt_[i]; } pref[512] = s; }
    __syncthreads();
    const int total = pref[512];
    bf16* PO = (bf16*)(ws + WS_PARTO); float2* PML = (float2*)(ws + WS_PARTML);
    const unsigned short* lists = (const unsigned short*)(ws + WS_LISTS);
    const int fr = C.lane & 15, fq = C.lane >> 4;
    LAS int* cntl = (LAS int*)(C.lds + 65536 + 8192);
    cntl[C.tid] = (int)__hip_atomic_load(acnt + C.tid, RLX_AGENT);
    __syncthreads();
    int curpair = -1;
    const int per = (total + C.G - 1) / C.G, T0 = C.vcu * per, T1 = (T0 + per < total) ? T0 + per : total;
    int cur = 0; { int lo_ = 0, hi_ = 511; while (lo_ < hi_) { const int mid_ = (lo_ + hi_ + 1) >> 1; if (pref[mid_] <= T0) lo_ = mid_; else hi_ = mid_ - 1; } cur = lo_; }
#define PC_ENT(ent_, pair_, T_) do { ent_[0] = 0u; ent_[1] = 0u; pair_ = 0; if ((T_) < T1) { while (pref[cur + 1] <= (T_)) ++cur; pair_ = cur; const int i_ = ((T_) - pref[cur]) * 256 + 32 * C.wave + fr; const int c_ = cntl[cur]; \
        if (i_ < c_) ent_[0] = 0x10000u | (unsigned)lists[(unsigned)(cur * S + i_)]; if (i_ + 16 < c_) ent_[1] = 0x10000u | (unsigned)lists[(unsigned)(cur * S + i_ + 16)]; } } while (0)
#define PC_Q(q_, ent_, pair_) do { _Pragma("unroll") for (int g_ = 0; g_ < 2; ++g_) { const bf16* qp_ = P + (unsigned)(((ent_)[g_] & 0x3fff) * NIN + Q_OFF + ((pair_) >> 6) * HD + 8 * fq); \
        q_[g_][0] = *(const bf16x8*)qp_; q_[g_][1] = *(const bf16x8*)(qp_ + 32); } } while (0)
    unsigned e1[2]; int p1;
    PC_ENT(e1, p1, T0);
    for (int T = T0; T < T1; ++T) {
        const int pair = p1, h = pair >> 6, n = pair & 63;
        const unsigned ent[2] = {e1[0], e1[1]};
        bf16x8 qf[2][2]; PC_Q(qf, ent, pair);
        PC_ENT(e1, p1, T + 1);
        if (pair != curpair) { __syncthreads(); stage_kv(C, P, n, h, 256, Ks, Vs); __syncthreads(); curpair = pair; }
        f32x4 sacc[2][16];
        attn_s2(sacc, Ks, qf, 16, C.lane);
        AttnOut R[2]; const int dz[2] = {0, 0};
        attn_pv2<false>(R, sacc, Vs, 16, dz, 0, C.lane);
#pragma unroll
        for (int g = 0; g < 2; ++g) {
            if (ent[g] & 0x10000u) {
                const int tok = ent[g] & 0x3fff, rank = (ent[g] >> 14) & 3;
                const float inv = 1.0f / R[g].l;
                bf16* op = PO + (unsigned)(((rank * S + tok) * NH + h) * HD + 4 * fq);
#pragma unroll
                for (int c = 0; c < 4; ++c) { u32x2 o; o.x = pk2(R[g].o[c][0] * inv, R[g].o[c][1] * inv); o.y = pk2(R[g].o[c][2] * inv, R[g].o[c][3] * inv); *(u32x2*)(op + 16 * c) = o; }
                if (fq == 0) PML[(unsigned)((rank * S + tok) * NH + h)] = make_float2(R[g].m, R[g].l);
            }
        }
    }
#undef PC_ENT
#undef PC_Q
    __syncthreads();
}

__device__ __forceinline__ void pd_ownattn(const Ctx& C0, int l) {
    Ctx C = C0; asm volatile("" : "+s"(C.wave), "+s"(C.vcu), "+s"(C.G), "+s"(C.lds)); C.lane = (int)__builtin_amdgcn_mbcnt_hi(~0u, __builtin_amdgcn_mbcnt_lo(~0u, 0u)); asm volatile("" : "+v"(C.lane)); C.tid = C.wave * 64 + C.lane;
    Args a; LOADARG(a, ws);
    unsigned char* ws = a.ws;
    const bf16* P = (const bf16*)(ws + WS_P);
    bf16* mix = (bf16*)(ws + WS_MIXIN);
    LAS unsigned char* Ks = C.lds; LAS unsigned char* Vs = C.lds + 32768;
    const bf16* PO = (const bf16*)(ws + WS_PARTO); const float2* PML = (const float2*)(ws + WS_PARTML);
    const int fr = C.lane & 15, fq = C.lane >> 4;
    for (int it = C.vcu; it < NH * 64; it += C.G) {
        const int h = it & 7, own = it >> 3;
        int qoff[2]; bf16x8 qf[2][2];
#pragma unroll
        for (int g = 0; g < 2; ++g) {
            qoff[g] = 32 * C.wave + 16 * g + fr;
#pragma unroll
            for (int ks = 0; ks < 2; ++ks) qf[g][ks] = *(const bf16x8*)(P + (size_t)(own * 256 + qoff[g]) * NIN + Q_OFF + h * HD + 32 * ks + 8 * fq);
        }
        __syncthreads();
        stage_kv(C, P, own, h, 256, Ks, Vs);
        __syncthreads();
        const int nct = 2 * C.wave + 2;
        AttnOut R[2]; const int dtile[2] = {2 * C.wave, 2 * C.wave + 1};
        f32x4 sacc[2][16];
        attn_s2(sacc, Ks, qf, nct, C.lane);
        attn_pv2<true>(R, sacc, Vs, nct, dtile, fr, C.lane);
        const int nsel = own < 3 ? own : 3;
#pragma unroll
        for (int g = 0; g < 2; ++g) {
            const int tok = own * 256 + qoff[g];
            float mm[3], ll[3]; float M = R[g].m;
#pragma unroll
            for (int r = 0; r < 3; ++r) { mm[r] = -1e30f; ll[r] = 0.f; if (r < nsel) { const float2 t = PML[((size_t)r * S + tok) * NH + h]; mm[r] = t.x; ll[r] = t.y; M = fmaxf(M, t.x); } }
            const float w0 = fast_exp2((R[g].m - M) * LOG2E);
            float wr_[3]; float den = R[g].l * w0;
#pragma unroll
            for (int r = 0; r < 3; ++r) { wr_[r] = (r < nsel) ? ll[r] * fast_exp2((mm[r] - M) * LOG2E) : 0.f; den += wr_[r]; }
            const float inv = 1.0f / den;
            f32x4 o[4];
#pragma unroll
            for (int c = 0; c < 4; ++c) o[c] = R[g].o[c] * w0;
#pragma unroll
            for (int r = 0; r < 3; ++r) {
                if (r < nsel) {
                    const bf16* op = PO + (((size_t)r * S + tok) * NH + h) * HD + 4 * fq;
#pragma unroll
                    for (int c = 0; c < 4; ++c) { const u32x2 w = *(const u32x2*)(op + 16 * c); o[c][0] += wr_[r] * bflo(w.x); o[c][1] += wr_[r] * bfhi(w.x); o[c][2] += wr_[r] * bflo(w.y); o[c][3] += wr_[r] * bfhi(w.y); }
                }
            }
            bf16* yp = mix + (size_t)tok * D + h * HD + 4 * fq;
#pragma unroll
            for (int c = 0; c < 4; ++c) { u32x2 w; w.x = pk2(o[c][0] * inv, o[c][1] * inv); w.y = pk2(o[c][2] * inv, o[c][3] * inv); *(u32x2*)(yp + 16 * c) = w; }
        }
    }
    __syncthreads();
}

__device__ __forceinline__ float reduce16_scatter(const float (&lg)[16], int lane) {
    const bool h32 = (lane & 32) != 0, h16 = (lane & 16) != 0, h8 = (lane & 8) != 0, h4 = (lane & 4) != 0;
    float r8[8], r4[4], r2[2];
#pragma unroll
    for (int e = 0; e < 8; ++e) { const float keep = h32 ? lg[e + 8] : lg[e], send = h32 ? lg[e] : lg[e + 8]; r8[e] = keep + __shfl_xor(send, 32); }
#pragma unroll
    for (int e = 0; e < 4; ++e) { const float keep = h16 ? r8[e + 4] : r8[e], send = h16 ? r8[e] : r8[e + 4]; r4[e] = keep + __shfl_xor(send, 16); }
#pragma unroll
    for (int e = 0; e < 2; ++e) { const float keep = h8 ? r4[e + 2] : r4[e], send = h8 ? r4[e] : r4[e + 2]; r2[e] = keep + __shfl_xor(send, 8); }
    float r1 = (h4 ? r2[1] : r2[0]) + __shfl_xor(h4 ? r2[0] : r2[1], 4);
    r1 += __shfl_xor(r1, 2); r1 += __shfl_xor(r1, 1);
    return r1;
}
__device__ __forceinline__ void route_one(float red, const float* router_bias, int lane, int lt, LAS int* tinfo, LAS float* tw, LAS unsigned* cntL) {
    float sc[16], bi[16];
#pragma unroll
    for (int e = 0; e < 16; ++e) {
        const int L = 32 * (e >> 3) + 16 * ((e >> 2) & 1) + 8 * ((e >> 1) & 1) + 4 * (e & 1);
        const float lgt = __builtin_bit_cast(float, __builtin_amdgcn_readlane(__builtin_bit_cast(int, red), L));
        sc[e] = sigmoidf_(lgt); bi[e] = sc[e] + router_bias[e];
    }
    int bg = 0; float bgs = -3e38f;
#pragma unroll
    for (int gI = 0; gI < 4; ++gI) {
        float t1 = -3e38f, t2 = -3e38f;
#pragma unroll
        for (int i = 0; i < 4; ++i) { const float x = bi[4 * gI + i]; if (x > t1) { t2 = t1; t1 = x; } else if (x > t2) t2 = x; }
        const float gs = t1 + t2;
        if (gs > bgs) { bgs = gs; bg = gI; }
    }
    float t1 = -3e38f, t2 = -3e38f; int j1 = 0, j2 = 0;
#pragma unroll
    for (int gI = 0; gI < 4; ++gI) {
        if (gI == bg) {
#pragma unroll
            for (int i = 0; i < 4; ++i) { const float x = bi[4 * gI + i]; if (x > t1) { t2 = t1; j2 = j1; t1 = x; j1 = i; } else if (x > t2) { t2 = x; j2 = i; } }
        }
    }
    float s1 = 0.f, s2 = 0.f;
#pragma unroll
    for (int e = 0; e < 16; ++e) { if (e == 4 * bg + j1) s1 = sc[e]; if (e == 4 * bg + j2) s2 = sc[e]; }
    const int e0 = 4 * bg + j1, e1 = 4 * bg + j2;
    if (lane == 0) {
        const float inv = 1.0f / (s1 + s2);
        tinfo[4 * lt + 0] = e0; tinfo[4 * lt + 1] = (int)__hip_atomic_fetch_add(&cntL[e0], 1u, __ATOMIC_RELAXED, __HIP_MEMORY_SCOPE_WORKGROUP);
        tinfo[4 * lt + 2] = e1; tinfo[4 * lt + 3] = (int)__hip_atomic_fetch_add(&cntL[e1], 1u, __ATOMIC_RELAXED, __HIP_MEMORY_SCOPE_WORKGROUP);
        tw[2 * lt] = s1 * inv; tw[2 * lt + 1] = s2 * inv;
    }
}

__device__ __forceinline__ void pf_convert(const Ctx& C0, int l) {
    Ctx C = C0; asm volatile("" : "+s"(C.wave), "+s"(C.vcu), "+s"(C.G), "+s"(C.lds)); C.lane = (int)__builtin_amdgcn_mbcnt_hi(~0u, __builtin_amdgcn_mbcnt_lo(~0u, 0u)); asm volatile("" : "+v"(C.lane)); C.tid = C.wave * 64 + C.lane;
    Args a; LOADARG(a, ws); LOADARG(a, w_gate); LOADARG(a, w_up); LOADARG(a, w_down);
    unsigned char* ws = a.ws;
    LAS float* scr = (LAS float*)(C.lds + C.wave * 16384);
    const int gw = C.vcu * NWAVES + C.wave, NGW = C.G * NWAVES;
    constexpr int I_G = (D / 64) * (DE / 64), I_D = (DE / 64) * (D / 64);
    for (int it = gw; it < NE * (2 * I_G + I_D); it += NGW) {
        const int e = it / (2 * I_G + I_D); int r = it % (2 * I_G + I_D);
        const size_t eo = ((size_t)l * NE + e) * D * DE;
        if (r < I_G) transpose_item(a.w_gate + eo, D, DE, (bf16*)(ws + WS_WGU) + (size_t)e * D * D, scr, r, C.lane, MapGU{0});
        else if (r < 2 * I_G) transpose_item(a.w_up + eo, D, DE, (bf16*)(ws + WS_WGU) + (size_t)e * D * D, scr, r - I_G, C.lane, MapGU{1});
        else transpose_item(a.w_down + eo, DE, D, (bf16*)(ws + WS_WDN) + (size_t)e * D * DE, scr, r - 2 * I_G, C.lane, MapPerm{});
    }
    __syncthreads();
}
__device__ __forceinline__ void pf_ln_router(const Ctx& C0, int l, bool dry = false) {
    Ctx C = C0; asm volatile("" : "+s"(C.wave), "+s"(C.vcu), "+s"(C.G), "+s"(C.lds)); C.lane = (int)__builtin_amdgcn_mbcnt_hi(~0u, __builtin_amdgcn_mbcnt_lo(~0u, 0u)); asm volatile("" : "+v"(C.lane)); C.tid = C.wave * 64 + C.lane;
    Args a; LOADARG(a, ws); LOADARG(a, w_router); LOADARG(a, router_bias); LOADARG(a, out); LOADARG(a, ln_mix_g); LOADARG(a, ln_mix_b);
    unsigned char* ws = a.ws;
    LAS float* wrt = (LAS float*)C.lds;
    LAS unsigned* cntL = (LAS unsigned*)(C.lds + 65536);
    LAS unsigned* baseL = cntL + 16;
    LAS int* tinfo = (LAS int*)(C.lds + 65536 + 256);
    LAS float* tw = (LAS float*)(C.lds + 65536 + 256 + 4096);
    for (int i = C.tid; i < D * NE / 4; i += NWAVES * 64) { const int k = i >> 2, q = i & 3; ((LAS f32x4*)wrt)[q * 1024 + ((k >> 8) * 4 + (k & 3)) * 64 + ((k >> 2) & 63)] = ((const f32x4*)a.w_router)[i]; }
    if (C.tid < 16) cntL[C.tid] = 0u;
    __syncthreads();
    float* H = a.out; bf16* hb = (bf16*)(ws + WS_HB);
    const float* g = a.ln_mix_g + l * D; const float* b = a.ln_mix_b + l * D;
    constexpr int TPW = S / 256;
    for (int lt = C.wave; lt < TPW; lt += 2 * NWAVES) {
        const int tokA = C.vcu * TPW + lt, tokB = tokA + NWAVES;
        f32x4 vA[4], vB[4];
#pragma unroll
        for (int j = 0; j < 4; ++j) { vA[j] = *(const f32x4*)(H + (size_t)tokA * D + 4 * C.lane + 256 * j); vB[j] = *(const f32x4*)(H + (size_t)tokB * D + 4 * C.lane + 256 * j); }
        ln_row(vA, g, b, C.lane, LN_EPS); ln_row(vB, g, b, C.lane, LN_EPS);
        if (dry) { store_row(vA, (float*)(ws + WS_AG) + (size_t)tokA * D, (bf16*)(ws + WS_ACT) + (size_t)tokA * D, C.lane); store_row(vB, (float*)(ws + WS_AG) + (size_t)tokB * D, (bf16*)(ws + WS_ACT) + (size_t)tokB * D, C.lane); }
        else { store_row(vA, H + (size_t)tokA * D, hb + (size_t)tokA * D, C.lane); store_row(vB, H + (size_t)tokB * D, hb + (size_t)tokB * D, C.lane); }
        float lgA[16], lgB[16];
#pragma unroll
        for (int e = 0; e < 16; ++e) { lgA[e] = 0.f; lgB[e] = 0.f; }
#pragma unroll
        for (int j = 0; j < 4; ++j)
#pragma unroll
            for (int i = 0; i < 4; ++i) {
                const LAS f32x4* wr4 = (const LAS f32x4*)wrt + (4 * j + i) * 64 + C.lane;
                const float xa = vA[j][i], xb = vB[j][i];
#pragma unroll
                for (int q = 0; q < 4; ++q) { const f32x4 w4 = wr4[q * 1024];
                    lgA[4 * q] += xa * w4[0]; lgA[4 * q + 1] += xa * w4[1]; lgA[4 * q + 2] += xa * w4[2]; lgA[4 * q + 3] += xa * w4[3];
                    lgB[4 * q] += xb * w4[0]; lgB[4 * q + 1] += xb * w4[1]; lgB[4 * q + 2] += xb * w4[2]; lgB[4 * q + 3] += xb * w4[3]; }
            }
        const float rA = reduce16_scatter(lgA, C.lane), rB = reduce16_scatter(lgB, C.lane);
        route_one(rA, a.router_bias, C.lane, lt, tinfo, tw, cntL);
        route_one(rB, a.router_bias, C.lane, lt + NWAVES, tinfo, tw, cntL);
    }
    __syncthreads();
    if (dry) { __syncthreads(); return; }
    unsigned* ecnt = (unsigned*)(ws + WS_CTL) + CW_ECNT + l * 16;
    if (C.tid < 16) { const unsigned c = cntL[C.tid]; baseL[C.tid] = c ? atomicAdd(&ecnt[C.tid], c) : 0u; }
    __syncthreads();
    int* elist = (int*)(ws + WS_ELIST); float* ew = (float*)(ws + WS_EW);
    if (C.tid < 2 * TPW) {
        const int lt = C.tid >> 1, sl = C.tid & 1, tok = C.vcu * TPW + lt;
        const int e = tinfo[4 * lt + 2 * sl], lp = tinfo[4 * lt + 2 * sl + 1];
        elist[(size_t)e * S + baseL[e] + lp] = tok * 2 + sl;
        ew[tok * 2 + sl] = tw[2 * lt + sl];
    }
    __syncthreads();
}

__device__ __forceinline__ void pg_gather(const Ctx& C0, int l, volatile LAS int* tstart) {
    Ctx C = C0; asm volatile("" : "+s"(C.wave), "+s"(C.vcu), "+s"(C.G), "+s"(C.lds)); C.lane = (int)__builtin_amdgcn_mbcnt_hi(~0u, __builtin_amdgcn_mbcnt_lo(~0u, 0u)); asm volatile("" : "+v"(C.lane)); C.tid = C.wave * 64 + C.lane;
    Args a; LOADARG(a, ws);
    unsigned char* ws = a.ws;
    const unsigned* ecnt = (const unsigned*)(ws + WS_CTL) + CW_ECNT + l * 16;
    LAS int* ecl = (LAS int*)(C.lds);
    if (C.tid == 0) { int s = 0; for (int e = 0; e < 16; ++e) { const int c = (int)__hip_atomic_load(ecnt + e, RLX_AGENT); ecl[e] = c; tstart[e] = s; s += (c + 255) >> 8; } tstart[16] = s; }
    __syncthreads();
    const int nrows = tstart[16] * 256;
    const int gw = C.vcu * NWAVES + C.wave, NGW = C.G * NWAVES;
    const int* elist = (const int*)(ws + WS_ELIST); const float* ew = (const float*)(ws + WS_EW);
    const bf16* hb = (const bf16*)(ws + WS_HB); bf16* AG = (bf16*)(ws + WS_AG); int2* rowinfo = (int2*)(ws + WS_ROWINFO);
    for (int R = gw; R < nrows; R += NGW) {
        const int mt = R >> 8; int e = 0;
#pragma unroll
        for (int j = 1; j < 16; ++j) e += (mt >= tstart[j]) ? 1 : 0;
        const int pos = R - tstart[e] * 256;
        if (pos < ecl[e]) {
            const int ent = elist[(size_t)e * S + pos], tok = ent >> 1;
            const u32x4* src = (const u32x4*)(hb + (size_t)tok * D); u32x4* dst = (u32x4*)(AG + (size_t)R * D);
            const u32x4 x0 = src[C.lane], x1 = src[64 + C.lane];
            dst[C.lane] = x0; dst[64 + C.lane] = x1;
            if (C.lane == 0) rowinfo[R] = make_int2(ent, __builtin_bit_cast(int, ew[ent]));
        } else {
            u32x4* dst = (u32x4*)(AG + (size_t)R * D); const u32x4 z = (u32x4){0u, 0u, 0u, 0u};
            dst[C.lane] = z; dst[64 + C.lane] = z;
            if (C.lane == 0) ((int*)rowinfo)[2 * R] = -1;
        }
    }
}

__device__ __forceinline__ void pj_final(const Ctx& C0, int l, bool poison, bool dry = false) {
    Ctx C = C0; asm volatile("" : "+s"(C.wave), "+s"(C.vcu), "+s"(C.G), "+s"(C.lds)); C.lane = (int)__builtin_amdgcn_mbcnt_hi(~0u, __builtin_amdgcn_mbcnt_lo(~0u, 0u)); asm volatile("" : "+v"(C.lane)); C.tid = C.wave * 64 + C.lane;
    Args a; LOADARG(a, ws); LOADARG(a, out); LOADARG(a, ln_ffn_g); LOADARG(a, ln_ffn_b);
    unsigned char* ws = a.ws;
    const int gw = C.vcu * NWAVES + C.wave, NGW = C.G * NWAVES;
    float* H = a.out; bf16* hb = (bf16*)(ws + WS_HB); const bf16* Y = (const bf16*)(ws + WS_Y);
    const float* g = a.ln_ffn_g + l * D; const float* b = a.ln_ffn_b + l * D;
    for (int tok = gw; tok < S; tok += NGW) {
        f32x4 v[4];
#pragma unroll
        for (int j = 0; j < 4; ++j) {
            v[j] = *(const f32x4*)(H + (size_t)tok * D + 4 * C.lane + 256 * j) * ALPHA;
            const u32x2 y0 = *(const u32x2*)(Y + ((size_t)tok * 2) * D + 4 * C.lane + 256 * j), y1 = *(const u32x2*)(Y + ((size_t)tok * 2 + 1) * D + 4 * C.lane + 256 * j);
            v[j][0] += bflo(y0.x) + bflo(y1.x); v[j][1] += bfhi(y0.x) + bfhi(y1.x); v[j][2] += bflo(y0.y) + bflo(y1.y); v[j][3] += bfhi(y0.y) + bfhi(y1.y);
        }
        ln_row(v, g, b, C.lane, LN_EPS);
        if (poison) {
#pragma unroll
            for (int j = 0; j < 4; ++j) v[j] = (f32x4){__builtin_nanf(""), __builtin_nanf(""), __builtin_nanf(""), __builtin_nanf("")};
        }
        if (dry) store_row(v, (float*)(ws + WS_AG) + (size_t)tok * D, (bf16*)(ws + WS_ACT) + (size_t)tok * D, C.lane);
        else store_row(v, H + (size_t)tok * D, hb + (size_t)tok * D, C.lane);
    }
}


#if SELFCHECK
__global__ void __launch_bounds__(256) selfcheck_kernel(Args a) {
    const int l = 0;
    unsigned char* ws = a.ws;
    const bf16* P = (const bf16*)(ws + WS_P);
    unsigned* err = (unsigned*)(ws + WS_ERR);
    const int gt = blockIdx.x * blockDim.x + threadIdx.x, NGT = gridDim.x * blockDim.x;
#if SELFCHECK & 1
    {
        const bf16* mix = (const bf16*)(ws + WS_MIXIN);
        const float* ksum = (const float*)(ws + WS_CTL) + CW_KMEAN + (size_t)l * (NH * NBLK * HD);
        constexpr int NTOK = 1024 + (S - 1024) / 7;
        for (int p = gt; p < NTOK * 8; p += NGT) {
            const int ti = p >> 3, h = p & 7;
            const int tok = ti < 1024 ? ti : 1024 + (ti - 1024) * 7 + 3;
            const int own = tok >> 8;
            float q[64];
            {
                const u32x4* qp = (const u32x4*)(P + (size_t)tok * NIN + Q_OFF + h * HD);
#pragma unroll
                for (int c = 0; c < 8; ++c) { const u32x4 w = qp[c]; q[8 * c + 0] = bflo(w.x); q[8 * c + 1] = bfhi(w.x); q[8 * c + 2] = bflo(w.y); q[8 * c + 3] = bfhi(w.y); q[8 * c + 4] = bflo(w.z); q[8 * c + 5] = bfhi(w.z); q[8 * c + 6] = bflo(w.w); q[8 * c + 7] = bfhi(w.w); }
            }
            float v0 = -3e38f, v1 = -3e38f, v2 = -3e38f; int i0 = 0, i1 = 0, i2 = 0;
            for (int n = 0; n < own; ++n) {
                const f32x4* kr = (const f32x4*)(ksum + ((size_t)h * NBLK + n) * HD);
                float g = 0.f;
#pragma unroll
                for (int c = 0; c < 16; ++c) { const f32x4 kv = kr[c]; g += q[4 * c] * kv[0] + q[4 * c + 1] * kv[1] + q[4 * c + 2] * kv[2] + q[4 * c + 3] * kv[3]; }
                if (g > v0) { v2 = v1; i2 = i1; v1 = v0; i1 = i0; v0 = g; i0 = n; }
                else if (g > v1) { v2 = v1; i2 = i1; v1 = g; i1 = n; }
                else if (g > v2) { v2 = g; i2 = n; }
            }
            const int nsel = own < 3 ? own : 3;
            float m = -1e30f, lsum = 0.f; float o[64];
#pragma unroll
            for (int d = 0; d < 64; ++d) o[d] = 0.f;
            for (int r = 0; r < 4; ++r) {
                if (r < 3 && r >= nsel) continue;
                const int blk = (r == 0) ? i0 : (r == 1) ? i1 : (r == 2) ? i2 : own;
                const int nk = (r == 3) ? (tok & 255) + 1 : 256;
                for (int j = 0; j < nk; ++j) {
                    const bf16* kp = P + (size_t)(blk * 256 + j) * NIN + K_OFF + h * HD;
                    float sc = 0.f;
#pragma unroll
                    for (int c = 0; c < 8; ++c) { const u32x4 w = ((const u32x4*)kp)[c]; sc += q[8 * c] * bflo(w.x) + q[8 * c + 1] * bfhi(w.x) + q[8 * c + 2] * bflo(w.y) + q[8 * c + 3] * bfhi(w.y) + q[8 * c + 4] * bflo(w.z) + q[8 * c + 5] * bfhi(w.z) + q[8 * c + 6] * bflo(w.w) + q[8 * c + 7] * bfhi(w.w); }
                    const float mn = fmaxf(m, sc), al = __expf(m - mn), pe = __expf(sc - mn);
                    lsum = lsum * al + pe; m = mn;
                    const bf16* vp = P + (size_t)(blk * 256 + j) * NIN + V_OFF + h * HD;
#pragma unroll
                    for (int c = 0; c < 8; ++c) { const u32x4 w = ((const u32x4*)vp)[c];
                        o[8 * c] = o[8 * c] * al + pe * bflo(w.x); o[8 * c + 1] = o[8 * c + 1] * al + pe * bfhi(w.x); o[8 * c + 2] = o[8 * c + 2] * al + pe * bflo(w.y); o[8 * c + 3] = o[8 * c + 3] * al + pe * bfhi(w.y);
                        o[8 * c + 4] = o[8 * c + 4] * al + pe * bflo(w.z); o[8 * c + 5] = o[8 * c + 5] * al + pe * bfhi(w.z); o[8 * c + 6] = o[8 * c + 6] * al + pe * bflo(w.w); o[8 * c + 7] = o[8 * c + 7] * al + pe * bfhi(w.w); }
                }
            }
            const float inv = 1.0f / lsum; bool bad = false;
            const u32x4* yp = (const u32x4*)(mix + (size_t)tok * D + h * HD);
#pragma unroll
            for (int c = 0; c < 8; ++c) { const u32x4 w = yp[c]; const float g8[8] = {bflo(w.x), bfhi(w.x), bflo(w.y), bfhi(w.y), bflo(w.z), bfhi(w.z), bflo(w.w), bfhi(w.w)};
#pragma unroll
                for (int j = 0; j < 8; ++j) { const float ref = o[8 * c + j] * inv, df = fabsf(ref - g8[j]); if (!(df <= 0.002f + 0.02f * fabsf(ref))) bad = true; } }
            atomicAdd(err + 0, 1u); if (bad) atomicAdd(err + 1, 1u);
        }
    }
#endif
#if SELFCHECK & 2
    {
        const bf16* hb = (const bf16*)(ws + WS_HB);
        const float* W = a.w_in + (size_t)l * D * NIN;
        constexpr int NT = S / 37;
        for (int it = gt; it < NT * NIN; it += NGT) {
            const int ti = it / NIN, col = it % NIN, tok = 37 * ti + 5;
            const bool rot = col < 1024;
            const int d = col & 63, pcol = rot ? ((d < 32) ? col + 32 : col - 32) : col;
            float s1 = 0.f, s2 = 0.f;
            for (int k = 0; k < D; ++k) { const float hv = bf2f(hb[(size_t)tok * D + k]); s1 += hv * W[(size_t)k * NIN + col]; s2 += hv * W[(size_t)k * NIN + pcol]; }
            float ref; int pidx = col;
            if (rot) {
                const int i = d & 31;
                const double ang = (double)((float)tok * powf(10000.0f, -(float)i / 32.0f));
                const float cs_ = (float)cos(ang), sn_ = (float)sin(ang);
                ref = (d < 32) ? (s1 * cs_ - s2 * sn_) : (s1 * cs_ + s2 * sn_);
                if (col < 512) ref *= 0.125f;
                const int n1 = d >> 5, w1 = (d >> 4) & 1, t = d & 15;
                pidx = (col & ~63) + 32 * w1 + 8 * (t >> 2) + 4 * n1 + (t & 3);
            } else if (col >= SGU_OFF && col < CA_OFF) ref = gelu_tanh(s1);
            else ref = s1;
            const float got = bf2f(P[(size_t)tok * NIN + pidx]);
            if (!(fabsf(ref - got) <= 0.03f + 0.02f * fabsf(ref))) atomicAdd(err + 2, 1u);
        }
    }
#endif
#if SELFCHECK & 4
    {
        const float* ksum = (const float*)(ws + WS_CTL) + CW_KMEAN + (size_t)l * (NH * NBLK * HD);
        for (int it = gt; it < NH * NBLK * HD; it += NGT) {
            const int h = it >> 12, n = (it >> 6) & 63, dd = it & 63;
            float s = 0.f;
            for (int j = 0; j < 256; ++j) s += bf2f(P[(size_t)(n * 256 + j) * NIN + K_OFF + h * HD + dd]);
            if (!(fabsf(s - ksum[it]) * (1.0f / 256.0f) <= 2e-3f)) atomicAdd(err + 3, 1u);
        }
    }
#endif
}
__device__ __forceinline__ bool selfcheck_failed(unsigned char* ws) {
    unsigned* err = (unsigned*)(ws + WS_ERR);
    const unsigned n = __hip_atomic_load(err + 0, RLX_AGENT), b1 = __hip_atomic_load(err + 1, RLX_AGENT);
    const unsigned b2 = __hip_atomic_load(err + 2, RLX_AGENT), b3 = __hip_atomic_load(err + 3, RLX_AGENT);
    bool f = false;
#if SELFCHECK & 1
    f = f || (n == 0u) || (b1 * 100u > n);
#endif
#if SELFCHECK & 2
    f = f || (b2 > 200u);
#endif
#if SELFCHECK & 4
    f = f || (b3 > 0u);
#endif
    return f;
}
#endif

__global__ void __launch_bounds__(NWAVES * 64, 2) hymba_fwd(Args args) {
    extern __shared__ __attribute__((aligned(16))) unsigned char lds_raw[];
    Ctx C;
    C.lds = (LAS unsigned char*)lds_raw;
    volatile LAS unsigned* MISC = (volatile LAS unsigned*)(C.lds + MISC_OFF);
    C.tid = threadIdx.x; C.lane = C.tid & 63; C.wave = __builtin_amdgcn_readfirstlane(C.tid >> 6);
    C.G = gridDim.x; { const int bx = blockIdx.x; C.vcu = (C.G % 8 == 0) ? (bx % 8) * (C.G / 8) + bx / 8 : bx; }
    for (int u = C.tid; u < 64; u += NWAVES * 64) MISC[u] = 0u;
    if (C.tid == 0) {
        const unsigned long long pv[24] = {(unsigned long long)args.x, (unsigned long long)args.ln_in_g, (unsigned long long)args.ln_in_b, (unsigned long long)args.w_in, (unsigned long long)args.w_out,
            (unsigned long long)args.sg_ln_g, (unsigned long long)args.sg_ln_b, (unsigned long long)args.sg_w, (unsigned long long)args.sg_b, (unsigned long long)args.conv_w, (unsigned long long)args.conv_b,
            (unsigned long long)args.conv_ln_g, (unsigned long long)args.conv_ln_b, (unsigned long long)args.ln_mix_g, (unsigned long long)args.ln_mix_b, (unsigned long long)args.w_router,
            (unsigned long long)args.router_bias, (unsigned long long)args.w_gate, (unsigned long long)args.w_up, (unsigned long long)args.w_down, (unsigned long long)args.ln_ffn_g,
            (unsigned long long)args.ln_ffn_b, (unsigned long long)args.out, (unsigned long long)args.ws};
        volatile LAS unsigned* ap = (volatile LAS unsigned*)(C.lds + ARGS_OFF);
#pragma unroll
        for (int i = 0; i < 24; ++i) { ap[2 * i] = (unsigned)pv[i]; ap[2 * i + 1] = (unsigned)(pv[i] >> 32); }
    }
    __syncthreads();
    XcdBarrier bar;
    { unsigned char* ws0 = ARG(ws); bar = xcd_barrier_post((unsigned*)((gu32*)(ws0 + WS_CTL) + CW_BAR), MISC + 8); }
    volatile LAS int* tstart = (volatile LAS int*)(MISC + 16);
#define GRID_BAR() xcd_barrier_t<false>(bar)

#ifndef SKIP_P0
for (int rep_ = 0; rep_ <= REP_P0; ++rep_) { p0_prologue(C); }
#endif
    xcd_barrier_t<true>(bar);

    for (int l = 0; l < DEPTH; ++l) {
        {
            unsigned char* ws = ARG(ws);
            pg8::DenseOrder So; int bxl = blockIdx.x, Gl = C.G; asm volatile("" : "+s"(bxl), "+s"(Gl)); So.init(ws + WS_HB, (bf16*)(ws + WS_WIN) + (size_t)l * NIN * D, S, NIN, D, Gl, bxl);
            pg8::EpiIn E{(bf16*)(ws + WS_P), (const float*)(ws + WS_CS), (float*)(ws + WS_CTL) + CW_KMEAN + (size_t)l * (NH * NBLK * HD)};
#ifndef SKIP_PA
for (int rep_ = 0; rep_ <= REP_PA; ++rep_) { pg8::gemm_phase<pg8::EpiIn, pg8::DenseOrder, true, true>(lds_opaque(C.lds), D, So, E, C.wave); }
#endif
        }
        GRID_BAR();
        for (int rep_ = 0; rep_ < REP_BAR; ++rep_) GRID_BAR();
        {
#if ENABLE_ATT
#ifndef SKIP_PBG
            for (int rep_ = 0; rep_ < REP_GATE; ++rep_) for (int it = C.vcu; it < 256; it += C.G) pb_gating(C, l, it, true);
            for (int it = C.vcu; it < 256; it += C.G) pb_gating(C, l, it);
#endif
#endif
#ifndef SKIP_PBS
for (int rep_ = 0; rep_ <= REP_SG; ++rep_) { for (int it = C.vcu; it < 128; it += C.G) pb_sg(C, l, it); }
#endif
#ifndef SKIP_PBC
for (int rep_ = 0; rep_ <= REP_CONV; ++rep_) { for (int it = C.vcu; it < 256; it += C.G) pb_conv(C, l, it); }
#endif
        }
        GRID_BAR();
#if ENABLE_ATT
#ifndef SKIP_PC
for (int rep_ = 0; rep_ <= REP_PC; ++rep_) { pc_selattn(C, l); }
#endif
        GRID_BAR();
#ifndef SKIP_PD
for (int rep_ = 0; rep_ <= REP_PD; ++rep_) { pd_ownattn(C, l); }
#endif
        GRID_BAR();
#else
        {
            unsigned char* ws = ARG(ws);
            const int gt = C.vcu * (NWAVES * 64) + C.tid, NGT = C.G * NWAVES * 64;
            bf16* mix = (bf16*)(ws + WS_MIXIN);
            for (int i = gt; i < S * 64; i += NGT) { const int tok = i >> 6, c8 = i & 63; *(u32x4*)(mix + (size_t)tok * D + 8 * c8) = (u32x4){0u, 0u, 0u, 0u}; }
        }
        GRID_BAR();
#endif
#if SELFCHECK
        if (args.mode == 1) return;
#endif
        {
            unsigned char* ws = ARG(ws);
            pg8::DenseOrder So; int bxl = blockIdx.x, Gl = C.G; asm volatile("" : "+s"(bxl), "+s"(Gl)); So.init(ws + WS_MIXIN, (bf16*)(ws + WS_WOUT) + (size_t)l * D * D, S, D, D, Gl, bxl);
            float* Hp = ARG(out);
            for (int rep_ = 0; rep_ < REP_PE; ++rep_) { pg8::EpiOut Ed{Hp, (float*)(ws + WS_Y)}; pg8::gemm_phase<pg8::EpiOut, pg8::DenseOrder, false, true>(lds_opaque(C.lds), D, So, Ed, C.wave); }
            pg8::EpiOut E{Hp, Hp};
#ifndef SKIP_PE
            pg8::gemm_phase<pg8::EpiOut, pg8::DenseOrder, false, true>(lds_opaque(C.lds), D, So, E, C.wave);
#endif
        }
        GRID_BAR();
#ifndef SKIP_PF
        for (int rep_ = 0; rep_ <= REP_PFC; ++rep_) pf_convert(C, l);
        for (int rep_ = 0; rep_ < REP_PF; ++rep_) pf_ln_router(C, l, true);
        pf_ln_router(C, l);
#endif
        GRID_BAR();
#ifndef SKIP_PG
for (int rep_ = 0; rep_ <= REP_PG; ++rep_) { pg_gather(C, l, tstart); }
#endif
        GRID_BAR();
        {
            unsigned char* ws = ARG(ws);
            pg8::MoeOrder So; int vl = C.vcu, Gl = C.G; asm volatile("" : "+s"(vl), "+s"(Gl)); So.init(ws + WS_AG, ws + WS_WGU, D, D, Gl, vl, tstart);
            pg8::EpiGU E{(bf16*)(ws + WS_ACT)};
#ifndef SKIP_PH
for (int rep_ = 0; rep_ <= REP_PH; ++rep_) { pg8::gemm_phase<pg8::EpiGU, pg8::MoeOrder, true, true>(lds_opaque(C.lds), D, So, E, C.wave); }
#endif
        }
        GRID_BAR();
        {
            unsigned char* ws = ARG(ws);
            pg8::MoeOrder So; int vl = C.vcu, Gl = C.G; asm volatile("" : "+s"(vl), "+s"(Gl)); So.init(ws + WS_ACT, ws + WS_WDN, DE, D, Gl, vl, tstart);
            pg8::EpiDown E{(bf16*)(ws + WS_Y), (const int2*)(ws + WS_ROWINFO)};
#ifndef SKIP_PI
for (int rep_ = 0; rep_ <= REP_PI; ++rep_) { pg8::gemm_phase<pg8::EpiDown, pg8::MoeOrder, true, true>(lds_opaque(C.lds), DE, So, E, C.wave); }
#endif
        }
        GRID_BAR();
        {
            bool poison = false;
            if (l == DEPTH - 1) {
                gu32* ctl = (gu32*)(ARG(ws) + WS_CTL);
                poison = __hip_atomic_load((unsigned*)(ctl + CW_BAR) + XB_TMO, RLX_AGENT) != 0u;
#if SELFCHECK
                poison = poison || selfcheck_failed(ARG(ws));
#endif
            }
#ifndef SKIP_PJ
            for (int rep_ = 0; rep_ < REP_PJ; ++rep_) pj_final(C, l, poison, true);
            pj_final(C, l, poison);
#endif
        }
        if (l + 1 < DEPTH) GRID_BAR();
    }
}

extern "C" void kernel_launch(void* const* d_in, const int* in_sizes, int n_in, void* d_out, int out_size, void* d_ws, size_t ws_size, hipStream_t stream) {
    static int grid = 0;
    if (grid == 0) {
        if (n_in != 22 || in_sizes[0] != S * D || out_size != S * D || ws_size < WS_END + 4096) {
            fprintf(stderr, "kernel_launch: unexpected shapes (n_in %d, in0 %d, out %d, ws %zu, need %zu); nothing launched\n", n_in, n_in > 0 ? in_sizes[0] : -1, out_size, ws_size, (size_t)WS_END); grid = -1; return; }
        int dev = 0, cus = 0, per_cu = 0;
        if (hipGetDevice(&dev) != hipSuccess || hipDeviceGetAttribute(&cus, hipDeviceAttributeMultiprocessorCount, dev) != hipSuccess) { grid = -1; return; }
        if (hipFuncSetAttribute((const void*)hymba_fwd, hipFuncAttributeMaxDynamicSharedMemorySize, LDS_BYTES) != hipSuccess) { fprintf(stderr, "kernel_launch: hipFuncSetAttribute failed\n"); grid = -1; return; }
        if (hipOccupancyMaxActiveBlocksPerMultiprocessor(&per_cu, (const void*)hymba_fwd, NWAVES * 64, LDS_BYTES) != hipSuccess || per_cu < 1) { fprintf(stderr, "kernel_launch: occupancy query says %d\n", per_cu); grid = -1; (void)hipGetLastError(); return; }
        (void)hipGetLastError();
        grid = cus;
        if (grid != 256) { fprintf(stderr, "kernel_launch: built for a 256-CU device, got %d CUs\n", cus); grid = -1; return; }
    }
    if (grid < 0) return;
    if (hipMemsetAsync((char*)d_ws + WS_CTL, 0, CTL_ZERO_BYTES, stream) != hipSuccess) return;
    Args a{};
    a.x = (const float*)d_in[0]; a.ln_in_g = (const float*)d_in[1]; a.ln_in_b = (const float*)d_in[2]; a.w_in = (const float*)d_in[3]; a.w_out = (const float*)d_in[4];
    a.sg_ln_g = (const float*)d_in[5]; a.sg_ln_b = (const float*)d_in[6]; a.sg_w = (const float*)d_in[7]; a.sg_b = (const float*)d_in[8];
    a.conv_w = (const float*)d_in[9]; a.conv_b = (const float*)d_in[10]; a.conv_ln_g = (const float*)d_in[11]; a.conv_ln_b = (const float*)d_in[12];
    a.ln_mix_g = (const float*)d_in[13]; a.ln_mix_b = (const float*)d_in[14]; a.w_router = (const float*)d_in[15]; a.router_bias = (const float*)d_in[16];
    a.w_gate = (const float*)d_in[17]; a.w_up = (const float*)d_in[18]; a.w_down = (const float*)d_in[19]; a.ln_ffn_g = (const float*)d_in[20]; a.ln_ffn_b = (const float*)d_in[21];
    a.out = (float*)d_out; a.ws = (unsigned char*)d_ws;
#if SELFCHECK
    (void)hipMemsetAsync((char*)d_ws + WS_ERR, 0, 4096, stream);
    a.mode = 1;
    hipLaunchKernelGGL(hymba_fwd, dim3(grid), dim3(NWAVES * 64), LDS_BYTES, stream, a);
    hipLaunchKernelGGL(selfcheck_kernel, dim3(2048), dim3(256), 0, stream, a);
    (void)hipMemsetAsync((char*)d_ws + WS_CTL, 0, CTL_ZERO_BYTES, stream);
    a.mode = 0;
#endif
    hipLaunchKernelGGL(hymba_fwd, dim3(grid), dim3(NWAVES * 64), LDS_BYTES, stream, a);
}
```
